# Optimizing an MI355X kernel written in HIP

```python
import math
import jax, jax.numpy as jnp
from jax import lax
import numpy as np

D_MODEL = 1024
BATCH = 4
SEQ = 8192
DEPTH = 2

HEAD_DIM = 64
A_HEADS = 8
A_KV_HEADS = 2
Q_RANK = 256
IDX_HEADS = 8
IDX_DIM = 64
IDX_TOPK = 256
B_HEADS = 8
SSM_WIDTH = D_MODEL
SSM_GROUP = 16
SSM_GROUPS = SSM_WIDTH // SSM_GROUP
SSM_STATE = 64
SSM_CHUNK = 128
DT_MIN = 1e-3
DT_MAX = 1e-1
MEM_LEN = 256
XA_HEADS = 4
XA_HEAD_DIM = D_MODEL // XA_HEADS
N_EXPERTS = 32
TOP_K = 4
D_EXPERT = D_MODEL
SWIGLU_LIMIT = 7.0
SWIGLU_ALPHA = 1.702
MOE_BLOCK = 128
Q_BLOCK = 128
ROPE_THETA = 500000.0
LN_EPS = 1e-5
N_EVEN = (DEPTH + 1) // 2
N_ODD = DEPTH // 2
DN_ALPHA = (2 * DEPTH) ** 0.25
DN_BETA = (8 * DEPTH) ** -0.25
A_WIDTH = A_HEADS * HEAD_DIM
B_WIDTH = B_HEADS * HEAD_DIM
MIX_WIDTH = A_WIDTH + B_WIDTH
_EVEN_COLS = (Q_RANK, A_KV_HEADS * HEAD_DIM, A_KV_HEADS * HEAD_DIM, IDX_DIM, IDX_HEADS, B_WIDTH, B_WIDTH, B_WIDTH)
_EVEN_VALUE_COLS = (False, False, True, False, False, False, False, True)
EVEN_IN = sum(_EVEN_COLS)
EVEN_SPLITS = tuple(int(c) for c in np.cumsum(_EVEN_COLS)[:-1])

kernel_name = "hybrid_dsa_stickbreak_s5_moe_deepnorm"


def layer_norm(x, g, b):
    xf = x.astype(jnp.float32)
    mu = jnp.mean(xf, axis=-1, keepdims=True)
    var = jnp.mean(jnp.square(xf - mu), axis=-1, keepdims=True)
    y = (xf - mu) * lax.rsqrt(var + LN_EPS) * g.astype(jnp.float32) + b.astype(jnp.float32)
    return y.astype(x.dtype)


def rms_norm(x, g):
    xf = x.astype(jnp.float32)
    y = xf * lax.rsqrt(jnp.mean(jnp.square(xf), axis=-1, keepdims=True) + LN_EPS) * g.astype(jnp.float32)
    return y.astype(x.dtype)


def rope_partial(t, pos):
    rot = t.shape[-1] // 4
    half = rot // 2
    inv = ROPE_THETA ** (-jnp.arange(half, dtype=jnp.float32) / half)
    ang = pos[:, None] * inv[None, :]
    cos = jnp.cos(ang)[:, None, :]
    sin = jnp.sin(ang)[:, None, :]
    t1 = t[..., :half].astype(jnp.float32)
    t2 = t[..., half:rot].astype(jnp.float32)
    r = jnp.concatenate([t1 * cos - t2 * sin, t2 * cos + t1 * sin, t[..., rot:].astype(jnp.float32)], axis=-1)
    return r.astype(t.dtype)


def to_blocks(t, nb):
    return jnp.swapaxes(t.reshape(t.shape[0], nb, Q_BLOCK, *t.shape[2:]), 0, 1)


def from_blocks(t):
    t = jnp.swapaxes(t, 0, 1)
    return t.reshape(t.shape[0], -1, *t.shape[3:])


def dsa_attention(q, k, v, q_idx, k_idx, w_idx):
    bsz, seq = q.shape[0], q.shape[1]
    nb = seq // Q_BLOCK
    topk = min(IDX_TOPK, seq // 4)
    rep = A_HEADS // A_KV_HEADS
    key_pos = jnp.arange(seq)

    def one_block(args):
        blk, qb, qib, wb = args
        qpos = blk * Q_BLOCK + jnp.arange(Q_BLOCK)
        causal = key_pos[None, :] <= qpos[:, None]
        s = jnp.einsum('bqhd,bsd->bqsh', qib, k_idx)
        score = jnp.einsum('bqsh,bqh->bqs', jax.nn.relu(s), wb).astype(jnp.float32)
        score = jnp.where(causal[None], score, -jnp.inf)
        _, idx = lax.top_k(score, topk)
        valid = idx <= qpos[None, :, None]
        kg = jax.vmap(lambda kk, ii: kk[ii])(k, idx)
        vg = jax.vmap(lambda vv, ii: vv[ii])(v, idx)
        qg = qb.reshape(bsz, Q_BLOCK, A_KV_HEADS, rep, HEAD_DIM)
        logits = jnp.einsum('bqgrd,bqkgd->bqgrk', qg, kg).astype(jnp.float32) * (HEAD_DIM ** -0.5)
        logits = jnp.where(valid[:, :, None, None, :], logits, -jnp.inf)
        p = jax.nn.softmax(logits, axis=-1).astype(v.dtype)
        o = jnp.einsum('bqgrk,bqkgd->bqgrd', p, vg)
        return o.reshape(bsz, Q_BLOCK, A_WIDTH)

    out = lax.map(one_block, (jnp.arange(nb), to_blocks(q, nb), to_blocks(q_idx, nb), to_blocks(w_idx, nb)))
    return from_blocks(out)


def stick_breaking_attention(q, k, v):
    bsz, seq = q.shape[0], q.shape[1]
    nb = seq // Q_BLOCK
    key_pos = jnp.arange(seq)

    def one_block(args):
        blk, qb = args
        qpos = blk * Q_BLOCK + jnp.arange(Q_BLOCK)
        strict = key_pos[None, :] < qpos[:, None]
        z = jnp.einsum('bqhd,bshd->bhqs', qb, k).astype(jnp.float32) * (HEAD_DIM ** -0.5)
        log_1mb = jnp.where(strict, jax.nn.log_sigmoid(-z), 0.0)
        after = lax.cumsum(log_1mb, axis=3, reverse=True) - log_1mb
        a = jnp.where(strict, jnp.exp(jax.nn.log_sigmoid(z) + after), 0.0)
        o = jnp.einsum('bhqs,bshd->bqhd', a.astype(v.dtype), v)
        return o.reshape(bsz, Q_BLOCK, B_WIDTH)

    out = lax.map(one_block, (jnp.arange(nb), to_blocks(q, nb)))
    return from_blocks(out)


def even_mixer(x, pos, w_in, qnorm_g, w_uq, w_uq_idx, kidx_g, kidx_b, w_out):
    bsz, seq, _ = x.shape
    c_q, k_a, v_a, k_i, w_i, q_b, k_b, v_b = jnp.split(x @ w_in, EVEN_SPLITS, axis=-1)
    c_q = rms_norm(c_q, qnorm_g)
    q_a = rope_partial((c_q @ w_uq).reshape(bsz, seq, A_HEADS, HEAD_DIM), pos)
    k_a = rope_partial(k_a.reshape(bsz, seq, A_KV_HEADS, HEAD_DIM), pos)
    v_a = v_a.reshape(bsz, seq, A_KV_HEADS, HEAD_DIM)
    q_i = rope_partial((c_q @ w_uq_idx).reshape(bsz, seq, IDX_HEADS, IDX_DIM), pos) * (IDX_DIM ** -0.5)
    k_i = rope_partial(layer_norm(k_i, kidx_g, kidx_b)[:, :, None, :], pos)[:, :, 0, :]
    w_i = w_i * (IDX_HEADS ** -0.5)
    o_a = dsa_attention(q_a, k_a, v_a, q_i, k_i, w_i)
    o_b = stick_breaking_attention(q_b.reshape(bsz, seq, B_HEADS, HEAD_DIM),
                                   k_b.reshape(bsz, seq, B_HEADS, HEAD_DIM),
                                   v_b.reshape(bsz, seq, B_HEADS, HEAD_DIM))
    return jnp.concatenate([o_a, o_b], axis=-1) @ w_out


def _complex_linear_combine(e1, e2):
    a1r, a1i, b1r, b1i = e1
    a2r, a2i, b2r, b2i = e2
    return (a2r * a1r - a2i * a1i, a2r * a1i + a2i * a1r,
            a2r * b1r - a2i * b1i + b2r, a2r * b1i + a2i * b1r + b2i)


def s5_mixer(x, w_in, log_dt, lam_re, lam_im, b_re, b_im, c_re, c_im, d, w_out):
    bsz, seq, _ = x.shape
    f32 = jnp.float32
    u = x @ w_in
    dt = jnp.exp(log_dt.astype(f32))[:, None]
    lr, li = lam_re.astype(f32), lam_im.astype(f32)
    mag = jnp.exp(lr * dt)
    a_re, a_im = mag * jnp.cos(li * dt), mag * jnp.sin(li * dt)
    den = lr * lr + li * li
    coef_re = ((a_re - 1.0) * lr + a_im * li) / den
    coef_im = (a_im * lr - (a_re - 1.0) * li) / den
    br, bi = b_re.astype(f32), b_im.astype(f32)
    bb_re = coef_re[..., None] * br - coef_im[..., None] * bi
    bb_im = coef_re[..., None] * bi + coef_im[..., None] * br
    cr, ci = c_re.astype(f32), c_im.astype(f32)
    nc = seq // SSM_CHUNK
    u_t = jnp.swapaxes(u, 0, 1).astype(f32).reshape(nc, SSM_CHUNK, bsz, SSM_GROUPS, SSM_GROUP)
    a_re_c = jnp.broadcast_to(a_re, (SSM_CHUNK, 1, SSM_GROUPS, SSM_STATE))
    a_im_c = jnp.broadcast_to(a_im, (SSM_CHUNK, 1, SSM_GROUPS, SSM_STATE))

    def chunk(h, u_c):
        h_re, h_im = h
        bu_re = jnp.einsum('lbgc,gpc->lbgp', u_c, bb_re)
        bu_im = jnp.einsum('lbgc,gpc->lbgp', u_c, bb_im)
        A_re, A_im, s_re, s_im = lax.associative_scan(_complex_linear_combine, (a_re_c, a_im_c, bu_re, bu_im), axis=0)
        st_re = s_re + A_re * h_re - A_im * h_im
        st_im = s_im + A_re * h_im + A_im * h_re
        y = jnp.einsum('lbgp,gcp->lbgc', st_re, cr) - jnp.einsum('lbgp,gcp->lbgc', st_im, ci)
        return (st_re[-1], st_im[-1]), y

    h0 = (jnp.zeros((bsz, SSM_GROUPS, SSM_STATE), f32), jnp.zeros((bsz, SSM_GROUPS, SSM_STATE), f32))
    _, ys = lax.scan(chunk, h0, u_t)
    y = jnp.swapaxes(ys.reshape(seq, bsz, SSM_WIDTH), 0, 1)
    y = y + d.astype(f32) * u.astype(f32)
    y = jax.nn.gelu(y).astype(x.dtype)
    z = y @ w_out
    return z[..., :D_MODEL] * jax.nn.sigmoid(z[..., D_MODEL:])


def memory_cross_attention(x, mem, w_q, w_kv, w_o):
    bsz, seq, _ = x.shape
    q = (x @ w_q).reshape(bsz, seq, XA_HEADS, XA_HEAD_DIM)
    k, v = jnp.split(mem @ w_kv, 2, axis=-1)
    k = k.reshape(bsz, -1, XA_HEADS, XA_HEAD_DIM)
    v = v.reshape(bsz, -1, XA_HEADS, XA_HEAD_DIM)
    logits = jnp.einsum('bqhd,bmhd->bhqm', q, k).astype(jnp.float32) * (XA_HEAD_DIM ** -0.5)
    p = jax.nn.softmax(logits, axis=-1).astype(v.dtype)
    o = jnp.einsum('bhqm,bmhd->bqhd', p, v).reshape(bsz, seq, D_MODEL)
    return o @ w_o


def moe_ffn(x, w_router, b_router, w_gu, b_gu, w_down, b_down):
    bsz, seq, _ = x.shape
    n = bsz * seq
    x2 = x.reshape(n, D_MODEL)
    logits = (x2 @ w_router).astype(jnp.float32) + b_router.astype(jnp.float32)
    top_val, top_idx = lax.top_k(logits, TOP_K)
    gates = jax.nn.softmax(top_val, axis=-1).astype(x.dtype)
    e_flat = top_idx.reshape(-1)
    tok_flat = jnp.arange(n * TOP_K) // TOP_K
    order = jnp.argsort(e_flat)
    e_sorted = e_flat[order]
    counts = jnp.bincount(e_flat, length=N_EXPERTS)
    padded = (counts + MOE_BLOCK - 1) // MOE_BLOCK * MOE_BLOCK
    start = jnp.cumsum(counts) - counts
    ends_p = jnp.cumsum(padded)
    pstart = ends_p - padded
    dest = pstart[e_sorted] + (jnp.arange(n * TOP_K) - start[e_sorted])
    n_rows = n * TOP_K + N_EXPERTS * MOE_BLOCK
    n_blocks = n_rows // MOE_BLOCK
    rows_tok = jnp.full((n_rows,), n, jnp.int32).at[dest].set(tok_flat[order].astype(jnp.int32))
    rows_gate = jnp.zeros((n_rows,), x.dtype).at[dest].set(gates.reshape(-1)[order])
    block_exp = jnp.minimum(jnp.searchsorted(ends_p, jnp.arange(n_blocks) * MOE_BLOCK, side='right'), N_EXPERTS - 1)
    x_pad = jnp.concatenate([x2, jnp.zeros((1, D_MODEL), x2.dtype)], axis=0)

    def expert_block(args):
        tok, g, e = args
        h = x_pad[tok] @ w_gu[e] + b_gu[e]
        gate = jnp.minimum(h[:, :D_EXPERT], SWIGLU_LIMIT)
        up = jnp.clip(h[:, D_EXPERT:], -SWIGLU_LIMIT, SWIGLU_LIMIT)
        act = gate * jax.nn.sigmoid(gate * SWIGLU_ALPHA) * (up + 1.0)
        return (act @ w_down[e] + b_down[e]) * g[:, None]

    y_rows = lax.map(expert_block, (rows_tok.reshape(n_blocks, MOE_BLOCK), rows_gate.reshape(n_blocks, MOE_BLOCK), block_exp))
    out = jax.ops.segment_sum(y_rows.reshape(n_rows, D_MODEL), rows_tok, num_segments=n + 1)[:n]
    return out.reshape(bsz, seq, D_MODEL)


def setup_inputs(seed: int = 0) -> dict:
    key = jax.random.key(seed)
    ks = jax.random.split(key, 40)
    f32 = jnp.float32

    def nrm(k, shape, fan_in, scale=1.0):
        return jax.random.normal(k, shape, f32) * (scale * fan_in ** -0.5)

    def gain(k, shape):
        return 1.0 + 0.02 * jax.random.normal(k, shape, f32)

    def small(k, shape, s=0.02):
        return s * jax.random.normal(k, shape, f32)

    even_col_scale = jnp.concatenate([jnp.full((c,), DN_BETA if is_v else 1.0, f32)
                                      for c, is_v in zip(_EVEN_COLS, _EVEN_VALUE_COLS)])
    xa_kv_scale = jnp.concatenate([jnp.ones((D_MODEL,), f32), jnp.full((D_MODEL,), DN_BETA, f32)])
    return {
        "x": jax.random.normal(ks[0], (BATCH, SEQ, D_MODEL), f32),
        "mem": jax.random.normal(ks[1], (BATCH, MEM_LEN, D_MODEL), f32),
        "ev_w_in": nrm(ks[2], (N_EVEN, D_MODEL, EVEN_IN), D_MODEL) * even_col_scale,
        "ev_qnorm_g": gain(ks[3], (N_EVEN, Q_RANK)),
        "ev_w_uq": nrm(ks[4], (N_EVEN, Q_RANK, A_WIDTH), Q_RANK),
        "ev_w_uq_idx": nrm(ks[5], (N_EVEN, Q_RANK, IDX_HEADS * IDX_DIM), Q_RANK),
        "ev_kidx_ln_g": gain(ks[6], (N_EVEN, IDX_DIM)),
        "ev_kidx_ln_b": small(ks[7], (N_EVEN, IDX_DIM)),
        "ev_w_out": nrm(ks[8], (N_EVEN, MIX_WIDTH, D_MODEL), MIX_WIDTH, DN_BETA),
        "od_w_in": nrm(ks[9], (N_ODD, D_MODEL, SSM_WIDTH), D_MODEL),
        "od_log_dt": jax.random.uniform(ks[10], (N_ODD, SSM_GROUPS), f32, math.log(DT_MIN), math.log(DT_MAX)),
        "od_lambda_re": -0.5 + small(ks[11], (N_ODD, SSM_GROUPS, SSM_STATE), 0.01),
        "od_lambda_im": math.pi * jnp.arange(SSM_STATE, dtype=f32) + small(ks[12], (N_ODD, SSM_GROUPS, SSM_STATE), 0.01),
        "od_b_re": nrm(ks[13], (N_ODD, SSM_GROUPS, SSM_STATE, SSM_GROUP), 2 * SSM_GROUP),
        "od_b_im": nrm(ks[14], (N_ODD, SSM_GROUPS, SSM_STATE, SSM_GROUP), 2 * SSM_GROUP),
        "od_c_re": nrm(ks[15], (N_ODD, SSM_GROUPS, SSM_GROUP, SSM_STATE), SSM_STATE, 2.0),
        "od_c_im": nrm(ks[16], (N_ODD, SSM_GROUPS, SSM_GROUP, SSM_STATE), SSM_STATE, 2.0),
        "od_d": jax.random.normal(ks[17], (N_ODD, SSM_WIDTH), f32),
        "od_w_out": nrm(ks[18], (N_ODD, SSM_WIDTH, 2 * D_MODEL), SSM_WIDTH, DN_BETA),
        "mix_ln_g": gain(ks[19], (DEPTH, D_MODEL)),
        "mix_ln_b": small(ks[20], (DEPTH, D_MODEL)),
        "xa_w_q": nrm(ks[21], (DEPTH, D_MODEL, D_MODEL), D_MODEL),
        "xa_w_kv": nrm(ks[22], (DEPTH, D_MODEL, 2 * D_MODEL), D_MODEL) * xa_kv_scale,
        "xa_w_o": nrm(ks[23], (DEPTH, D_MODEL, D_MODEL), D_MODEL, DN_BETA),
        "xa_ln_g": gain(ks[24], (DEPTH, D_MODEL)),
        "xa_ln_b": small(ks[25], (DEPTH, D_MODEL)),
        "moe_w_router": nrm(ks[26], (DEPTH, D_MODEL, N_EXPERTS), D_MODEL),
        "moe_b_router": small(ks[27], (DEPTH, N_EXPERTS), 0.01),
        "moe_w_gu": nrm(ks[28], (DEPTH, N_EXPERTS, D_MODEL, 2 * D_EXPERT), D_MODEL),
        "moe_b_gu": small(ks[29], (DEPTH, N_EXPERTS, 2 * D_EXPERT)),
        "moe_w_down": nrm(ks[30], (DEPTH, N_EXPERTS, D_EXPERT, D_MODEL), D_EXPERT, DN_BETA),
        "moe_b_down": small(ks[31], (DEPTH, N_EXPERTS, D_MODEL)),
        "ffn_ln_g": gain(ks[32], (DEPTH, D_MODEL)),
        "ffn_ln_b": small(ks[33], (DEPTH, D_MODEL)),
    }


def reference(x, mem, ev_w_in, ev_qnorm_g, ev_w_uq, ev_w_uq_idx, ev_kidx_ln_g, ev_kidx_ln_b, ev_w_out,
              od_w_in, od_log_dt, od_lambda_re, od_lambda_im, od_b_re, od_b_im, od_c_re, od_c_im, od_d, od_w_out,
              mix_ln_g, mix_ln_b, xa_w_q, xa_w_kv, xa_w_o, xa_ln_g, xa_ln_b,
              moe_w_router, moe_b_router, moe_w_gu, moe_b_gu, moe_w_down, moe_b_down, ffn_ln_g, ffn_ln_b):
    pos = jnp.arange(x.shape[1], dtype=jnp.float32)
    h = x
    for layer in range(DEPTH):
        j = layer // 2
        if layer % 2 == 0:
            m = even_mixer(h, pos, ev_w_in[j], ev_qnorm_g[j], ev_w_uq[j], ev_w_uq_idx[j],
                           ev_kidx_ln_g[j], ev_kidx_ln_b[j], ev_w_out[j])
        else:
            m = s5_mixer(h, od_w_in[j], od_log_dt[j], od_lambda_re[j], od_lambda_im[j], od_b_re[j], od_b_im[j],
                         od_c_re[j], od_c_im[j], od_d[j], od_w_out[j])
        h = layer_norm(DN_ALPHA * h + m, mix_ln_g[layer], mix_ln_b[layer])
        h = layer_norm(DN_ALPHA * h + memory_cross_attention(h, mem, xa_w_q[layer], xa_w_kv[layer], xa_w_o[layer]),
                       xa_ln_g[layer], xa_ln_b[layer])
        h = layer_norm(DN_ALPHA * h + moe_ffn(h, moe_w_router[layer], moe_b_router[layer], moe_w_gu[layer],
                                              moe_b_gu[layer], moe_w_down[layer], moe_b_down[layer]),
                       ffn_ln_g[layer], ffn_ln_b[layer])
    return h
```

```cpp
#include <hip/hip_runtime.h>
#include <cstdio>
#include <cstdint>
namespace pg8 {
#define PG8_LAS __attribute__((address_space(3)))
typedef unsigned short bf16_t;
typedef short bf16x8 __attribute__((ext_vector_type(8)));
typedef float f32x4 __attribute__((ext_vector_type(4)));
typedef unsigned u32x4 __attribute__((ext_vector_type(4)));
constexpr int BM = 256, BK = 64, HALF = 128, HTB = HALF * BK * 2  , STAGE_BYTES = 8 * HTB, NXCD = 8, WGM = 8;

__host__ __device__ __forceinline__ int lds_byte(int r, int c) { const int st = (r >> 4) * 2 + (c >> 5), rr = r & 15, cc = c & 31, ob = rr * 64 + cc * 2; return st * 1024 + (ob ^ (((ob >> 9) & 1) << 5)); }
__host__ __device__ __forceinline__ void stage_rc(int b, int& R, int& C) { const int st = b / 1024, sb = b % 1024, swz = sb ^ (((sb >> 9) & 1) << 5); R = (st >> 1) * 16 + swz / 64; C = (st & 1) * 32 + (swz % 64) / 2; }
__host__ __device__ __forceinline__ int perm32(int rho) { const int n = rho >> 4, i = rho & 15; return 8 * (i >> 2) + 4 * n + (i & 3); }

struct Unit { int pm, pn; };
struct Gemm { const bf16_t* A; const bf16_t* Bt; int M, N, K; int wid; };

struct StaticOrder {
    int nM, nN, nwg, G, c;
    __host__ __device__ void init(int M, int N, int G_, int c_) { nM = M / BM; nN = N / BM; nwg = nM * nN; G = G_; c = c_; }
    __host__ __device__ bool next(int i, Unit& u) const {
        const long L = (long)i * G + c; if (L >= nwg) return false;
        int wgid = (int)L; { const int q = nwg / NXCD, r = nwg % NXCD, xcd = wgid % NXCD, off = wgid / NXCD; wgid = (xcd < r ? xcd * (q + 1) : r * (q + 1) + (xcd - r) * q) + off; }
        const int nig = WGM * nN, gid = wgid / nig, fm = gid * WGM, gsz = (nM - fm) < WGM ? (nM - fm) : WGM;
        u.pm = fm + ((wgid % nig) % gsz); u.pn = (wgid % nig) / gsz; return true;
    }
    __device__ __forceinline__ void a_ready(const Unit&) const {}
    __device__ __forceinline__ void done(const Unit&) const {}
};

__device__ __forceinline__ unsigned cvt_pk_bf16(float lo, float hi) { unsigned r; asm volatile("v_cvt_pk_bf16_f32 %0, %1, %2" : "=v"(r) : "v"(lo), "v"(hi)); return r; }
typedef float f32x2 __attribute__((ext_vector_type(2)));
__device__ __forceinline__ f32x2 gelu_pk(f32x2 v) {
    const f32x2 av = __builtin_elementwise_abs(v), d = av * 0.2316418882f + 1.0f;
    f32x2 t; t.x = __builtin_amdgcn_rcpf(d.x); t.y = __builtin_amdgcn_rcpf(d.y);
    f32x2 q = t * 0.5307027145f + (-0.7265760135f); q = q * t + 0.7107068705f; q = q * t + (-0.142248368f); q = q * t + 0.127414796f; q = q * t;
    const f32x2 s = (v * v) * (-0.72134752044f);
    f32x2 e; e.x = __builtin_amdgcn_exp2f(s.x); e.y = __builtin_amdgcn_exp2f(s.y);
    const f32x2 m = v * (q * e), r = v - m;
    f32x2 o; o.x = v.x < 0.f ? m.x : r.x; o.y = v.y < 0.f ? m.y : r.y; return o;
}

template <int ACT  > struct EpiBf16 {
    static constexpr bool PERM = true, AFTER_DRAIN = false; static_assert(ACT == 0 || ACT == 1, "EpiBf16: ACT is 0 (none) or 1 (gelu_pk)");
    bf16_t* O; int ldc; const float* bias; int split_cols; size_t split_stride; float scale0;
    __device__ __forceinline__ void operator()(const f32x4 (&acc)[2][2][4][2], const Unit& u, int wr, int wc, int fr, int fq) const {
        const int row0 = u.pm * BM + wr * 64 + fr; int colt = u.pn * BM; bf16_t* base = O;
        float sc = 1.f; if (split_cols) { const int t = colt / split_cols; base += (size_t)t * split_stride; colt -= t * split_cols; if (t == 0) sc = scale0; }
        const int col0 = colt + wc * 32 + 8 * fq, bcol0 = u.pn * BM + wc * 32 + 8 * fq;
        f32x4 bv[2][2];
#pragma unroll
        for (int bj = 0; bj < 2; ++bj)
#pragma unroll
            for (int n = 0; n < 2; ++n) bv[bj][n] = bias ? *(const f32x4*)(bias + bcol0 + bj * HALF + 4 * n) : (f32x4){0.f, 0.f, 0.f, 0.f};
#pragma unroll
        for (int ai = 0; ai < 2; ++ai)
#pragma unroll
            for (int m = 0; m < 4; ++m) { bf16_t* rowp = base + (size_t)(row0 + ai * HALF + m * 16) * ldc + col0;
#pragma unroll
                for (int bj = 0; bj < 2; ++bj) { f32x4 v0 = acc[ai][bj][m][0] + bv[bj][0], v1 = acc[ai][bj][m][1] + bv[bj][1];
                    if (ACT == 1) { f32x2 a = gelu_pk((f32x2){v0[0], v0[1]}), b = gelu_pk((f32x2){v0[2], v0[3]}), c = gelu_pk((f32x2){v1[0], v1[1]}), d = gelu_pk((f32x2){v1[2], v1[3]});
                        v0 = (f32x4){a.x, a.y, b.x, b.y}; v1 = (f32x4){c.x, c.y, d.x, d.y}; }
                    v0 = v0 * sc; v1 = v1 * sc; u32x4 w; w.x = cvt_pk_bf16(v0[0], v0[1]); w.y = cvt_pk_bf16(v0[2], v0[3]); w.z = cvt_pk_bf16(v1[0], v1[1]); w.w = cvt_pk_bf16(v1[2], v1[3]);
                    *(u32x4*)(rowp + bj * HALF) = w; } }
    }
};
template <class Epi, class Sched, bool ALIGN_EPI = false, bool SP2 = false>
__device__ __forceinline__ void gemm_phase(PG8_LAS unsigned char* lds, const Gemm g, const Sched& S, const Epi& E) {
    int tid_; asm volatile("v_mbcnt_lo_u32_b32 %0, -1, 0\n\tv_mbcnt_hi_u32_b32 %0, -1, %0" : "=v"(tid_)); tid_ += g.wid * 64;
    const int tid = tid_, wid = __builtin_amdgcn_readfirstlane(tid >> 6), lane = tid & 63, wr = wid >> 2, wc = wid & 3, fr = lane & 15, fq = lane >> 4;
    const int K = g.K, nt = K / BK;
    unsigned voffA[2], voffB[2];
#pragma unroll
    for (int i = 0; i < 2; ++i) { int R, C; stage_rc(tid * 16 + i * 8192, R, C); const int Rb = Epi::PERM ? ((R & ~31) + perm32(R & 31)) : R;
        voffA[i] = (unsigned)(R * K + C) * 2u; voffB[i] = (unsigned)(Rb * K + C) * 2u; }
    const size_t kstep = (size_t)(BK * 2);
    const size_t hstep = (size_t)HALF * K * 2;
    const size_t tstep = 2 * hstep;
    const unsigned ldsw = (unsigned)wid * 1024u;
    const int aoff = lds_byte(wr * 64 + fr, fq * 8), boff = lds_byte(wc * 32 + fr, fq * 8);
#define PG8_SA(b, h) (((b) * 2 + (h)) * HTB)
#define PG8_SB(b, h) ((4 + (b) * 2 + (h)) * HTB)
#define PG8_STAGE(bufoff, gbase, voff) do { _Pragma("unroll") for (int _i = 0; _i < 2; ++_i) \
        __builtin_amdgcn_global_load_lds((const unsigned*)((const char*)(gbase) + (voff)[_i]), (PG8_LAS unsigned*)(lds + (bufoff) + ldsw + _i * 8192), 16, 0, 0); } while (0)
#define PG8_LDA(dst, b, h) do { _Pragma("unroll") for (int m = 0; m < 4; ++m) _Pragma("unroll") for (int k = 0; k < 2; ++k) dst[m][k] = *(const PG8_LAS bf16x8*)(lds + PG8_SA(b, h) + aoff + m * 2048 + k * 1024); } while (0)
#define PG8_LDB(dst, b, h) do { _Pragma("unroll") for (int n = 0; n < 2; ++n) _Pragma("unroll") for (int k = 0; k < 2; ++k) dst[n][k] = *(const PG8_LAS bf16x8*)(lds + PG8_SB(b, h) + boff + n * 2048 + k * 1024); } while (0)
#define PG8_MMA(ai, bj, At, Bt) do { __builtin_amdgcn_s_setprio(1); _Pragma("unroll") for (int m = 0; m < 4; ++m) _Pragma("unroll") for (int n = 0; n < 2; ++n) _Pragma("unroll") for (int k = 0; k < 2; ++k) \
        acc[ai][bj][m][n] = __builtin_amdgcn_mfma_f32_16x16x32_bf16(Bt[n][k], At[m][k], acc[ai][bj][m][n], 0, 0, 0); __builtin_amdgcn_s_setprio(0); } while (0)
#define PG8_WAIT_V(n) asm volatile("s_waitcnt vmcnt(" #n ")" ::: "memory")
#define PG8_WAIT_L(n) asm volatile("s_waitcnt lgkmcnt(" #n ")" ::: "memory")
#define PG8_BAR __builtin_amdgcn_s_barrier()
#define PG8_SCHED __builtin_amdgcn_sched_barrier(0)
    Unit cur, nxt; int ui = 0;
    if (!S.next(0, cur)) return;
    f32x4 acc[2][2][4][2];
#pragma unroll
    for (int a = 0; a < 2; ++a)
#pragma unroll
        for (int b = 0; b < 2; ++b)
#pragma unroll
            for (int m = 0; m < 4; ++m)
#pragma unroll
                for (int n = 0; n < 2; ++n) acc[a][b][m][n] = (f32x4){0.f, 0.f, 0.f, 0.f};
    bf16x8 At[4][2], B0[2][2], B1[2][2];
    const char* cA = (const char*)g.A + (size_t)cur.pm * tstep; const char* cB = (const char*)g.Bt + (size_t)cur.pn * tstep;
    S.a_ready(cur);
    if constexpr (SP2) {
        PG8_STAGE(PG8_SB(0, 0), cB, voffB); PG8_STAGE(PG8_SB(0, 1), cB + hstep, voffB); PG8_STAGE(PG8_SA(0, 0), cA, voffA); PG8_STAGE(PG8_SA(0, 1), cA + hstep, voffA);
        if (wr == 1) PG8_BAR;
        PG8_WAIT_V(2); PG8_BAR;
        PG8_STAGE(PG8_SB(1, 0), cB + kstep, voffB); PG8_STAGE(PG8_SA(1, 0), cA + kstep, voffA); PG8_STAGE(PG8_SB(1, 1), cB + hstep + kstep, voffB);
        PG8_WAIT_V(6); PG8_BAR;
    } else {
        PG8_STAGE(PG8_SB(0, 0), cB, voffB); PG8_STAGE(PG8_SA(0, 0), cA, voffA); PG8_STAGE(PG8_SB(0, 1), cB + hstep, voffB); PG8_STAGE(PG8_SA(0, 1), cA + hstep, voffA);
        if (wr == 1) PG8_BAR;
        PG8_WAIT_V(4); PG8_BAR;
        PG8_STAGE(PG8_SB(1, 0), cB + kstep, voffB); PG8_STAGE(PG8_SA(1, 0), cA + kstep, voffA); PG8_STAGE(PG8_SB(1, 1), cB + hstep + kstep, voffB);
        PG8_WAIT_V(6); PG8_BAR;
    }
    for (;;) {
        const bool has_next = S.next(ui + 1, nxt);
        const char* nA = has_next ? (const char*)g.A + (size_t)nxt.pm * tstep : cA; const char* nB = has_next ? (const char*)g.Bt + (size_t)nxt.pn * tstep : cB;
        for (int t = 0; t < nt; t += 2) {
            const bool last = (t == nt - 2);
            const char* a1 = cA + (size_t)(t + 1) * kstep;
            const char* a2 = last ? nA : cA + (size_t)(t + 2) * kstep; const char* b2 = last ? nB : cB + (size_t)(t + 2) * kstep;
            const char* a3 = a2 + kstep; const char* b3 = b2 + kstep;
            if (last && has_next) S.a_ready(nxt);
            if constexpr (SP2) {
            PG8_LDB(B0, 0, 0); PG8_LDB(B1, 0, 1); PG8_SCHED; PG8_LDA(At, 0, 0); PG8_STAGE(PG8_SA(1, 1), a1 + hstep, voffA);
            PG8_WAIT_V(8); PG8_WAIT_L(0); PG8_BAR; PG8_MMA(0, 0, At, B0); PG8_MMA(0, 1, At, B1); PG8_BAR; PG8_SCHED;
            PG8_LDA(At, 0, 1); PG8_STAGE(PG8_SB(0, 0), b2, voffB); PG8_STAGE(PG8_SB(0, 1), b2 + hstep, voffB); PG8_STAGE(PG8_SA(0, 0), a2, voffA);
            PG8_WAIT_V(8); PG8_WAIT_L(0); PG8_BAR; PG8_MMA(1, 0, At, B0); PG8_MMA(1, 1, At, B1); PG8_BAR; PG8_SCHED;
            PG8_LDB(B0, 1, 0); PG8_LDB(B1, 1, 1); PG8_SCHED; PG8_LDA(At, 1, 0); PG8_STAGE(PG8_SA(0, 1), a2 + hstep, voffA);
            PG8_WAIT_V(8); PG8_WAIT_L(0); PG8_BAR; PG8_MMA(0, 0, At, B0); PG8_MMA(0, 1, At, B1); PG8_BAR; PG8_SCHED;
            PG8_LDA(At, 1, 1); PG8_STAGE(PG8_SB(1, 0), b3, voffB); PG8_STAGE(PG8_SB(1, 1), b3 + hstep, voffB); PG8_STAGE(PG8_SA(1, 0), a3, voffA);
            PG8_WAIT_V(8); PG8_WAIT_L(0); PG8_BAR; PG8_MMA(1, 0, At, B0); PG8_MMA(1, 1, At, B1); PG8_BAR; PG8_SCHED;
            } else {
            PG8_LDB(B0, 0, 0); PG8_SCHED; PG8_LDA(At, 0, 0); PG8_STAGE(PG8_SA(1, 1), a1 + hstep, voffA);
            PG8_WAIT_L(8); PG8_BAR; PG8_WAIT_L(0); PG8_MMA(0, 0, At, B0); PG8_BAR; PG8_SCHED;
            PG8_LDB(B1, 0, 1); PG8_STAGE(PG8_SB(0, 0), b2, voffB);
            PG8_BAR; PG8_WAIT_L(0); PG8_MMA(0, 1, At, B1); PG8_BAR;
            PG8_LDA(At, 0, 1); PG8_STAGE(PG8_SA(0, 0), a2, voffA);
            PG8_BAR; PG8_WAIT_L(0); PG8_MMA(1, 0, At, B0); PG8_BAR; PG8_SCHED;
            PG8_STAGE(PG8_SB(0, 1), b2 + hstep, voffB);
            PG8_WAIT_V(6); PG8_BAR; PG8_MMA(1, 1, At, B1); PG8_BAR;
            PG8_LDB(B0, 1, 0); PG8_SCHED; PG8_LDA(At, 1, 0); PG8_STAGE(PG8_SA(0, 1), a2 + hstep, voffA);
            PG8_WAIT_L(8); PG8_BAR; PG8_WAIT_L(0); PG8_MMA(0, 0, At, B0); PG8_BAR; PG8_SCHED;
            PG8_LDB(B1, 1, 1); PG8_STAGE(PG8_SB(1, 0), b3, voffB);
            PG8_BAR; PG8_WAIT_L(0); PG8_MMA(0, 1, At, B1); PG8_BAR;
            PG8_LDA(At, 1, 1); PG8_STAGE(PG8_SA(1, 0), a3, voffA);
            PG8_BAR; PG8_WAIT_L(0); PG8_MMA(1, 0, At, B0); PG8_BAR; PG8_SCHED;
            PG8_STAGE(PG8_SB(1, 1), b3 + hstep, voffB);
            PG8_WAIT_V(6); PG8_BAR; PG8_MMA(1, 1, At, B1); PG8_BAR;
            }
        }
        if constexpr (ALIGN_EPI) { if (wr == 0) PG8_BAR; }
        if constexpr (!Epi::AFTER_DRAIN) { E(acc, cur, wr, wc, fr, fq); S.done(cur); }
        if (!has_next) break;
#pragma unroll
        for (int a = 0; a < 2; ++a)
#pragma unroll
            for (int b = 0; b < 2; ++b)
#pragma unroll
                for (int m = 0; m < 4; ++m)
#pragma unroll
                    for (int n = 0; n < 2; ++n) acc[a][b][m][n] = (f32x4){0.f, 0.f, 0.f, 0.f};
        cur = nxt; cA = nA; cB = nB; ++ui;
        if constexpr (ALIGN_EPI) { if (wr == 1) PG8_BAR; }
    }
    PG8_WAIT_V(0);
    if constexpr (!ALIGN_EPI) { if (wr == 0) PG8_BAR; }
    PG8_BAR;
    if constexpr (Epi::AFTER_DRAIN) { E.fused(acc, cur, wr, wc, fr, fq, lds, wid, lane); S.done(cur); }
#undef PG8_SA
#undef PG8_SB
#undef PG8_STAGE
#undef PG8_LDA
#undef PG8_LDB
#undef PG8_MMA
#undef PG8_WAIT_V
#undef PG8_WAIT_L
#undef PG8_BAR
#undef PG8_SCHED
}
}
#define LAS __attribute__((address_space(3)))
#define XB_TMO      128
#define XB_XCNT(j)  (256  + 64 * (j))
#define XB_XSUB(j)  (1280 + 64 * (j))
#define XB_XGEN(j)  (2304 + 64 * (j))
#define XB_TOP      3328
#define XB_TOPGEN   3392
#define XCD_BAR_WORDS 3456
#define XB_SPIN_CAP (1u << 18)

__device__ __forceinline__ unsigned xb_ld(unsigned* p)              { return __hip_atomic_load(p, __ATOMIC_RELAXED, __HIP_MEMORY_SCOPE_AGENT); }
__device__ __forceinline__ unsigned xb_add(unsigned* p, unsigned v) { return __hip_atomic_fetch_add(p, v, __ATOMIC_RELAXED, __HIP_MEMORY_SCOPE_AGENT); }
__device__ __forceinline__ unsigned xb_xcc_id() { return (unsigned)__builtin_amdgcn_s_getreg((3 << 11) | 20) & 0xFu; }
#define XB_SPIN(cond, bar) do { unsigned _sp = 0; while (cond) { __builtin_amdgcn_s_sleep(1); \
    if ((++_sp & 255u) == 0u) { if (xb_ld(&(bar)[XB_TMO])) break; if (_sp > XB_SPIN_CAP) { atomicAdd(&(bar)[XB_TMO], 1u); break; } } } } while (0)

__device__ __forceinline__ int xb_lane() { int l; asm volatile("v_mbcnt_lo_u32_b32 %0, -1, 0\n\tv_mbcnt_hi_u32_b32 %0, -1, %0" : "=v"(l)); return l; }
struct XcdBarrier {
    bool w0;
    unsigned* bar; unsigned x;
    volatile LAS unsigned* st;
};

__device__ __forceinline__ XcdBarrier xcd_barrier_post(unsigned* bar, volatile LAS unsigned* st, bool w0) {
    XcdBarrier b; b.w0 = w0; b.bar = bar; b.x = xb_xcc_id(); b.st = st;
    if (b.w0 && xb_lane() == 0) (void)xb_add(&bar[XB_XCNT(b.x)], 1u);
    return b;
}
__device__ __forceinline__ void xcd_barrier_complete(unsigned* bar, unsigned x, unsigned& nloc, unsigned& nx) {
    const unsigned G = gridDim.x * gridDim.y * gridDim.z;
    unsigned sum, cnt, mine, sp = 0u;
    for (;;) {
        sum = 0u; cnt = 0u; mine = 0u;
#pragma unroll
        for (unsigned j = 0; j < 16; ++j) { const unsigned c = xb_ld(&bar[XB_XCNT(j)]); sum += c; cnt += (c > 0u) ? 1u : 0u; mine = (j == x) ? c : mine; }
        if (sum == G) break;
        __builtin_amdgcn_s_sleep(1);
        if ((++sp & 255u) == 0u) { if (xb_ld(&bar[XB_TMO])) break; if (sp > XB_SPIN_CAP) { atomicAdd(&bar[XB_TMO], 1u); break; } }
    }
    nloc = mine > 0u ? mine : 1u; nx = cnt > 0u ? cnt : 1u;
}

__device__ __forceinline__ void xcd_barrier(const XcdBarrier& b) {
    asm volatile("s_waitcnt vmcnt(0)" ::: "memory");
    __syncthreads();
    if (b.w0 && xb_lane() == 0) {
        unsigned* bar = b.bar;
        __builtin_amdgcn_s_waitcnt(0);
        unsigned nloc = b.st[0], nx = b.st[1];
        if (nloc == 0u) { xcd_barrier_complete(bar, b.x, nloc, nx); b.st[0] = nloc; b.st[1] = nx; }
        const unsigned old = xb_add(&bar[XB_XSUB(b.x)], 1u);
        const unsigned gen = old / nloc;
        if (old + 1u == (gen + 1u) * nloc) {
            __builtin_amdgcn_fence(__ATOMIC_RELEASE, "agent");
            asm volatile("s_waitcnt vmcnt(0)" ::: "memory");
            const unsigned og = xb_add(&bar[XB_TOP], 1u);
            const unsigned tg = og / nx;
            if (og + 1u == (tg + 1u) * nx) xb_add(&bar[XB_TOPGEN], 1u);
            else XB_SPIN(xb_ld(&bar[XB_TOPGEN]) == tg, bar);
            __builtin_amdgcn_fence(__ATOMIC_ACQUIRE, "agent");
            xb_add(&bar[XB_XGEN(b.x)], 1u);
            asm volatile("s_waitcnt vmcnt(0)" ::: "memory");
        } else {
            XB_SPIN(xb_ld(&bar[XB_XGEN(b.x)]) == gen, bar);
            __builtin_amdgcn_fence(__ATOMIC_ACQUIRE, "agent");
            asm volatile("s_waitcnt vmcnt(0)" ::: "memory");
        }
    }
    __syncthreads();
}
#define GAS __attribute__((address_space(1)))
#ifndef LAS
#define LAS __attribute__((address_space(3)))
#endif
typedef unsigned short bf16;
typedef unsigned v4u __attribute__((ext_vector_type(4)));
typedef unsigned v2u __attribute__((ext_vector_type(2)));
typedef float f32x4 __attribute__((ext_vector_type(4)));
typedef float f32x2 __attribute__((ext_vector_type(2)));
typedef float f32x16 __attribute__((ext_vector_type(16)));
typedef short bf16x8 __attribute__((ext_vector_type(8)));
typedef __bf16 bf2_t __attribute__((ext_vector_type(2)));

constexpr int NWAVES = 8, NTHR = 512;
constexpr int NB = 4, SEQ = 8192, NTOK = NB * SEQ, DM = 1024, MEML = 256, NMEM = NB * MEML;
constexpr int EVW = 2304;
constexpr int C_CQ = 0, C_KA = 256, C_VA = 384, C_KI = 512, C_QB = 576, C_KB = 1088, C_VB = 1600, C_WI = 2112;
constexpr int NEXP = 32, TOPK = 4;
constexpr int NROWS_MAX = NTOK * TOPK + NEXP * 256;
constexpr int NRT_MAX = NROWS_MAX / 256;
constexpr float LN_EPS = 1e-5f;
constexpr float DN_ALPHA = 1.4142135623730951f;
constexpr int SCH = 64, NCHUNK = SEQ / SCH;

constexpr size_t MiB = 1u << 20;
constexpr size_t WS_CTL = 0, CTL_ZERO_BYTES = 1 * MiB;
constexpr size_t WS_ROPE = 1 * MiB;
constexpr size_t WS_APOW = 2 * MiB;
constexpr size_t WS_BB = 5 * MiB;
constexpr size_t WS_WTQ = 6 * MiB;
constexpr size_t WS_WTIN0 = 8 * MiB;
constexpr size_t WS_WTOUT0 = 13 * MiB;
constexpr size_t WS_WTS5IN = 15 * MiB;
constexpr size_t WS_WTS5OUT = 17 * MiB;
constexpr size_t WS_WTXQ = 21 * MiB;
constexpr size_t WS_WTXK = 25 * MiB;
constexpr size_t WS_WTXV = 29 * MiB;
constexpr size_t WS_WTXO = 33 * MiB;
constexpr size_t WS_MEMB = 37 * MiB;
constexpr size_t WS_KX = 39 * MiB;
constexpr size_t WS_VXT = 43 * MiB;
constexpr size_t WS_W1 = 47 * MiB;
constexpr size_t WS_W3 = 63 * MiB;
constexpr size_t WS_KT = 79 * MiB;
constexpr size_t WS_ELOC = 81 * MiB;
constexpr size_t WS_HS = 97 * MiB;
constexpr size_t WS_KI = 105 * MiB;
constexpr size_t WS_KA = 109 * MiB;
constexpr size_t WS_VA = 117 * MiB;
constexpr size_t WS_WI = 125 * MiB;
constexpr size_t WS_TOKE = 126 * MiB;
constexpr size_t WS_TOKP = 127 * MiB;
constexpr size_t WS_WTGU = 128 * MiB;
constexpr size_t WS_WTDN = 384 * MiB;
constexpr size_t WS_XB = 512 * MiB;
constexpr size_t WS_HF = 576 * MiB;
constexpr size_t WS_T = 704 * MiB;
constexpr size_t WS_SCR = 832 * MiB;
constexpr size_t WS_P1 = WS_SCR;
constexpr size_t WS_CQ = WS_SCR + 144 * MiB;
constexpr size_t WS_QAI = WS_SCR + 160 * MiB;
constexpr size_t WS_OAB = WS_SCR + 224 * MiB;
constexpr size_t WS_QX = WS_SCR;
constexpr size_t WS_AX = WS_SCR + 64 * MiB;
constexpr size_t WS_ELIST = WS_SCR + 128 * MiB;
constexpr size_t WS_EGATE = WS_SCR + 132 * MiB;
constexpr size_t WS_RGATE = WS_SCR + 136 * MiB;
constexpr size_t WS_XG = WS_SCR + 144 * MiB;
constexpr size_t WS_ACT = WS_SCR + 416 * MiB;
constexpr size_t WS_U = WS_SCR;
constexpr size_t WS_YG = WS_SCR + 64 * MiB;
constexpr size_t WS_END = WS_SCR + 688 * MiB;
static_assert(WS_END <= (size_t)2047 * MiB, "workspace map");

constexpr int CW_BAR = 4096;
constexpr int CW_CNT = 16384;

constexpr int RING_BYTES = 131072;
constexpr int UP_OFF = RING_BYTES;
constexpr int UP_MISC = UP_OFF;
constexpr int UP_PTR = UP_OFF + 256;
constexpr int UP_SEL = UP_OFF + 1024;
constexpr int UP_TILEE = UP_OFF + 6144;
constexpr int UP_TSTART = UP_TILEE + 576 * 4;
constexpr int UP_CNT = UP_TSTART + 64 * 4;
constexpr int LDS_BYTES = 147456;
static_assert(UP_CNT + 32 * 4 <= LDS_BYTES, "LDS map");

#define LDS_WAIT() asm volatile("s_waitcnt lgkmcnt(0)" ::: "memory")
#define VM_WAIT() asm volatile("s_waitcnt vmcnt(0)" ::: "memory")
__device__ __forceinline__ unsigned f2bf(float f) { unsigned u = __builtin_bit_cast(unsigned, f); return (u + 0x7fffu + ((u >> 16) & 1u)) >> 16; }
__device__ __forceinline__ unsigned pk2(float lo, float hi) { return f2bf(lo) | (f2bf(hi) << 16); }
__device__ __forceinline__ float bflo(unsigned w) { return __builtin_bit_cast(float, w << 16); }
__device__ __forceinline__ float bfhi(unsigned w) { return __builtin_bit_cast(float, w & 0xffff0000u); }
__device__ __forceinline__ float bf2f(bf16 h) { return __builtin_bit_cast(float, (unsigned)h << 16); }
__device__ __forceinline__ float dot2bf(unsigned a, unsigned b, float c) { return __builtin_amdgcn_fdot2_f32_bf16(__builtin_bit_cast(bf2_t, a), __builtin_bit_cast(bf2_t, b), c, false); }
__device__ __forceinline__ float dot8bf(v4u a, v4u b, float c) { c = dot2bf(a.x, b.x, c); c = dot2bf(a.y, b.y, c); c = dot2bf(a.z, b.z, c); return dot2bf(a.w, b.w, c); }
__device__ __forceinline__ float shx(float v, int o, int lane) { return __builtin_bit_cast(float, __builtin_amdgcn_ds_bpermute((lane ^ o) << 2, __builtin_bit_cast(int, v))); }
__device__ __forceinline__ int shxi(int v, int o, int lane) { return __builtin_amdgcn_ds_bpermute((lane ^ o) << 2, v); }
__device__ __forceinline__ float wave_sum(float v, int lane) {
#pragma unroll
    for (int o = 1; o < 64; o <<= 1) v += shx(v, o, lane);
    return v;
}
__device__ __forceinline__ float wave_max(float v, int lane) {
#pragma unroll
    for (int o = 1; o < 64; o <<= 1) v = fmaxf(v, shx(v, o, lane));
    return v;
}
__device__ __forceinline__ int wave_sum_i(int v, int lane) {
#pragma unroll
    for (int o = 1; o < 64; o <<= 1) v += shxi(v, o, lane);
    return v;
}
__device__ __forceinline__ int crow(int r, int hf) { return (r & 3) + 8 * (r >> 2) + 4 * hf; }
__device__ __forceinline__ int rperm(int j) { return j < 16 ? ((j & 1) ? 8 + (j >> 1) : (j >> 1)) : j; }

struct Frame {
    LAS unsigned char* lds;
    int tid, lane, wave, vcu, G;
    float* out;
    unsigned char* ws;
};
__device__ __forceinline__ Frame pframe(const Frame& F) {
    Frame P = F;
    { int l; asm volatile("v_mbcnt_lo_u32_b32 %0, -1, 0\n\tv_mbcnt_hi_u32_b32 %0, -1, %0" : "=v"(l)); P.tid = P.wave * 64 + l; }
    asm volatile("" : "+s"(P.ws), "+s"(P.out), "+v"(P.tid), "+s"(P.vcu), "+s"(P.G));
    P.lane = P.tid & 63;
    return P;
}
__device__ __forceinline__ const float* inp(const Frame& F, int i) {
    const unsigned long long p = *(const LAS unsigned long long*)(F.lds + UP_PTR + 8 * i);
    const unsigned lo = (unsigned)__builtin_amdgcn_readfirstlane((int)(unsigned)p), hi = (unsigned)__builtin_amdgcn_readfirstlane((int)(unsigned)(p >> 32));
    return (const float*)(((unsigned long long)hi << 32) | lo);
}
template <class T> __device__ __forceinline__ T* wsp(const Frame& F, size_t off) { return (T*)(F.ws + off); }

namespace pg8 {
struct EpiRope {
    static constexpr bool PERM = true, AFTER_DRAIN = false;
    bf16_t* O; int ldc; const f32x2* rope;
    __device__ __forceinline__ void operator()(const f32x4 (&acc)[2][2][4][2], const Unit& u, int wr, int wc, int fr, int fq) const {
        const int row0 = u.pm * BM + wr * 64 + fr; const int col0 = u.pn * BM + wc * 32 + 8 * fq;
#pragma unroll
        for (int ai = 0; ai < 2; ++ai)
#pragma unroll
            for (int m = 0; m < 4; ++m) { const int row = row0 + ai * HALF + m * 16; const int pos = row & (SEQ - 1); bf16_t* rowp = O + (size_t)row * ldc + col0;
#pragma unroll
                for (int bj = 0; bj < 2; ++bj) { f32x4 v0 = acc[ai][bj][m][0], v1 = acc[ai][bj][m][1];
                    const int c64 = (col0 + bj * HALF) & 63;
                    if (c64 < 16) { const f32x2* rp = rope + pos * 8 + (c64 >> 1);
                        const f32x2 r0 = rp[0], r1 = rp[1], r2 = rp[2], r3 = rp[3];
                        f32x4 w0, w1;
                        w0[0] = v0[0] * r0.x - v0[1] * r0.y; w0[1] = v0[1] * r0.x + v0[0] * r0.y;
                        w0[2] = v0[2] * r1.x - v0[3] * r1.y; w0[3] = v0[3] * r1.x + v0[2] * r1.y;
                        w1[0] = v1[0] * r2.x - v1[1] * r2.y; w1[1] = v1[1] * r2.x + v1[0] * r2.y;
                        w1[2] = v1[2] * r3.x - v1[3] * r3.y; w1[3] = v1[3] * r3.x + v1[2] * r3.y;
                        v0 = w0; v1 = w1; }
                    u32x4 w; w.x = cvt_pk_bf16(v0[0], v0[1]); w.y = cvt_pk_bf16(v0[2], v0[3]); w.z = cvt_pk_bf16(v1[0], v1[1]); w.w = cvt_pk_bf16(v1[2], v1[3]);
                    *(u32x4*)(rowp + bj * HALF) = w; } }
    }
};
struct EpiResF32 {
    static constexpr bool PERM = false, AFTER_DRAIN = false;
    const float* R; float* T; int ldc; float alpha;
    __device__ __forceinline__ void operator()(const f32x4 (&acc)[2][2][4][2], const Unit& u, int wr, int wc, int fr, int fq) const {
        const int row0 = u.pm * BM + wr * 64 + fr; const int col0 = u.pn * BM + wc * 32 + 4 * fq;
#pragma unroll
        for (int ai = 0; ai < 2; ++ai)
#pragma unroll
            for (int m = 0; m < 4; ++m) { const size_t off = (size_t)(row0 + ai * HALF + m * 16) * ldc + col0;
#pragma unroll
                for (int bj = 0; bj < 2; ++bj)
#pragma unroll
                    for (int n = 0; n < 2; ++n) { const f32x4 r = *(const f32x4*)(R + off + bj * HALF + n * 16); *(f32x4*)(T + off + bj * HALF + n * 16) = r * alpha + acc[ai][bj][m][n]; } }
    }
};
struct EpiGluRes {
    static constexpr bool PERM = false, AFTER_DRAIN = false;
    const float* R; float* T; int ldc; float alpha;
    __device__ __forceinline__ void operator()(const f32x4 (&acc)[2][2][4][2], const Unit& u, int wr, int wc, int fr, int fq) const {
        const int row0 = u.pm * BM + wr * 64 + fr; const int col0 = u.pn * HALF + wc * 32 + 4 * fq;
#pragma unroll
        for (int ai = 0; ai < 2; ++ai)
#pragma unroll
            for (int m = 0; m < 4; ++m) { const size_t off = (size_t)(row0 + ai * HALF + m * 16) * ldc + col0;
#pragma unroll
                for (int n = 0; n < 2; ++n) { const f32x4 r = *(const f32x4*)(R + off + n * 16); const f32x4 v = acc[ai][0][m][n], g = acc[ai][1][m][n]; f32x4 o;
#pragma unroll
                    for (int i = 0; i < 4; ++i) o[i] = r[i] * alpha + v[i] * __builtin_amdgcn_rcpf(1.0f + __expf(-g[i]));
                    *(f32x4*)(T + off + n * 16) = o; } }
    }
};
struct EpiSwiGlu {
    static constexpr bool PERM = true, AFTER_DRAIN = false;
    bf16_t* O; const float* bgu;
    __device__ __forceinline__ void operator()(const f32x4 (&acc)[2][2][4][2], const Unit& u, int wr, int wc, int fr, int fq) const {
        const int e = u.pn >> 3, ct = u.pn & 7; const int row0 = u.pm * BM + wr * 64 + fr; const int col0 = ct * HALF + wc * 32 + 8 * fq;
        const float* bg = bgu + (size_t)e * 2048 + col0; const float* bu = bg + 1024;
        f32x4 g0 = *(const f32x4*)bg, g1 = *(const f32x4*)(bg + 4), u0 = *(const f32x4*)bu, u1 = *(const f32x4*)(bu + 4);
#pragma unroll
        for (int ai = 0; ai < 2; ++ai)
#pragma unroll
            for (int m = 0; m < 4; ++m) { bf16_t* rowp = O + (size_t)(row0 + ai * HALF + m * 16) * 1024 + col0;
                f32x4 a0 = acc[ai][0][m][0] + g0, a1 = acc[ai][0][m][1] + g1, b0 = acc[ai][1][m][0] + u0, b1 = acc[ai][1][m][1] + u1; float o[8];
#pragma unroll
                for (int i = 0; i < 4; ++i) { float g = fminf(a0[i], 7.0f), up = fminf(fmaxf(b0[i], -7.0f), 7.0f); o[i] = g * __builtin_amdgcn_rcpf(1.0f + __expf(-1.702f * g)) * (up + 1.0f);
                    g = fminf(a1[i], 7.0f); up = fminf(fmaxf(b1[i], -7.0f), 7.0f); o[4 + i] = g * __builtin_amdgcn_rcpf(1.0f + __expf(-1.702f * g)) * (up + 1.0f); }
                u32x4 w; w.x = cvt_pk_bf16(o[0], o[1]); w.y = cvt_pk_bf16(o[2], o[3]); w.z = cvt_pk_bf16(o[4], o[5]); w.w = cvt_pk_bf16(o[6], o[7]);
                *(u32x4*)rowp = w; }
    }
};
struct EpiDown {
    static constexpr bool PERM = true, AFTER_DRAIN = false;
    bf16_t* O; const float* bdn; const float* rgate;
    __device__ __forceinline__ void operator()(const f32x4 (&acc)[2][2][4][2], const Unit& u, int wr, int wc, int fr, int fq) const {
        const int e = u.pn >> 2, ct = u.pn & 3; const int row0 = u.pm * BM + wr * 64 + fr; const int col0 = ct * BM + wc * 32 + 8 * fq;
        const float* bp = bdn + (size_t)e * 1024 + col0;
        f32x4 bv[2][2];
#pragma unroll
        for (int bj = 0; bj < 2; ++bj)
#pragma unroll
            for (int n = 0; n < 2; ++n) bv[bj][n] = *(const f32x4*)(bp + bj * HALF + 4 * n);
#pragma unroll
        for (int ai = 0; ai < 2; ++ai)
#pragma unroll
            for (int m = 0; m < 4; ++m) { const int row = row0 + ai * HALF + m * 16; const float gt = rgate[row]; bf16_t* rowp = O + (size_t)row * 1024 + col0;
#pragma unroll
                for (int bj = 0; bj < 2; ++bj) { const f32x4 v0 = (acc[ai][bj][m][0] + bv[bj][0]) * gt, v1 = (acc[ai][bj][m][1] + bv[bj][1]) * gt;
                    u32x4 w; w.x = cvt_pk_bf16(v0[0], v0[1]); w.y = cvt_pk_bf16(v0[2], v0[3]); w.z = cvt_pk_bf16(v1[0], v1[1]); w.w = cvt_pk_bf16(v1[2], v1[3]);
                    *(u32x4*)(rowp + bj * HALF) = w; } }
    }
};
template <int NCT> struct MoeOrder {
    const PG8_LAS int* tile_e; int nrt, G, vc;
    __device__ __forceinline__ bool next(int i, Unit& u) const {
        const int L = i * G + vc; const int rt = L / NCT, ct = L % NCT; if (rt >= nrt) return false;
        u.pm = rt; u.pn = __builtin_amdgcn_readfirstlane(tile_e[rt]) * NCT + ct; return true;
    }
    __device__ __forceinline__ void a_ready(const Unit&) const {}
    __device__ __forceinline__ void done(const Unit&) const {}
};
}
__device__ __forceinline__ int map_col(int id, int r) {
    switch (id) {
    default: return r;
    case 1: {
        if (r < 256) return r;
        if (r < 384) { const int q = r - 256; return 256 + (q & ~63) + rperm(q & 63); }
        if (r < 576) return r;
        if (r < 1088) return 584 + (r - 576);
        if (r < 1600) return 1096 + (r - 1088);
        if (r < 2112) return 1608 + (r - 1600);
        if (r < 2120) return 576 + (r - 2112);
        return -1; }
    case 2: return (r & ~63) + rperm(r & 63);
    case 3: { const int t = r >> 8, w = r & 255; return w < 128 ? 128 * t + w : 1024 + 128 * t + (w - 128); }
    case 4: return 1024 + r;
    }
}
__device__ __forceinline__ void tr_item(const float* W, int K, int Nsrc, bf16* WT, LAS float* scr, int kb, int nb, int lane, int mapid, float scale) {
    const int k0 = 64 * kb, n0 = 32 * nb;
    const int sc = map_col(mapid, n0 + (lane & 31));
#pragma unroll 8
    for (int i = 0; i < 32; ++i) { const int kk = 2 * i + (lane >> 5); scr[kk * 33 + (lane & 31)] = (sc >= 0) ? W[(size_t)(k0 + kk) * Nsrc + sc] * scale : 0.f; }
    LDS_WAIT(); asm volatile("" ::: "memory");
    const int c = lane & 7;
#pragma unroll
    for (int j = 0; j < 4; ++j) { const int n = (lane >> 3) + 8 * j; const LAS float* s = scr + (8 * c) * 33 + n;
        v4u o; o.x = pk2(s[0 * 33], s[1 * 33]); o.y = pk2(s[2 * 33], s[3 * 33]); o.z = pk2(s[4 * 33], s[5 * 33]); o.w = pk2(s[6 * 33], s[7 * 33]);
        *(v4u*)(WT + (size_t)(n0 + n) * K + k0 + 8 * c) = o; }
    LDS_WAIT(); asm volatile("" ::: "memory");
}
struct TrJob { const float* src; bf16* dst; int K, Nsrc, Ndst, batch, mapid; float scale; };
__device__ __forceinline__ TrJob tr_job(const Frame& F, int j) {
    TrJob t; t.batch = 1; t.mapid = 0; t.scale = 1.f; t.K = 1024; t.Nsrc = 1024; t.Ndst = 1024;
    switch (j) {
    case 0: t.src = inp(F, 2); t.dst = wsp<bf16>(F, WS_WTIN0); t.Nsrc = 2120; t.Ndst = EVW; t.mapid = 1; break;
    case 1: t.src = inp(F, 4); t.dst = wsp<bf16>(F, WS_WTQ); t.K = 256; t.Nsrc = 512; t.Ndst = 512; t.mapid = 2; break;
    case 2: t.src = inp(F, 5); t.dst = wsp<bf16>(F, WS_WTQ) + 512 * 256; t.K = 256; t.Nsrc = 512; t.Ndst = 512; t.mapid = 2; t.scale = 0.125f; break;
    case 3: t.src = inp(F, 8); t.dst = wsp<bf16>(F, WS_WTOUT0); break;
    case 4: t.src = inp(F, 9); t.dst = wsp<bf16>(F, WS_WTS5IN); break;
    case 5: t.src = inp(F, 18); t.dst = wsp<bf16>(F, WS_WTS5OUT); t.Nsrc = 2048; t.Ndst = 2048; t.mapid = 3; break;
    case 6: t.src = inp(F, 21); t.dst = wsp<bf16>(F, WS_WTXQ); t.batch = 2; t.scale = 0.0625f; break;
    case 7: t.src = inp(F, 22); t.dst = wsp<bf16>(F, WS_WTXK); t.Nsrc = 2048; t.batch = 2; break;
    case 8: t.src = inp(F, 22); t.dst = wsp<bf16>(F, WS_WTXV); t.Nsrc = 2048; t.batch = 2; t.mapid = 4; break;
    case 9: t.src = inp(F, 23); t.dst = wsp<bf16>(F, WS_WTXO); t.batch = 2; break;
    case 10: t.src = inp(F, 28); t.dst = wsp<bf16>(F, WS_WTGU); t.Nsrc = 2048; t.Ndst = 2048; t.mapid = 3; t.batch = 64; break;
    default: t.src = inp(F, 30); t.dst = wsp<bf16>(F, WS_WTDN); t.batch = 64; break;
    }
    return t;
}
__device__ __forceinline__ void p0_prologue(const Frame& F) {
    LAS float* scr = (LAS float*)(F.lds + F.wave * 16384);
    const int gw = F.vcu * NWAVES + F.wave, NGW = F.G * NWAVES;
    for (int j = 11; j >= 0; --j) {
        const TrJob t = tr_job(F, j);
        const int nkb = t.K / 64, nnb = t.Ndst / 32, per = nkb * nnb, total = per * t.batch;
        for (int it = gw; it < total; it += NGW) {
            const int bi = it / per, r = it - bi * per, kb = r / nnb, nb = r - kb * nnb;
            tr_item(t.src + (size_t)bi * t.K * t.Nsrc, t.K, t.Nsrc, t.dst + (size_t)bi * t.Ndst * t.K, scr, kb, nb, F.lane, t.mapid, t.scale);
        }
    }
    const int gt = F.vcu * NTHR + F.tid, NGT = F.G * NTHR;
    { const float* x = inp(F, 0); bf16* xb = wsp<bf16>(F, WS_XB);
      for (int i = gt; i < NTOK * DM / 8; i += NGT) { const f32x4 a = *(const f32x4*)(x + (size_t)i * 8), b = *(const f32x4*)(x + (size_t)i * 8 + 4);
          v4u o; o.x = pk2(a[0], a[1]); o.y = pk2(a[2], a[3]); o.z = pk2(b[0], b[1]); o.w = pk2(b[2], b[3]); *(v4u*)(xb + (size_t)i * 8) = o; }
      const float* mm = inp(F, 1); bf16* mb = wsp<bf16>(F, WS_MEMB);
      for (int i = gt; i < NMEM * DM / 8; i += NGT) { const f32x4 a = *(const f32x4*)(mm + (size_t)i * 8), b = *(const f32x4*)(mm + (size_t)i * 8 + 4);
          v4u o; o.x = pk2(a[0], a[1]); o.y = pk2(a[2], a[3]); o.z = pk2(b[0], b[1]); o.w = pk2(b[2], b[3]); *(v4u*)(mb + (size_t)i * 8) = o; } }
    { f32x2* rope = wsp<f32x2>(F, WS_ROPE);
      for (int i = gt; i < SEQ * 8; i += NGT) { const int pos = i >> 3, k = i & 7; const float inv = (float)pow(500000.0, -(double)k / 8.0); const float ang = (float)pos * inv;
          rope[i] = (f32x2){(float)cos((double)ang), (float)sin((double)ang)}; } }
    { const float* log_dt = inp(F, 10); const float* lre = inp(F, 11); const float* lim = inp(F, 12); const float* bre = inp(F, 13); const float* bim = inp(F, 14);
      f32x2* apow = wsp<f32x2>(F, WS_APOW); f32x2* bb = wsp<f32x2>(F, WS_BB);
      for (int i = gt; i < 64 * 64 * 65; i += NGT) { const int gp = i / 65, k = i - gp * 65, g = gp >> 6;
          const double dt = exp((double)log_dt[g]), lr = lre[gp], li = lim[gp]; const double mag = exp(lr * dt * k), ang = li * dt * k;
          apow[i] = (f32x2){(float)(mag * cos(ang)), (float)(mag * sin(ang))}; }
      for (int i = gt; i < 64 * 64 * 16; i += NGT) { const int gp = i >> 4, g = gp >> 6;
          const double dt = exp((double)log_dt[g]), lr = lre[gp], li = lim[gp]; const double mag = exp(lr * dt), ar = mag * cos(li * dt), ai = mag * sin(li * dt);
          const double den = lr * lr + li * li, cr = ((ar - 1.0) * lr + ai * li) / den, ci = (ai * lr - (ar - 1.0) * li) / den; const double br = bre[i], bi = bim[i];
          bb[i] = (f32x2){(float)(cr * br - ci * bi), (float)(cr * bi + ci * br)}; } }
}

__device__ __forceinline__ void ln_row_store(const Frame& F, f32x4 (&v)[4], const float* g, const float* b, float* dstF, bf16* dstB) {
    float s = 0.f;
#pragma unroll
    for (int j = 0; j < 4; ++j) s += (v[j][0] + v[j][1]) + (v[j][2] + v[j][3]);
    const float mean = wave_sum(s, F.lane) * (1.f / DM); float s2 = 0.f;
#pragma unroll
    for (int j = 0; j < 4; ++j) { v[j] = v[j] - mean; s2 += (v[j][0] * v[j][0] + v[j][1] * v[j][1]) + (v[j][2] * v[j][2] + v[j][3] * v[j][3]); }
    const float rstd = 1.f / sqrtf(wave_sum(s2, F.lane) * (1.f / DM) + LN_EPS);
#pragma unroll
    for (int j = 0; j < 4; ++j) { const int c = 4 * F.lane + 256 * j; const f32x4 gg = *(const f32x4*)(g + c), bv = *(const f32x4*)(b + c);
        const f32x4 o = v[j] * rstd * gg + bv; *(f32x4*)(dstF + c) = o;
        v2u w; w.x = pk2(o[0], o[1]); w.y = pk2(o[2], o[3]); *(v2u*)(dstB + c) = w; }
}
__device__ __forceinline__ void ln_phase(const Frame& F, const float* T, const float* g, const float* b, float* dstF, bf16* dstB) {
    const int gw = F.vcu * NWAVES + F.wave, NGW = F.G * NWAVES;
    for (int m = gw; m < NTOK; m += NGW) { f32x4 v[4];
#pragma unroll
        for (int j = 0; j < 4; ++j) v[j] = *(const f32x4*)(T + (size_t)m * DM + 4 * F.lane + 256 * j);
        ln_row_store(F, v, g, b, dstF + (size_t)m * DM, dstB + (size_t)m * DM); }
}

__device__ __forceinline__ void p2_postproc(const Frame& F) {
    const int gw = F.vcu * NWAVES + F.wave, NGW = F.G * NWAVES, lane = F.lane;
    const bf16* P1 = wsp<bf16>(F, WS_P1); bf16* CQ = wsp<bf16>(F, WS_CQ); bf16* KI = wsp<bf16>(F, WS_KI); bf16* KA = wsp<bf16>(F, WS_KA); bf16* VA = wsp<bf16>(F, WS_VA);
    float* WI = wsp<float>(F, WS_WI); const f32x2* rope = wsp<f32x2>(F, WS_ROPE);
    const float* qg = inp(F, 3); const float* kg = inp(F, 6); const float* kb = inp(F, 7);
    const f32x4 qg4 = *(const f32x4*)(qg + 4 * lane); const float kgl = kg[lane], kbl = kb[lane];
    for (int tok = gw; tok < NTOK; tok += NGW) {
        const bf16* row = P1 + (size_t)tok * EVW; const int pos = tok & (SEQ - 1);
        { const v2u w = *(const v2u*)(row + C_CQ + 4 * lane); float v0 = bflo(w.x), v1 = bfhi(w.x), v2 = bflo(w.y), v3 = bfhi(w.y);
          const float ss = wave_sum(v0 * v0 + v1 * v1 + v2 * v2 + v3 * v3, lane); const float rs = 1.f / sqrtf(ss * (1.f / 256.f) + LN_EPS);
          v2u o; o.x = pk2(v0 * rs * qg4[0], v1 * rs * qg4[1]); o.y = pk2(v2 * rs * qg4[2], v3 * rs * qg4[3]); *(v2u*)(CQ + (size_t)tok * 256 + 4 * lane) = o; }
        { const float v = bf2f(row[C_KI + lane]); const float mean = wave_sum(v, lane) * (1.f / 64.f); const float d = v - mean; const float var = wave_sum(d * d, lane) * (1.f / 64.f);
          const float y = d * (1.f / sqrtf(var + LN_EPS)) * kgl + kbl; const float partner = shx(y, 8, lane);
          float o = y; int dst = lane;
          if (lane < 16) { const int i = lane & 7; const f32x2 cs = rope[pos * 8 + i];
              if (lane < 8) { o = y * cs.x - partner * cs.y; dst = 2 * lane; } else { o = y * cs.x + partner * cs.y; dst = 2 * (lane - 8) + 1; } }
          KI[(size_t)tok * 64 + dst] = (bf16)f2bf(o); }
        { const unsigned w = *(const unsigned*)(row + C_KA + 2 * lane); float t1 = bflo(w), t2 = bfhi(w); const int j = (2 * lane) & 63;
          if (j < 16) { const f32x2 cs = rope[pos * 8 + (j >> 1)]; const float a = t1 * cs.x - t2 * cs.y, b = t2 * cs.x + t1 * cs.y; t1 = a; t2 = b; }
          *(unsigned*)(KA + (size_t)tok * 128 + 2 * lane) = pk2(t1, t2);
          *(unsigned*)(VA + (size_t)tok * 128 + 2 * lane) = *(const unsigned*)(row + C_VA + 2 * lane); }
        if (lane < 8) WI[(size_t)tok * 8 + lane] = bf2f(row[C_WI + lane]) * 0.35355339059327373f;
    }
    const int gt = F.vcu * NTHR + F.tid, NGT = F.G * NTHR;
    const f32x2* apow = wsp<f32x2>(F, WS_APOW); const f32x2* bb = wsp<f32x2>(F, WS_BB);
    const float* cre = inp(F, 15); const float* cim = inp(F, 16);
    bf16* W1 = wsp<bf16>(F, WS_W1); bf16* W3 = wsp<bf16>(F, WS_W3); bf16* KT = wsp<bf16>(F, WS_KT);
    for (int i = gt; i < 64 * 128 * 1024 / 8; i += NGT) { const int e0 = i * 8, g = e0 >> 17, rem = e0 & 131071, rp = rem >> 10, k = rem & 1023, ri = rp >> 6, p = rp & 63, s = k >> 4, c0 = k & 15;
        const f32x2 a = apow[(g * 64 + p) * 65 + (63 - s)]; float o[8];
#pragma unroll
        for (int q = 0; q < 8; ++q) { const f32x2 b = bb[(g * 64 + p) * 16 + c0 + q]; o[q] = ri == 0 ? a.x * b.x - a.y * b.y : a.x * b.y + a.y * b.x; }
        v4u w; w.x = pk2(o[0], o[1]); w.y = pk2(o[2], o[3]); w.z = pk2(o[4], o[5]); w.w = pk2(o[6], o[7]); *(v4u*)(W1 + (size_t)e0) = w; }
    for (int i = gt; i < 64 * 1024 * 128 / 8; i += NGT) { const int e0 = i * 8, g = e0 >> 17, rem = e0 & 131071, tc = rem >> 7, k = rem & 127, t = tc >> 4, c = tc & 15, ri = k >> 6, p0 = k & 63; float o[8];
#pragma unroll
        for (int q = 0; q < 8; ++q) { const int p = p0 + q; const f32x2 a = apow[(g * 64 + p) * 65 + (t + 1)]; const float cr = cre[(g * 16 + c) * 64 + p], ci = cim[(g * 16 + c) * 64 + p];
            o[q] = ri == 0 ? cr * a.x - ci * a.y : -(cr * a.y + ci * a.x); }
        v4u w; w.x = pk2(o[0], o[1]); w.y = pk2(o[2], o[3]); w.z = pk2(o[4], o[5]); w.w = pk2(o[6], o[7]); *(v4u*)(W3 + (size_t)e0) = w; }
    for (int i = gt; i < 64 * 64 * 256; i += NGT) { const int g = i >> 14, tau = (i >> 8) & 63, c = (i >> 4) & 15, c2 = i & 15; float acc = 0.f;
        for (int p = 0; p < 64; ++p) { const f32x2 a = apow[(g * 64 + p) * 65 + tau]; const float cr = cre[(g * 16 + c) * 64 + p], ci = cim[(g * 16 + c) * 64 + p]; const f32x2 b = bb[(g * 64 + p) * 16 + c2];
            const float xr = cr * a.x - ci * a.y, xi = cr * a.y + ci * a.x; acc += xr * b.x - xi * b.y; }
        KT[i] = (bf16)f2bf(acc); }
}

__device__ __forceinline__ unsigned rope1(unsigned w, f32x2 cs) { const float t1 = bflo(w), t2 = bfhi(w); return pk2(t1 * cs.x - t2 * cs.y, t2 * cs.x + t1 * cs.y); }
__device__ __forceinline__ bf16x8 rope8(bf16x8 f, const f32x2* cs) { v4u w = __builtin_bit_cast(v4u, f); w.x = rope1(w.x, cs[0]); w.y = rope1(w.y, cs[1]); w.z = rope1(w.z, cs[2]); w.w = rope1(w.w, cs[3]); return __builtin_bit_cast(bf16x8, w); }
__device__ __forceinline__ unsigned f16key(float s) {
    const _Float16 h = (_Float16)s; unsigned u = (unsigned)__builtin_bit_cast(unsigned short, h);
    return (u & 0x8000u) ? (~u & 0xffffu) : (u | 0x8000u);
}
__device__ __forceinline__ int count_ge(const LAS bf16* row, int L, unsigned X, int lane) {
    int cnt = 0;
    for (int c = lane; c < (L >> 3); c += 64) { const v4u w = *(const LAS v4u*)(row + 8 * c);
        cnt += ((w.x & 0xffffu) >= X) + ((w.x >> 16) >= X) + ((w.y & 0xffffu) >= X) + ((w.y >> 16) >= X) + ((w.z & 0xffffu) >= X) + ((w.z >> 16) >= X) + ((w.w & 0xffffu) >= X) + ((w.w >> 16) >= X); }
    return wave_sum_i(cnt, lane);
}
__device__ __forceinline__ void dsa_unit(const Frame& F, int b, int qg) {
    const int lane = F.lane, wave = F.wave, m = lane & 31, hf = lane >> 5;
    const bf16* QAI = wsp<bf16>(F, WS_QAI); const bf16* KI = wsp<bf16>(F, WS_KI); const bf16* KA = wsp<bf16>(F, WS_KA); const bf16* VA = wsp<bf16>(F, WS_VA);
    const float* WI = wsp<float>(F, WS_WI); bf16* OAB = wsp<bf16>(F, WS_OAB); const f32x2* rope = wsp<f32x2>(F, WS_ROPE);
    LAS bf16* SC = (LAS bf16*)F.lds;
    LAS bf16* SEL = (LAS bf16*)(F.lds + UP_SEL);
    const int t0 = qg * 8, nkeys = t0 + 8, ntile = (nkeys + 31) >> 5, L = ntile * 32;
    const size_t tb = (size_t)b * SEQ;
    {
        const int qq = 2 * ((m >> 2) & 1) + (m >> 4), head = (m & 3) + 4 * ((m >> 3) & 1);
        bf16x8 Af[2][4]; float wv[2][2][8];
#pragma unroll
        for (int mt = 0; mt < 2; ++mt) { const bf16* qp = QAI + (tb + t0 + 4 * mt + qq) * 1024 + 512 + head * 64 + 8 * hf;
#pragma unroll
            for (int kk = 0; kk < 4; ++kk) Af[mt][kk] = *(const bf16x8*)(qp + 16 * kk);
            Af[mt][0] = rope8(Af[mt][0], rope + (size_t)(t0 + 4 * mt + qq) * 8 + 4 * hf);
#pragma unroll
            for (int q2 = 0; q2 < 2; ++q2) { const float* wp = WI + (tb + t0 + 4 * mt + 2 * hf + q2) * 8; const f32x4 a = *(const f32x4*)wp, c = *(const f32x4*)(wp + 4);
                wv[mt][q2][0] = a[0]; wv[mt][q2][1] = a[1]; wv[mt][q2][2] = a[2]; wv[mt][q2][3] = a[3]; wv[mt][q2][4] = c[0]; wv[mt][q2][5] = c[1]; wv[mt][q2][6] = c[2]; wv[mt][q2][7] = c[3]; } }
        for (int tile = wave; tile < ntile; tile += NWAVES) {
            const int key = 32 * tile + m; const bf16* kp = KI + (tb + key) * 64 + 8 * hf;
            bf16x8 Bf[4];
#pragma unroll
            for (int kk = 0; kk < 4; ++kk) Bf[kk] = *(const bf16x8*)(kp + 16 * kk);
#pragma unroll
            for (int mt = 0; mt < 2; ++mt) { f32x16 acc;
#pragma unroll
                for (int r = 0; r < 16; ++r) acc[r] = 0.f;
#pragma unroll
                for (int kk = 0; kk < 4; ++kk) acc = __builtin_amdgcn_mfma_f32_32x32x16_bf16(Af[mt][kk], Bf[kk], acc, 0, 0, 0);
#pragma unroll
                for (int q2 = 0; q2 < 2; ++q2) { float s = 0.f;
#pragma unroll
                    for (int h = 0; h < 8; ++h) s += wv[mt][q2][h] * fmaxf(acc[8 * q2 + h], 0.f);
                    const int ql = 4 * mt + 2 * hf + q2;
                    SC[ql * SEQ + key] = (bf16)((key <= t0 + ql) ? f16key(s) : 0u); } }
        }
    }
    __syncthreads();
    const int ql = wave, t = t0 + ql, n = t + 1; int nsel;
    const LAS bf16* row = SC + ql * SEQ; LAS bf16* sel = SEL + ql * 256;
    if (n <= 256) { for (int i = lane; i < n; i += 64) sel[i] = (bf16)i; nsel = n; }
    else {
        unsigned T = 0;
        for (int bit = 15; bit >= 0; --bit) { const unsigned cand = T | (1u << bit); if (count_ge(row, L, cand, lane) >= 256) T = cand; }
        const int cgt = count_ge(row, L, T + 1u, lane), need = 256 - cgt;
        int bgt = 0, beq = 0; const unsigned long long lt = (1ull << lane) - 1ull;
        for (int i0 = 0; i0 < L; i0 += 64) { const int i = i0 + lane; const unsigned k = (i < L) ? (unsigned)row[i] : 0u; const bool gt = k > T, eq = (k == T);
            const unsigned long long mg = __ballot(gt), me = __ballot(eq); const int pg = __popcll(mg & lt), pe = __popcll(me & lt);
            if (gt) sel[bgt + pg] = (bf16)i;
            if (eq && (beq + pe) < need) sel[cgt + beq + pe] = (bf16)i;
            bgt += __popcll(mg); beq += __popcll(me); }
        nsel = 256;
    }
    LDS_WAIT(); asm volatile("" ::: "memory");
    {
        LAS bf16* qs = (LAS bf16*)(F.lds + ql * (SEQ * 2));
        LAS float* P = (LAS float*)(F.lds + ql * (SEQ * 2) + 1024);
        { v4u w = *(const v4u*)(QAI + (tb + t) * 1024 + 8 * lane);
          if ((lane & 7) < 2) w = __builtin_bit_cast(v4u, rope8(__builtin_bit_cast(bf16x8, w), rope + (size_t)t * 8 + 4 * (lane & 7)));
          *(LAS v4u*)(qs + 8 * lane) = w; }
        LDS_WAIT(); asm volatile("" ::: "memory");
#pragma unroll 1
        for (int j = 0; j < 4; ++j) { const int slot = lane + 64 * j; const bool valid = slot < nsel; const int key = valid ? (int)sel[slot] : 0; const bf16* kp = KA + (tb + key) * 128; float lg[8];
#pragma unroll
            for (int g = 0; g < 2; ++g) { v4u kr[8];
#pragma unroll
                for (int c = 0; c < 8; ++c) kr[c] = *(const v4u*)(kp + 64 * g + 8 * c);
#pragma unroll
                for (int hh = 0; hh < 4; ++hh) { const int h = 4 * g + hh; float acc = 0.f;
#pragma unroll
                    for (int c = 0; c < 8; ++c) acc = dot8bf(kr[c], *(const LAS v4u*)(qs + h * 64 + 8 * c), acc);
                    lg[h] = valid ? acc * 0.125f : -INFINITY; }
                asm volatile("" ::: "memory"); }
            *(LAS f32x4*)(P + slot * 8) = (f32x4){lg[0], lg[1], lg[2], lg[3]}; *(LAS f32x4*)(P + slot * 8 + 4) = (f32x4){lg[4], lg[5], lg[6], lg[7]}; }
        LDS_WAIT(); asm volatile("" ::: "memory");
#pragma unroll
        for (int h = 0; h < 8; ++h) { float l4[4];
#pragma unroll
            for (int j = 0; j < 4; ++j) l4[j] = P[(lane + 64 * j) * 8 + h];
            const float mx = wave_max(fmaxf(fmaxf(l4[0], l4[1]), fmaxf(l4[2], l4[3])), lane); float s = 0.f;
#pragma unroll
            for (int j = 0; j < 4; ++j) { l4[j] = __expf(l4[j] - mx); s += l4[j]; }
            const float inv = 1.f / wave_sum(s, lane);
#pragma unroll
            for (int j = 0; j < 4; ++j) P[(lane + 64 * j) * 8 + h] = l4[j] * inv; }
        LDS_WAIT(); asm volatile("" ::: "memory");
        const int g = lane >> 5; float o[4][2];
#pragma unroll
        for (int hh = 0; hh < 4; ++hh) { o[hh][0] = 0.f; o[hh][1] = 0.f; }
#pragma unroll 4
        for (int slot = 0; slot < nsel; ++slot) { const int key = (int)sel[slot]; const unsigned vv = *(const unsigned*)(VA + (tb + key) * 128 + 2 * lane); const f32x4 p4 = *(const LAS f32x4*)(P + slot * 8 + 4 * g);
            const float v0 = bflo(vv), v1 = bfhi(vv);
#pragma unroll
            for (int hh = 0; hh < 4; ++hh) { o[hh][0] += p4[hh] * v0; o[hh][1] += p4[hh] * v1; } }
        const int d = (2 * lane) & 63;
#pragma unroll
        for (int hh = 0; hh < 4; ++hh) *(unsigned*)(OAB + (tb + t) * 1024 + (4 * g + hh) * 64 + d) = pk2(o[hh][0], o[hh][1]);
    }
    __syncthreads();
}
__device__ __forceinline__ void dsa_phase(const Frame& F) {
    if (F.G == 256) { const int c = F.vcu, b = c & 3, j = c >> 2;
        for (int i = 0; i < 16; ++i) dsa_unit(F, b, 64 * i + ((i & 1) ? 63 - j : j)); }
    else { for (int u = F.vcu; u < NB * (SEQ / 8); u += F.G) dsa_unit(F, u & 3, u >> 2); }
}
__device__ __forceinline__ void sb_phase(const Frame& F) {
    const int gw = F.wave * F.G + F.vcu, NGW = F.G * NWAVES, lane = F.lane;
    const bf16* P1 = wsp<bf16>(F, WS_P1); bf16* OAB = wsp<bf16>(F, WS_OAB);
    for (int task = gw; task < NB * 8 * (SEQ / 64); task += NGW) {
        const int qt = task & 127, h = (task >> 7) & 7, b = task >> 10; const int t = qt * 64 + lane; const size_t tb = (size_t)b * SEQ;
        v4u q[8];
#pragma unroll
        for (int c = 0; c < 8; ++c) q[c] = *(const v4u*)(P1 + (tb + t) * EVW + C_QB + h * 64 + 8 * c);
        float o[64];
#pragma unroll
        for (int d = 0; d < 64; ++d) o[d] = 0.f;
        float carry = 1.f;
#pragma unroll 1
        for (int step = 0;; ++step) {
            const int s = t - 1 - step; const bool act = (s >= 0) && (carry > 1e-30f);
            if (!__any(act)) break;
            const bf16* kp = P1 + (tb + (s < 0 ? 0 : s)) * EVW + C_KB + h * 64; float z = 0.f;
#pragma unroll
            for (int c = 0; c < 8; ++c) z = dot8bf(q[c], *(const v4u*)(kp + 8 * c), z);
            z *= 0.125f;
            const float ez = __expf(fminf(z, 80.f)), r = 1.f / (1.f + ez), beta = ez * r;
            const float a = act ? beta * carry : 0.f; carry = act ? carry * r : carry;
            const bf16* vp = kp + (C_VB - C_KB);
#pragma unroll
            for (int c = 0; c < 8; ++c) { const v4u w = *(const v4u*)(vp + 8 * c);
                o[8 * c + 0] += a * bflo(w.x); o[8 * c + 1] += a * bfhi(w.x); o[8 * c + 2] += a * bflo(w.y); o[8 * c + 3] += a * bfhi(w.y);
                o[8 * c + 4] += a * bflo(w.z); o[8 * c + 5] += a * bfhi(w.z); o[8 * c + 6] += a * bflo(w.w); o[8 * c + 7] += a * bfhi(w.w); }
        }
        bf16* op = OAB + (tb + t) * 1024 + 512 + h * 64;
#pragma unroll
        for (int c = 0; c < 8; ++c) { v4u w; w.x = pk2(o[8 * c], o[8 * c + 1]); w.y = pk2(o[8 * c + 2], o[8 * c + 3]); w.z = pk2(o[8 * c + 4], o[8 * c + 5]); w.w = pk2(o[8 * c + 6], o[8 * c + 7]); *(v4u*)(op + 8 * c) = w; }
    }
}
__device__ __forceinline__ void xattn_phase(const Frame& F, int layer) {
    const int gw = F.wave * F.G + F.vcu, NGW = F.G * NWAVES, lane = F.lane, m = lane & 31, hf = lane >> 5;
    const bf16* QX = wsp<bf16>(F, WS_QX); const bf16* KX = wsp<bf16>(F, WS_KX) + layer * 1024; const bf16* VXT = wsp<bf16>(F, WS_VXT) + (size_t)layer * 1024 * 1024; bf16* AX = wsp<bf16>(F, WS_AX);
    for (int task = gw; task < (NTOK / 32) * 4; task += NGW) {
        const int h = task & 3, qtile = task >> 2, q0 = qtile * 32, b = q0 / SEQ;
        bf16x8 qf[16];
        { const bf16* qp = QX + (size_t)(q0 + m) * 1024 + h * 256 + 8 * hf;
#pragma unroll
          for (int kk = 0; kk < 16; ++kk) qf[kk] = *(const bf16x8*)(qp + 16 * kk); }
        f32x16 S[8];
#pragma unroll
        for (int kt = 0; kt < 8; ++kt) {
#pragma unroll
            for (int r = 0; r < 16; ++r) S[kt][r] = 0.f;
            const bf16* kp = KX + (size_t)(b * MEML + 32 * kt + m) * 2048 + h * 256 + 8 * hf;
#pragma unroll
            for (int kk = 0; kk < 16; ++kk) { const bf16x8 kf = *(const bf16x8*)(kp + 16 * kk); S[kt] = __builtin_amdgcn_mfma_f32_32x32x16_bf16(kf, qf[kk], S[kt], 0, 0, 0); }
        }
        float mx = -INFINITY;
#pragma unroll
        for (int kt = 0; kt < 8; ++kt)
#pragma unroll
            for (int r = 0; r < 16; ++r) mx = fmaxf(mx, S[kt][r]);
        mx = fmaxf(mx, shx(mx, 32, lane));
        float sum = 0.f;
#pragma unroll
        for (int kt = 0; kt < 8; ++kt)
#pragma unroll
            for (int r = 0; r < 16; ++r) { const float p = __expf(S[kt][r] - mx); S[kt][r] = p; sum += p; }
        sum += shx(sum, 32, lane);
        const float inv = 1.f / sum;
        bf16x8 pf[8][2];
#pragma unroll
        for (int kt = 0; kt < 8; ++kt)
#pragma unroll
            for (int s = 0; s < 2; ++s) { v4u w; w.x = pk2(S[kt][8 * s + 0], S[kt][8 * s + 1]); w.y = pk2(S[kt][8 * s + 2], S[kt][8 * s + 3]); w.z = pk2(S[kt][8 * s + 4], S[kt][8 * s + 5]); w.w = pk2(S[kt][8 * s + 6], S[kt][8 * s + 7]);
                pf[kt][s] = __builtin_bit_cast(bf16x8, w); }
#pragma unroll
        for (int half = 0; half < 2; ++half) {
            f32x16 O[4];
#pragma unroll
            for (int d4 = 0; d4 < 4; ++d4) {
#pragma unroll
                for (int r = 0; r < 16; ++r) O[d4][r] = 0.f;
                const bf16* vp = VXT + (size_t)(h * 256 + 32 * (4 * half + d4) + m) * 1024 + b * MEML + 4 * hf;
#pragma unroll
                for (int kt = 0; kt < 8; ++kt)
#pragma unroll
                    for (int s = 0; s < 2; ++s) { const v2u lo = *(const v2u*)(vp + 32 * kt + 16 * s), hi = *(const v2u*)(vp + 32 * kt + 16 * s + 8);
                        v4u a; a.x = lo.x; a.y = lo.y; a.z = hi.x; a.w = hi.y;
                        O[d4] = __builtin_amdgcn_mfma_f32_32x32x16_bf16(__builtin_bit_cast(bf16x8, a), pf[kt][s], O[d4], 0, 0, 0); }
            }
            bf16* op = AX + (size_t)(q0 + m) * 1024 + h * 256 + 4 * hf;
#pragma unroll
            for (int d4 = 0; d4 < 4; ++d4)
#pragma unroll
                for (int rg = 0; rg < 4; ++rg) { v2u w; w.x = pk2(O[d4][4 * rg] * inv, O[d4][4 * rg + 1] * inv); w.y = pk2(O[d4][4 * rg + 2] * inv, O[d4][4 * rg + 3] * inv);
                    *(v2u*)(op + 32 * (4 * half + d4) + 8 * rg) = w; }
        }
    }
}

__device__ __forceinline__ void router_phase(const Frame& F, int layer) {
    const int gw = F.wave * F.G + F.vcu, NGW = F.G * NWAVES, lane = F.lane, m = lane & 31, hf = lane >> 5;
    const float* HF = wsp<float>(F, WS_HF); const float* Wr = inp(F, 26) + (size_t)layer * DM * NEXP; const float* br = inp(F, 27) + layer * NEXP;
    unsigned* cnt = wsp<unsigned>(F, WS_CTL) + CW_CNT + layer * 32 * 64;
    int* elist = wsp<int>(F, WS_ELIST); float* egate = wsp<float>(F, WS_EGATE); int* toke = wsp<int>(F, WS_TOKE); int* tokp = wsp<int>(F, WS_TOKP);
    LAS float* scr = (LAS float*)(F.lds + F.wave * 8192);
    for (int tile = gw; tile < NTOK / 32; tile += NGW) {
        const int tok0 = tile * 32;
        f32x16 acc;
#pragma unroll
        for (int r = 0; r < 16; ++r) acc[r] = 0.f;
        const float* ap = HF + (size_t)(tok0 + m) * DM + 4 * hf; const float* bp = Wr + (size_t)(4 * hf) * NEXP + m;
#pragma unroll 4
        for (int j = 0; j < 128; ++j) { const f32x4 a = *(const f32x4*)(ap + 8 * j);
#pragma unroll
            for (int s = 0; s < 4; ++s) acc = __builtin_amdgcn_mfma_f32_32x32x2f32(a[s], bp[(size_t)(8 * j + s) * NEXP], acc, 0, 0, 0); }
#pragma unroll
        for (int r = 0; r < 16; ++r) scr[crow(r, hf) * 33 + m] = acc[r];
        LDS_WAIT(); asm volatile("" ::: "memory");
        int e4[4]; float g4[4];
        { float lg[32];
#pragma unroll
          for (int e = 0; e < 32; ++e) lg[e] = scr[m * 33 + e] + br[e];
          unsigned taken = 0u; float v4[4];
#pragma unroll
          for (int k = 0; k < 4; ++k) { float best = -INFINITY; int bi = 0;
#pragma unroll
              for (int e = 0; e < 32; ++e) { const bool ok = !((taken >> e) & 1u) && (lg[e] > best); best = ok ? lg[e] : best; bi = ok ? e : bi; }
              taken |= 1u << bi; e4[k] = bi; v4[k] = best; }
          float s = 0.f;
#pragma unroll
          for (int k = 0; k < 4; ++k) { g4[k] = __expf(v4[k] - v4[0]); s += g4[k]; }
          const float inv = 1.f / s;
#pragma unroll
          for (int k = 0; k < 4; ++k) g4[k] *= inv; }
        LDS_WAIT(); asm volatile("" ::: "memory");
        int pos4[4];
        const bool act = lane < 32;
        for (int e = 0; e < 32; ++e) {
            unsigned long long mk[4]; int tot = 0;
#pragma unroll
            for (int k = 0; k < 4; ++k) { mk[k] = __ballot(act && e4[k] == e); tot += __popcll(mk[k]); }
            if (tot == 0) continue;
            unsigned base = 0u;
            if (lane == 0) base = __hip_atomic_fetch_add(cnt + e * 64, (unsigned)tot, __ATOMIC_RELAXED, __HIP_MEMORY_SCOPE_AGENT);
            base = (unsigned)__builtin_amdgcn_readfirstlane((int)base);
            const unsigned long long lt = (1ull << lane) - 1ull; int off = 0;
#pragma unroll
            for (int k = 0; k < 4; ++k) { if (act && e4[k] == e) pos4[k] = (int)base + off + __popcll(mk[k] & lt); off += __popcll(mk[k]); }
        }
        if (act) { const int tok = tok0 + lane;
#pragma unroll
            for (int k = 0; k < 4; ++k) { elist[(size_t)e4[k] * NTOK + pos4[k]] = tok; egate[(size_t)e4[k] * NTOK + pos4[k]] = g4[k]; }
            *(int4*)(toke + (size_t)tok * 4) = make_int4(e4[0], e4[1], e4[2], e4[3]); *(int4*)(tokp + (size_t)tok * 4) = make_int4(pos4[0], pos4[1], pos4[2], pos4[3]); }
    }
}
__device__ __forceinline__ void moe_tables(const Frame& F, int layer) {
    LAS int* tile_e = (LAS int*)(F.lds + UP_TILEE); LAS int* tstart = (LAS int*)(F.lds + UP_TSTART); LAS int* cntl = (LAS int*)(F.lds + UP_CNT);
    unsigned* cnt = wsp<unsigned>(F, WS_CTL) + CW_CNT + layer * 32 * 64;
    __syncthreads();
    if (F.tid < 32) cntl[F.tid] = (int)__hip_atomic_load(cnt + F.tid * 64, __ATOMIC_RELAXED, __HIP_MEMORY_SCOPE_AGENT);
    __syncthreads();
    if (F.tid == 0) { int s = 0; for (int e = 0; e < 32; ++e) { tstart[e] = s; s += (cntl[e] + 255) >> 8; } tstart[32] = s; }
    __syncthreads();
    for (int e = 0; e < 32; ++e) { const int a = tstart[e], b = tstart[e + 1]; for (int rt = a + F.tid; rt < b; rt += NTHR) tile_e[rt] = e; }
    __syncthreads();
}
__device__ __forceinline__ void gather_phase(const Frame& F, int layer) {
    moe_tables(F, layer);
    const LAS int* tile_e = (const LAS int*)(F.lds + UP_TILEE); const LAS int* tstart = (const LAS int*)(F.lds + UP_TSTART); const LAS int* cntl = (const LAS int*)(F.lds + UP_CNT);
    const int gw = F.vcu * NWAVES + F.wave, NGW = F.G * NWAVES, lane = F.lane; const int nrows = tstart[32] * 256;
    const int* elist = wsp<int>(F, WS_ELIST); const float* egate = wsp<float>(F, WS_EGATE); float* rgate = wsp<float>(F, WS_RGATE);
    const bf16* XB = wsp<bf16>(F, WS_XB); bf16* XG = wsp<bf16>(F, WS_XG);
    for (int row = gw; row < nrows; row += NGW) {
        const int rt = row >> 8, e = tile_e[rt], pos = (rt - tstart[e]) * 256 + (row & 255); const bool valid = pos < cntl[e];
        v4u a = (v4u){0u, 0u, 0u, 0u}, b = a; float gt = 0.f;
        if (valid) { const int tok = elist[(size_t)e * NTOK + pos]; gt = egate[(size_t)e * NTOK + pos]; const bf16* src = XB + (size_t)tok * DM + 16 * lane; a = *(const v4u*)src; b = *(const v4u*)(src + 8); }
        bf16* dst = XG + (size_t)row * DM + 16 * lane; *(v4u*)dst = a; *(v4u*)(dst + 8) = b;
        if (lane == 0) rgate[row] = gt;
    }
}
__device__ __forceinline__ void combine_phase(const Frame& F, int layer, float* dstF) {
    moe_tables(F, layer);
    const LAS int* tstart = (const LAS int*)(F.lds + UP_TSTART);
    const int gw = F.vcu * NWAVES + F.wave, NGW = F.G * NWAVES, lane = F.lane;
    const int* toke = wsp<int>(F, WS_TOKE); const int* tokp = wsp<int>(F, WS_TOKP); const bf16* Y = wsp<bf16>(F, WS_XG); const float* HF = wsp<float>(F, WS_HF); bf16* XB = wsp<bf16>(F, WS_XB);
    const float* g = inp(F, 32) + layer * DM; const float* b = inp(F, 33) + layer * DM;
    for (int tok = gw; tok < NTOK; tok += NGW) {
        const int4 e4 = *(const int4*)(toke + (size_t)tok * 4), p4 = *(const int4*)(tokp + (size_t)tok * 4);
        const int r0 = tstart[e4.x] * 256 + p4.x, r1 = tstart[e4.y] * 256 + p4.y, r2 = tstart[e4.z] * 256 + p4.z, r3 = tstart[e4.w] * 256 + p4.w;
        f32x4 v[4];
#pragma unroll
        for (int j = 0; j < 4; ++j) { const int c = 4 * lane + 256 * j; v[j] = *(const f32x4*)(HF + (size_t)tok * DM + c) * DN_ALPHA;
            const v2u y0 = *(const v2u*)(Y + (size_t)r0 * DM + c), y1 = *(const v2u*)(Y + (size_t)r1 * DM + c), y2 = *(const v2u*)(Y + (size_t)r2 * DM + c), y3 = *(const v2u*)(Y + (size_t)r3 * DM + c);
            v[j][0] += ((bflo(y0.x) + bflo(y1.x)) + bflo(y2.x)) + bflo(y3.x); v[j][1] += ((bfhi(y0.x) + bfhi(y1.x)) + bfhi(y2.x)) + bfhi(y3.x);
            v[j][2] += ((bflo(y0.y) + bflo(y1.y)) + bflo(y2.y)) + bflo(y3.y); v[j][3] += ((bfhi(y0.y) + bfhi(y1.y)) + bfhi(y2.y)) + bfhi(y3.y); }
        ln_row_store(F, v, g, b, dstF + (size_t)tok * DM, XB + (size_t)tok * DM);
    }
}

constexpr int S5_APITCH = 2064, S5_HPITCH = 272, S5_AOFF = 0, S5_HOFF = 32 * S5_APITCH  , S5_ROFF = 81920  ;
__device__ __forceinline__ void s5_stage_u(const Frame& F, int g, int mt) {
    const bf16* U = wsp<bf16>(F, WS_U); const int b = mt >> 2, ch0 = (mt & 3) * 32;
    for (int pc = F.tid; pc < 32 * 64; pc += NTHR) { const int i = pc >> 6, s = pc & 63; const bf16* src = U + ((size_t)b * SEQ + (size_t)(ch0 + i) * SCH + s) * DM + 16 * g;
        const v4u a = *(const v4u*)src, c = *(const v4u*)(src + 8); LAS unsigned char* d = F.lds + S5_AOFF + i * S5_APITCH + s * 32; *(LAS v4u*)d = a; *(LAS v4u*)(d + 16) = c; }
}
__device__ __forceinline__ void s5_local_phase(const Frame& F) {
    const int lane = F.lane, wave = F.wave, m = lane & 31, hf = lane >> 5;
    const bf16* W1 = wsp<bf16>(F, WS_W1); float* ELOC = wsp<float>(F, WS_ELOC);
    for (int unit = F.vcu; unit < 64 * 16; unit += F.G) {
        const int g = unit & 63, mt = unit >> 6, b = mt >> 2, ch0 = (mt & 3) * 32;
        __syncthreads();
        s5_stage_u(F, g, mt);
        LDS_WAIT(); __syncthreads();
        const int nt = wave & 3, kh = wave >> 2;
        f32x16 acc;
#pragma unroll
        for (int r = 0; r < 16; ++r) acc[r] = 0.f;
        const bf16* wp = W1 + ((size_t)g * 128 + 32 * nt + m) * 1024 + 8 * hf; const LAS unsigned char* ap = F.lds + S5_AOFF + m * S5_APITCH + 16 * hf;
#pragma unroll 8
        for (int kk = 32 * kh; kk < 32 * kh + 32; ++kk) { const bf16x8 af = *(const LAS bf16x8*)(ap + 32 * kk); const bf16x8 bf = *(const bf16x8*)(wp + 16 * kk);
            acc = __builtin_amdgcn_mfma_f32_32x32x16_bf16(af, bf, acc, 0, 0, 0); }
        LAS float* red = (LAS float*)(F.lds + S5_ROFF) + (nt * 64 + lane) * 16;
        if (kh == 1) {
#pragma unroll
            for (int r = 0; r < 16; r += 4) *(LAS f32x4*)(red + r) = (f32x4){acc[r], acc[r + 1], acc[r + 2], acc[r + 3]}; }
        LDS_WAIT(); __syncthreads();
        if (kh == 0) {
#pragma unroll
            for (int r = 0; r < 16; ++r) { const int i = crow(r, hf); ELOC[(((size_t)b * 64 + g) * NCHUNK + ch0 + i) * 128 + 32 * nt + m] = acc[r] + red[r]; } }
    }
}
__device__ __forceinline__ void s5_scan_phase(const Frame& F) {
    if (F.wave != 0) return;
    const f32x2* apow = wsp<f32x2>(F, WS_APOW); const float* ELOC = wsp<float>(F, WS_ELOC); bf16* HS = wsp<bf16>(F, WS_HS);
    for (int idx = F.vcu * 64 + F.lane; idx < NB * 64 * 64; idx += F.G * 64) {
        const int p = idx & 63, g = (idx >> 6) & 63, b = idx >> 12; const f32x2 a = apow[(g * 64 + p) * 65 + 64];
        const size_t base = ((size_t)b * 64 + g) * NCHUNK * 128; float hr = 0.f, hi = 0.f;
#pragma unroll 8
        for (int k = 0; k < NCHUNK; ++k) { HS[base + (size_t)k * 128 + p] = (bf16)f2bf(hr); HS[base + (size_t)k * 128 + 64 + p] = (bf16)f2bf(hi);
            const float er = ELOC[base + (size_t)k * 128 + p], ei = ELOC[base + (size_t)k * 128 + 64 + p];
            const float nr = a.x * hr - a.y * hi + er, ni = a.x * hi + a.y * hr + ei; hr = nr; hi = ni; }
    }
}
__device__ __forceinline__ void s5_out_phase(const Frame& F) {
    const int lane = F.lane, wave = F.wave, m = lane & 31, hf = lane >> 5;
    const bf16* KT = wsp<bf16>(F, WS_KT); const bf16* W3 = wsp<bf16>(F, WS_W3); const bf16* HS = wsp<bf16>(F, WS_HS); const bf16* U = wsp<bf16>(F, WS_U); bf16* YG = wsp<bf16>(F, WS_YG);
    const float* dvec = inp(F, 17);
    for (int unit = F.vcu; unit < 64 * 16; unit += F.G) {
        const int g = unit & 63, mt = unit >> 6, b = mt >> 2, ch0 = (mt & 3) * 32;
        __syncthreads();
        s5_stage_u(F, g, mt);
        for (int pc = F.tid; pc < 32 * 16; pc += NTHR) { const int i = pc >> 4, q = pc & 15;
            *(LAS v4u*)(F.lds + S5_HOFF + i * S5_HPITCH + q * 16) = *(const v4u*)(HS + (((size_t)b * 64 + g) * NCHUNK + ch0 + i) * 128 + 8 * q); }
        LDS_WAIT(); __syncthreads();
        const int tl = m >> 4, c = m & 15; const float dv = dvec[16 * g + c];
        const LAS unsigned char* ap = F.lds + S5_AOFF + m * S5_APITCH + 16 * hf; const LAS unsigned char* hp = F.lds + S5_HOFF + m * S5_HPITCH + 16 * hf;
#pragma unroll 1
        for (int q = 0; q < 4; ++q) {
            const int j = (q == 0) ? wave : (q == 1) ? 15 - wave : (q == 2) ? 16 + wave : 31 - wave; const int t = 2 * j + tl;
            f32x16 acc;
#pragma unroll
            for (int r = 0; r < 16; ++r) acc[r] = 0.f;
            const bf16* kt = KT + ((size_t)g * 64 * 16 + c) * 16 + 8 * hf;
#pragma unroll 2
            for (int s = 0; s <= 2 * j + 1; ++s) { const int tau = t - s; bf16x8 bf = (bf16x8){0, 0, 0, 0, 0, 0, 0, 0}; if (tau >= 0) bf = *(const bf16x8*)(kt + tau * 256);
                const bf16x8 af = *(const LAS bf16x8*)(ap + 32 * s); acc = __builtin_amdgcn_mfma_f32_32x32x16_bf16(af, bf, acc, 0, 0, 0); }
            const bf16* w3 = W3 + ((size_t)g * 1024 + 16 * t + c) * 128 + 8 * hf;
#pragma unroll
            for (int kk = 0; kk < 8; ++kk) { const bf16x8 af = *(const LAS bf16x8*)(hp + 32 * kk); const bf16x8 bf = *(const bf16x8*)(w3 + 16 * kk); acc = __builtin_amdgcn_mfma_f32_32x32x16_bf16(af, bf, acc, 0, 0, 0); }
#pragma unroll
            for (int r = 0; r < 16; ++r) { const int i = crow(r, hf); const size_t off = ((size_t)b * SEQ + (size_t)(ch0 + i) * SCH + t) * DM + 16 * g + c;
                const float y = acc[r] + dv * bf2f(U[off]); const float x = 0.7978845608028654f * (y + 0.044715f * y * y * y); const float th = 1.f - 2.f / (1.f + __expf(2.f * x));
                YG[off] = (bf16)f2bf(0.5f * y * (1.f + th)); }
        }
    }
}
#ifndef MK_PER_PHASE
#define MK_PER_PHASE 0
#endif
constexpr int NPH = 31;
__device__ __forceinline__ bool in_ph(int k, int lo, int hi) { asm volatile("" : "+s"(lo), "+s"(hi)); return lo <= k && k < hi; }
struct Args { const float* in[34]; float* out; unsigned char* ws; int ph_lo, ph_hi; };
__global__ void __launch_bounds__(NTHR, 2) fwd_kernel(Args args) {
    extern __shared__ __attribute__((aligned(16))) unsigned char lds_raw[];
    Frame F;
    F.lds = (LAS unsigned char*)lds_raw;
    F.tid = threadIdx.x; F.lane = F.tid & 63; F.wave = __builtin_amdgcn_readfirstlane(F.tid >> 6);
    F.G = gridDim.x; { const int bx = blockIdx.x; F.vcu = (F.G % 8 == 0) ? (bx % 8) * (F.G / 8) + bx / 8 : bx; }
    F.out = args.out; F.ws = args.ws;
    for (int u = F.tid; u < 64; u += NTHR) ((LAS unsigned*)(F.lds + UP_MISC))[u] = 0u;
    if (F.tid < 34) *(LAS unsigned long long*)(F.lds + UP_PTR + 8 * F.tid) = (unsigned long long)args.in[F.tid];
    const bool is_w0 = (F.wave == 0);
    F.tid = 0; F.lane = 0;
    __syncthreads();
    XcdBarrier bar; bar.w0 = is_w0; bar.bar = wsp<unsigned>(F, WS_CTL) + CW_BAR; bar.x = 0; bar.st = nullptr;
#if !MK_PER_PHASE
    bar = xcd_barrier_post(wsp<unsigned>(F, WS_CTL) + CW_BAR, (volatile LAS unsigned*)(F.lds + UP_MISC) + 8, is_w0);
#endif
    const int lo = args.ph_lo, hi = args.ph_hi;
#define IN(k) in_ph((k), lo, hi)
#ifndef ONLY_SITE
#define EN(n) true
#else
#define EN(n) ((n) == ONLY_SITE)
#endif
#if MK_PER_PHASE
#define SEAM(k) do { } while (0)
#else
#define SEAM(k) do { if (IN(k) && IN((k) + 1)) xcd_barrier(bar); } while (0)
#endif
    const int bx = (int)blockIdx.x;
    typedef pg8::EpiBf16<0> EpiB;
    if (IN(0) && EN(0)) { const Frame P = pframe(F); p0_prologue(P); }
    SEAM(0);

            if (IN(1) && EN(1)) { const Frame P = pframe(F);
                { pg8::Gemm g{wsp<bf16>(P, WS_XB), wsp<bf16>(P, WS_WTIN0), NTOK, EVW, DM, P.wave}; pg8::StaticOrder S; S.init(NTOK, EVW, P.G, bx);
                  EpiB E{wsp<bf16>(P, WS_P1), EVW, nullptr, 0, 0, 1.f}; pg8::gemm_phase<EpiB, pg8::StaticOrder, true, true>(P.lds, g, S, E); }
                { pg8::Gemm g{wsp<bf16>(P, WS_MEMB), wsp<bf16>(P, WS_WTXK), NMEM, 2048, DM, P.wave}; pg8::StaticOrder S; S.init(NMEM, 2048, P.G, (bx + P.G - P.G / 2) % P.G);
                  EpiB E{wsp<bf16>(P, WS_KX), 2048, nullptr, 0, 0, 1.f}; pg8::gemm_phase<EpiB, pg8::StaticOrder, true, true>(P.lds, g, S, E); }
                { pg8::Gemm g{wsp<bf16>(P, WS_WTXV), wsp<bf16>(P, WS_MEMB), 2048, NMEM, DM, P.wave}; pg8::StaticOrder S; S.init(2048, NMEM, P.G, (bx + P.G - P.G / 2 - 32) % P.G);
                  EpiB E{wsp<bf16>(P, WS_VXT), NMEM, nullptr, 0, 0, 1.f}; pg8::gemm_phase<EpiB, pg8::StaticOrder, true, true>(P.lds, g, S, E); }
            }
            SEAM(1);
            if (IN(2) && EN(2)) { const Frame P = pframe(F); p2_postproc(P); }
            SEAM(2);
            if (IN(3) && EN(3)) { const Frame P = pframe(F); const int kq = (lo < 0) ? 512 : 256;     pg8::Gemm g{wsp<bf16>(P, WS_CQ), wsp<bf16>(P, WS_WTQ), NTOK, 1024, kq, P.wave}; pg8::StaticOrder S; S.init(NTOK, 1024, P.G, bx);
                EpiB E{wsp<bf16>(P, WS_QAI), 1024, nullptr, 0, 0, 1.f}; pg8::gemm_phase<EpiB, pg8::StaticOrder, true, true>(P.lds, g, S, E); }
            SEAM(3);
            if (IN(4)) { if (EN(4)) { const Frame P = pframe(F); dsa_phase(P); } if (EN(40)) { const Frame P = pframe(F); sb_phase(P); } }
            SEAM(4);
            if (IN(5) && EN(5)) { const Frame P = pframe(F); pg8::Gemm g{wsp<bf16>(P, WS_OAB), wsp<bf16>(P, WS_WTOUT0), NTOK, DM, DM, P.wave}; pg8::StaticOrder S; S.init(NTOK, DM, P.G, bx);
                pg8::EpiResF32 E{inp(P, 0), wsp<float>(P, WS_T), DM, DN_ALPHA}; pg8::gemm_phase<pg8::EpiResF32, pg8::StaticOrder, true, true>(P.lds, g, S, E); }
            SEAM(5);
            if (IN(6) && EN(6)) { const Frame P = pframe(F); ln_phase(P, wsp<float>(P, WS_T), inp(P, 19), inp(P, 20), wsp<float>(P, WS_HF), wsp<bf16>(P, WS_XB)); }
            SEAM(6);
    {
        constexpr int cb = 7;
        if (IN(cb + 0) && EN(7)) { const Frame P = pframe(F); pg8::Gemm g{wsp<bf16>(P, WS_XB), wsp<bf16>(P, WS_WTXQ) + (size_t)0 * DM * DM, NTOK, DM, DM, P.wave}; pg8::StaticOrder S; S.init(NTOK, DM, P.G, bx);
            EpiB E{wsp<bf16>(P, WS_QX), DM, nullptr, 0, 0, 1.f}; pg8::gemm_phase<EpiB, pg8::StaticOrder, true, true>(P.lds, g, S, E); }
        SEAM(cb + 0);
        if (IN(cb + 1) && EN(8)) { const Frame P = pframe(F); xattn_phase(P, 0); }
        SEAM(cb + 1);
        if (IN(cb + 2) && EN(9)) { const Frame P = pframe(F); pg8::Gemm g{wsp<bf16>(P, WS_AX), wsp<bf16>(P, WS_WTXO) + (size_t)0 * DM * DM, NTOK, DM, DM, P.wave}; pg8::StaticOrder S; S.init(NTOK, DM, P.G, bx);
            pg8::EpiResF32 E{wsp<float>(P, WS_HF), wsp<float>(P, WS_T), DM, DN_ALPHA}; pg8::gemm_phase<pg8::EpiResF32, pg8::StaticOrder, true, true>(P.lds, g, S, E); }
        SEAM(cb + 2);
        if (IN(cb + 3) && EN(10)) { const Frame P = pframe(F); ln_phase(P, wsp<float>(P, WS_T), inp(P, 24) + 0 * DM, inp(P, 25) + 0 * DM, wsp<float>(P, WS_HF), wsp<bf16>(P, WS_XB)); }
        SEAM(cb + 3);
        if (IN(cb + 4) && EN(11)) { const Frame P = pframe(F); router_phase(P, 0); }
        SEAM(cb + 4);
        if (IN(cb + 5) && EN(12)) { const Frame P = pframe(F); gather_phase(P, 0); }
        SEAM(cb + 5);
        if (IN(cb + 6) && EN(13)) { const Frame P0 = pframe(F); moe_tables(P0, 0); }
        if (IN(cb + 6) && EN(13)) { const Frame P = pframe(F); const int nrt = __builtin_amdgcn_readfirstlane(((const LAS int*)(P.lds + UP_TSTART))[32]);
            pg8::Gemm g{wsp<bf16>(P, WS_XG), wsp<bf16>(P, WS_WTGU) + (size_t)0 * NEXP * 2048 * DM, nrt * 256, NEXP * 2048, DM, P.wave};
            pg8::MoeOrder<8> S{(const LAS int*)(P.lds + UP_TILEE), nrt, P.G, P.vcu};
            pg8::EpiSwiGlu E{wsp<bf16>(P, WS_ACT), inp(P, 29) + (size_t)0 * NEXP * 2048}; pg8::gemm_phase<pg8::EpiSwiGlu, pg8::MoeOrder<8>, true, true>(P.lds, g, S, E); }
        SEAM(cb + 6);
        if (IN(cb + 7) && EN(14)) { const Frame P0 = pframe(F); moe_tables(P0, 0); }
        if (IN(cb + 7) && EN(14)) { const Frame P = pframe(F); const int nrt = __builtin_amdgcn_readfirstlane(((const LAS int*)(P.lds + UP_TSTART))[32]);
            pg8::Gemm g{wsp<bf16>(P, WS_ACT), wsp<bf16>(P, WS_WTDN) + (size_t)0 * NEXP * DM * DM, nrt * 256, NEXP * DM, DM, P.wave};
            pg8::MoeOrder<4> S{(const LAS int*)(P.lds + UP_TILEE), nrt, P.G, P.vcu};
            pg8::EpiDown E{wsp<bf16>(P, WS_XG), inp(P, 31) + (size_t)0 * NEXP * DM, wsp<float>(P, WS_RGATE)}; pg8::gemm_phase<pg8::EpiDown, pg8::MoeOrder<4>, true, true>(P.lds, g, S, E); }
        SEAM(cb + 7);
        if (IN(cb + 8) && EN(15)) { const Frame P = pframe(F); combine_phase(P, 0, 0 == 0 ? wsp<float>(P, WS_HF) : P.out); }
        SEAM(cb + 8);
    }

            if (IN(16) && EN(16)) { const Frame P = pframe(F); pg8::Gemm g{wsp<bf16>(P, WS_XB), wsp<bf16>(P, WS_WTS5IN), NTOK, DM, DM, P.wave}; pg8::StaticOrder S; S.init(NTOK, DM, P.G, bx);
                EpiB E{wsp<bf16>(P, WS_U), DM, nullptr, 0, 0, 1.f}; pg8::gemm_phase<EpiB, pg8::StaticOrder, true, true>(P.lds, g, S, E); }
            SEAM(16);
            if (IN(17) && EN(17)) { const Frame P = pframe(F); s5_local_phase(P); }
            SEAM(17);
            if (IN(18) && EN(18)) { const Frame P = pframe(F); s5_scan_phase(P); }
            SEAM(18);
            if (IN(19) && EN(19)) { const Frame P = pframe(F); s5_out_phase(P); }
            SEAM(19);
            if (IN(20) && EN(20)) { const Frame P = pframe(F); pg8::Gemm g{wsp<bf16>(P, WS_YG), wsp<bf16>(P, WS_WTS5OUT), NTOK, 2048, DM, P.wave}; pg8::StaticOrder S; S.init(NTOK, 2048, P.G, bx);
                pg8::EpiGluRes E{wsp<float>(P, WS_HF), wsp<float>(P, WS_T), DM, DN_ALPHA}; pg8::gemm_phase<pg8::EpiGluRes, pg8::StaticOrder, true, true>(P.lds, g, S, E); }
            SEAM(20);
            if (IN(21) && EN(21)) { const Frame P = pframe(F); ln_phase(P, wsp<float>(P, WS_T), inp(P, 19) + DM, inp(P, 20) + DM, wsp<float>(P, WS_HF), wsp<bf16>(P, WS_XB)); }
            SEAM(21);
    {
        constexpr int cb = 22;
        if (IN(cb + 0) && EN(7)) { const Frame P = pframe(F); pg8::Gemm g{wsp<bf16>(P, WS_XB), wsp<bf16>(P, WS_WTXQ) + (size_t)1 * DM * DM, NTOK, DM, DM, P.wave}; pg8::StaticOrder S; S.init(NTOK, DM, P.G, bx);
            EpiB E{wsp<bf16>(P, WS_QX), DM, nullptr, 0, 0, 1.f}; pg8::gemm_phase<EpiB, pg8::StaticOrder, true, true>(P.lds, g, S, E); }
        SEAM(cb + 0);
        if (IN(cb + 1) && EN(8)) { const Frame P = pframe(F); xattn_phase(P, 1); }
        SEAM(cb + 1);
        if (IN(cb + 2) && EN(9)) { const Frame P = pframe(F); pg8::Gemm g{wsp<bf16>(P, WS_AX), wsp<bf16>(P, WS_WTXO) + (size_t)1 * DM * DM, NTOK, DM, DM, P.wave}; pg8::StaticOrder S; S.init(NTOK, DM, P.G, bx);
            pg8::EpiResF32 E{wsp<float>(P, WS_HF), wsp<float>(P, WS_T), DM, DN_ALPHA}; pg8::gemm_phase<pg8::EpiResF32, pg8::StaticOrder, true, true>(P.lds, g, S, E); }
        SEAM(cb + 2);
        if (IN(cb + 3) && EN(10)) { const Frame P = pframe(F); ln_phase(P, wsp<float>(P, WS_T), inp(P, 24) + 1 * DM, inp(P, 25) + 1 * DM, wsp<float>(P, WS_HF), wsp<bf16>(P, WS_XB)); }
        SEAM(cb + 3);
        if (IN(cb + 4) && EN(11)) { const Frame P = pframe(F); router_phase(P, 1); }
        SEAM(cb + 4);
        if (IN(cb + 5) && EN(12)) { const Frame P = pframe(F); gather_phase(P, 1); }
        SEAM(cb + 5);
        if (IN(cb + 6) && EN(13)) { const Frame P0 = pframe(F); moe_tables(P0, 1); }
        if (IN(cb + 6) && EN(13)) { const Frame P = pframe(F); const int nrt = __builtin_amdgcn_readfirstlane(((const LAS int*)(P.lds + UP_TSTART))[32]);
            pg8::Gemm g{wsp<bf16>(P, WS_XG), wsp<bf16>(P, WS_WTGU) + (size_t)1 * NEXP * 2048 * DM, nrt * 256, NEXP * 2048, DM, P.wave};
            pg8::MoeOrder<8> S{(const LAS int*)(P.lds + UP_TILEE), nrt, P.G, P.vcu};
            pg8::EpiSwiGlu E{wsp<bf16>(P, WS_ACT), inp(P, 29) + (size_t)1 * NEXP * 2048}; pg8::gemm_phase<pg8::EpiSwiGlu, pg8::MoeOrder<8>, true, true>(P.lds, g, S, E); }
        SEAM(cb + 6);
        if (IN(cb + 7) && EN(14)) { const Frame P0 = pframe(F); moe_tables(P0, 1); }
        if (IN(cb + 7) && EN(14)) { const Frame P = pframe(F); const int nrt = __builtin_amdgcn_readfirstlane(((const LAS int*)(P.lds + UP_TSTART))[32]);
            pg8::Gemm g{wsp<bf16>(P, WS_ACT), wsp<bf16>(P, WS_WTDN) + (size_t)1 * NEXP * DM * DM, nrt * 256, NEXP * DM, DM, P.wave};
            pg8::MoeOrder<4> S{(const LAS int*)(P.lds + UP_TILEE), nrt, P.G, P.vcu};
            pg8::EpiDown E{wsp<bf16>(P, WS_XG), inp(P, 31) + (size_t)1 * NEXP * DM, wsp<float>(P, WS_RGATE)}; pg8::gemm_phase<pg8::EpiDown, pg8::MoeOrder<4>, true, true>(P.lds, g, S, E); }
        SEAM(cb + 7);
        if (IN(cb + 8) && EN(15)) { const Frame P = pframe(F); combine_phase(P, 1, 1 == 0 ? wsp<float>(P, WS_HF) : P.out); }

    }
#undef IN
#undef SEAM
}

extern "C" void kernel_launch(void* const* d_in, const int* in_sizes, int n_in, void* d_out, int out_size, void* d_ws, size_t ws_size, hipStream_t stream) {
    static int grid = 0;
    if (grid == 0) {
        if (n_in != 34 || in_sizes[0] != NTOK * DM || out_size != NTOK * DM || ws_size < WS_END) {
            fprintf(stderr, "kernel_launch: built for 34 inputs, x/out of %d floats, >= %zu bytes of workspace; got n_in %d, in0 %d, out %d, ws %zu; nothing launched\n", NTOK * DM, (size_t)WS_END, n_in, n_in > 0 ? in_sizes[0] : -1, out_size, ws_size);
            grid = -1; return; }
        int dev = 0, cus = 0, per_cu = 0;
        if (hipGetDevice(&dev) != hipSuccess || hipDeviceGetAttribute(&cus, hipDeviceAttributeMultiprocessorCount, dev) != hipSuccess) { fprintf(stderr, "kernel_launch: device query failed\n"); grid = -1; return; }
        if (hipFuncSetAttribute((const void*)fwd_kernel, hipFuncAttributeMaxDynamicSharedMemorySize, LDS_BYTES) != hipSuccess) { fprintf(stderr, "kernel_launch: hipFuncSetAttribute failed\n"); grid = -1; return; }
        if (hipOccupancyMaxActiveBlocksPerMultiprocessor(&per_cu, (const void*)fwd_kernel, NTHR, LDS_BYTES) != hipSuccess || per_cu < 1)
            fprintf(stderr, "kernel_launch: note: occupancy query reports %d workgroups per CU\n", per_cu);
        (void)hipGetLastError();
        grid = cus;
    }
    if (grid < 0) return;
    if (hipMemsetAsync((char*)d_ws + WS_CTL, 0, CTL_ZERO_BYTES, stream) != hipSuccess) { fprintf(stderr, "kernel_launch: memset failed\n"); return; }
    Args a{};
    for (int i = 0; i < 34; ++i) a.in[i] = (const float*)d_in[i];
    a.out = (float*)d_out; a.ws = (unsigned char*)d_ws;
#if MK_PER_PHASE
    for (int p = 0; p < NPH; ++p) { a.ph_lo = p; a.ph_hi = p + 1; hipLaunchKernelGGL(fwd_kernel, dim3(grid), dim3(NTHR), LDS_BYTES, stream, a); }
#else
    a.ph_lo = 0; a.ph_hi = NPH;
    hipLaunchKernelGGL(fwd_kernel, dim3(grid), dim3(NTHR), LDS_BYTES, stream, a);
#endif
    const hipError_t le = hipPeekAtLastError();
    if (le != hipSuccess) fprintf(stderr, "kernel_launch: launch failed: %s\n", hipGetErrorName(le));
}
```

```cpp
#include <hip/hip_runtime.h>
#include <cstdio>
#include <cstdint>
namespace pg8 {
#define PG8_LAS __attribute__((address_space(3)))
typedef unsigned short bf16_t;
typedef short bf16x8 __attribute__((ext_vector_type(8)));
typedef float f32x4 __attribute__((ext_vector_type(4)));
typedef unsigned u32x4 __attribute__((ext_vector_type(4)));
constexpr int BM = 256, BK = 64, HALF = 128, HTB = HALF * BK * 2  , STAGE_BYTES = 8 * HTB, NXCD = 8, WGM = 8;

__host__ __device__ __forceinline__ int lds_byte(int r, int c) { const int st = (r >> 4) * 2 + (c >> 5), rr = r & 15, cc = c & 31, ob = rr * 64 + cc * 2; return st * 1024 + (ob ^ (((ob >> 9) & 1) << 5)); }
__host__ __device__ __forceinline__ void stage_rc(int b, int& R, int& C) { const int st = b / 1024, sb = b % 1024, swz = sb ^ (((sb >> 9) & 1) << 5); R = (st >> 1) * 16 + swz / 64; C = (st & 1) * 32 + (swz % 64) / 2; }
__host__ __device__ __forceinline__ int perm32(int rho) { const int n = rho >> 4, i = rho & 15; return 8 * (i >> 2) + 4 * n + (i & 3); }

struct Unit { int pm, pn; };
struct Gemm { const bf16_t* A; const bf16_t* Bt; int M, N, K; int wid; };

struct StaticOrder {
    int nM, nN, nwg, G, c;
    __host__ __device__ void init(int M, int N, int G_, int c_) { nM = M / BM; nN = N / BM; nwg = nM * nN; G = G_; c = c_; }
    __host__ __device__ bool next(int i, Unit& u) const {
        const long L = (long)i * G + c; if (L >= nwg) return false;
        int wgid = (int)L; { const int q = nwg / NXCD, r = nwg % NXCD, xcd = wgid % NXCD, off = wgid / NXCD; wgid = (xcd < r ? xcd * (q + 1) : r * (q + 1) + (xcd - r) * q) + off; }
        const int nig = WGM * nN, gid = wgid / nig, fm = gid * WGM, gsz = (nM - fm) < WGM ? (nM - fm) : WGM;
        u.pm = fm + ((wgid % nig) % gsz); u.pn = (wgid % nig) / gsz; return true;
    }
    __device__ __forceinline__ void a_ready(const Unit&) const {}
    __device__ __forceinline__ void done(const Unit&) const {}
};

__device__ __forceinline__ unsigned cvt_pk_bf16(float lo, float hi) { unsigned r; asm volatile("v_cvt_pk_bf16_f32 %0, %1, %2" : "=v"(r) : "v"(lo), "v"(hi)); return r; }
typedef float f32x2 __attribute__((ext_vector_type(2)));
__device__ __forceinline__ f32x2 gelu_pk(f32x2 v) {
    const f32x2 av = __builtin_elementwise_abs(v), d = av * 0.2316418882f + 1.0f;
    f32x2 t; t.x = __builtin_amdgcn_rcpf(d.x); t.y = __builtin_amdgcn_rcpf(d.y);
    f32x2 q = t * 0.5307027145f + (-0.7265760135f); q = q * t + 0.7107068705f; q = q * t + (-0.142248368f); q = q * t + 0.127414796f; q = q * t;
    const f32x2 s = (v * v) * (-0.72134752044f);
    f32x2 e; e.x = __builtin_amdgcn_exp2f(s.x); e.y = __builtin_amdgcn_exp2f(s.y);
    const f32x2 m = v * (q * e), r = v - m;
    f32x2 o; o.x = v.x < 0.f ? m.x : r.x; o.y = v.y < 0.f ? m.y : r.y; return o;
}

template <int ACT  > struct EpiBf16 {
    static constexpr bool PERM = true, AFTER_DRAIN = false; static_assert(ACT == 0 || ACT == 1, "EpiBf16: ACT is 0 (none) or 1 (gelu_pk)");
    bf16_t* O; int ldc; const float* bias; int split_cols; size_t split_stride; float scale0;
    __device__ __forceinline__ void operator()(const f32x4 (&acc)[2][2][4][2], const Unit& u, int wr, int wc, int fr, int fq) const {
        const int row0 = u.pm * BM + wr * 64 + fr; int colt = u.pn * BM; bf16_t* base = O;
        float sc = 1.f; if (split_cols) { const int t = colt / split_cols; base += (size_t)t * split_stride; colt -= t * split_cols; if (t == 0) sc = scale0; }
        const int col0 = colt + wc * 32 + 8 * fq, bcol0 = u.pn * BM + wc * 32 + 8 * fq;
        f32x4 bv[2][2];
#pragma unroll
        for (int bj = 0; bj < 2; ++bj)
#pragma unroll
            for (int n = 0; n < 2; ++n) bv[bj][n] = bias ? *(const f32x4*)(bias + bcol0 + bj * HALF + 4 * n) : (f32x4){0.f, 0.f, 0.f, 0.f};
#pragma unroll
        for (int ai = 0; ai < 2; ++ai)
#pragma unroll
            for (int m = 0; m < 4; ++m) { bf16_t* rowp = base + (size_t)(row0 + ai * HALF + m * 16) * ldc + col0;
#pragma unroll
                for (int bj = 0; bj < 2; ++bj) { f32x4 v0 = acc[ai][bj][m][0] + bv[bj][0], v1 = acc[ai][bj][m][1] + bv[bj][1];
                    if (ACT == 1) { f32x2 a = gelu_pk((f32x2){v0[0], v0[1]}), b = gelu_pk((f32x2){v0[2], v0[3]}), c = gelu_pk((f32x2){v1[0], v1[1]}), d = gelu_pk((f32x2){v1[2], v1[3]});
                        v0 = (f32x4){a.x, a.y, b.x, b.y}; v1 = (f32x4){c.x, c.y, d.x, d.y}; }
                    v0 = v0 * sc; v1 = v1 * sc; u32x4 w; w.x = cvt_pk_bf16(v0[0], v0[1]); w.y = cvt_pk_bf16(v0[2], v0[3]); w.z = cvt_pk_bf16(v1[0], v1[1]); w.w = cvt_pk_bf16(v1[2], v1[3]);
                    *(u32x4*)(rowp + bj * HALF) = w; } }
    }
};
template <class Epi, class Sched, bool ALIGN_EPI = false, bool SP2 = false>
__device__ __forceinline__ void gemm_phase(PG8_LAS unsigned char* lds, const Gemm g, const Sched& S, const Epi& E) {
    int tid_; asm volatile("v_mbcnt_lo_u32_b32 %0, -1, 0\n\tv_mbcnt_hi_u32_b32 %0, -1, %0" : "=v"(tid_)); tid_ += g.wid * 64;
    const int tid = tid_, wid = __builtin_amdgcn_readfirstlane(tid >> 6), lane = tid & 63, wr = wid >> 2, wc = wid & 3, fr = lane & 15, fq = lane >> 4;
    const int K = g.K, nt = K / BK;
    unsigned voffA[2], voffB[2];
#pragma unroll
    for (int i = 0; i < 2; ++i) { int R, C; stage_rc(tid * 16 + i * 8192, R, C); const int Rb = Epi::PERM ? ((R & ~31) + perm32(R & 31)) : R;
        voffA[i] = (unsigned)(R * K + C) * 2u; voffB[i] = (unsigned)(Rb * K + C) * 2u; }
    const size_t kstep = (size_t)(BK * 2);
    const size_t hstep = (size_t)HALF * K * 2;
    const size_t tstep = 2 * hstep;
    const unsigned ldsw = (unsigned)wid * 1024u;
    const int aoff = lds_byte(wr * 64 + fr, fq * 8), boff = lds_byte(wc * 32 + fr, fq * 8);
#define PG8_SA(b, h) (((b) * 2 + (h)) * HTB)
#define PG8_SB(b, h) ((4 + (b) * 2 + (h)) * HTB)
#define PG8_STAGE(bufoff, gbase, voff) do { _Pragma("unroll") for (int _i = 0; _i < 2; ++_i) \
        __builtin_amdgcn_global_load_lds((const unsigned*)((const char*)(gbase) + (voff)[_i]), (PG8_LAS unsigned*)(lds + (bufoff) + ldsw + _i * 8192), 16, 0, 0); } while (0)
#define PG8_LDA(dst, b, h) do { _Pragma("unroll") for (int m = 0; m < 4; ++m) _Pragma("unroll") for (int k = 0; k < 2; ++k) dst[m][k] = *(const PG8_LAS bf16x8*)(lds + PG8_SA(b, h) + aoff + m * 2048 + k * 1024); } while (0)
#define PG8_LDB(dst, b, h) do { _Pragma("unroll") for (int n = 0; n < 2; ++n) _Pragma("unroll") for (int k = 0; k < 2; ++k) dst[n][k] = *(const PG8_LAS bf16x8*)(lds + PG8_SB(b, h) + boff + n * 2048 + k * 1024); } while (0)
#define PG8_MMA(ai, bj, At, Bt) do { __builtin_amdgcn_s_setprio(1); _Pragma("unroll") for (int m = 0; m < 4; ++m) _Pragma("unroll") for (int n = 0; n < 2; ++n) _Pragma("unroll") for (int k = 0; k < 2; ++k) \
        acc[ai][bj][m][n] = __builtin_amdgcn_mfma_f32_16x16x32_bf16(Bt[n][k], At[m][k], acc[ai][bj][m][n], 0, 0, 0); __builtin_amdgcn_s_setprio(0); } while (0)
#define PG8_WAIT_V(n) asm volatile("s_waitcnt vmcnt(" #n ")" ::: "memory")
#define PG8_WAIT_L(n) asm volatile("s_waitcnt lgkmcnt(" #n ")" ::: "memory")
#define PG8_BAR __builtin_amdgcn_s_barrier()
#define PG8_SCHED __builtin_amdgcn_sched_barrier(0)
    Unit cur, nxt; int ui = 0;
    if (!S.next(0, cur)) return;
    f32x4 acc[2][2][4][2];
#pragma unroll
    for (int a = 0; a < 2; ++a)
#pragma unroll
        for (int b = 0; b < 2; ++b)
#pragma unroll
            for (int m = 0; m < 4; ++m)
#pragma unroll
                for (int n = 0; n < 2; ++n) acc[a][b][m][n] = (f32x4){0.f, 0.f, 0.f, 0.f};
    bf16x8 At[4][2], B0[2][2], B1[2][2];
    const char* cA = (const char*)g.A + (size_t)cur.pm * tstep; const char* cB = (const char*)g.Bt + (size_t)cur.pn * tstep;
    S.a_ready(cur);
    if constexpr (SP2) {
        PG8_STAGE(PG8_SB(0, 0), cB, voffB); PG8_STAGE(PG8_SB(0, 1), cB + hstep, voffB); PG8_STAGE(PG8_SA(0, 0), cA, voffA); PG8_STAGE(PG8_SA(0, 1), cA + hstep, voffA);
        if (wr == 1) PG8_BAR;
        PG8_WAIT_V(2); PG8_BAR;
        PG8_STAGE(PG8_SB(1, 0), cB + kstep, voffB); PG8_STAGE(PG8_SA(1, 0), cA + kstep, voffA); PG8_STAGE(PG8_SB(1, 1), cB + hstep + kstep, voffB);
        PG8_WAIT_V(6); PG8_BAR;
    } else {
        PG8_STAGE(PG8_SB(0, 0), cB, voffB); PG8_STAGE(PG8_SA(0, 0), cA, voffA); PG8_STAGE(PG8_SB(0, 1), cB + hstep, voffB); PG8_STAGE(PG8_SA(0, 1), cA + hstep, voffA);
        if (wr == 1) PG8_BAR;
        PG8_WAIT_V(4); PG8_BAR;
        PG8_STAGE(PG8_SB(1, 0), cB + kstep, voffB); PG8_STAGE(PG8_SA(1, 0), cA + kstep, voffA); PG8_STAGE(PG8_SB(1, 1), cB + hstep + kstep, voffB);
        PG8_WAIT_V(6); PG8_BAR;
    }
    for (;;) {
        const bool has_next = S.next(ui + 1, nxt);
        const char* nA = has_next ? (const char*)g.A + (size_t)nxt.pm * tstep : cA; const char* nB = has_next ? (const char*)g.Bt + (size_t)nxt.pn * tstep : cB;
        for (int t = 0; t < nt; t += 2) {
            const bool last = (t == nt - 2);
            const char* a1 = cA + (size_t)(t + 1) * kstep;
            const char* a2 = last ? nA : cA + (size_t)(t + 2) * kstep; const char* b2 = last ? nB : cB + (size_t)(t + 2) * kstep;
            const char* a3 = a2 + kstep; const char* b3 = b2 + kstep;
            if (last && has_next) S.a_ready(nxt);
            if constexpr (SP2) {
            PG8_LDB(B0, 0, 0); PG8_LDB(B1, 0, 1); PG8_SCHED; PG8_LDA(At, 0, 0); PG8_STAGE(PG8_SA(1, 1), a1 + hstep, voffA);
            PG8_WAIT_V(8); PG8_WAIT_L(0); PG8_BAR; PG8_MMA(0, 0, At, B0); PG8_MMA(0, 1, At, B1); PG8_BAR; PG8_SCHED;
            PG8_LDA(At, 0, 1); PG8_STAGE(PG8_SB(0, 0), b2, voffB); PG8_STAGE(PG8_SB(0, 1), b2 + hstep, voffB); PG8_STAGE(PG8_SA(0, 0), a2, voffA);
            PG8_WAIT_V(8); PG8_WAIT_L(0); PG8_BAR; PG8_MMA(1, 0, At, B0); PG8_MMA(1, 1, At, B1); PG8_BAR; PG8_SCHED;
            PG8_LDB(B0, 1, 0); PG8_LDB(B1, 1, 1); PG8_SCHED; PG8_LDA(At, 1, 0); PG8_STAGE(PG8_SA(0, 1), a2 + hstep, voffA);
            PG8_WAIT_V(8); PG8_WAIT_L(0); PG8_BAR; PG8_MMA(0, 0, At, B0); PG8_MMA(0, 1, At, B1); PG8_BAR; PG8_SCHED;
            PG8_LDA(At, 1, 1); PG8_STAGE(PG8_SB(1, 0), b3, voffB); PG8_STAGE(PG8_SB(1, 1), b3 + hstep, voffB); PG8_STAGE(PG8_SA(1, 0), a3, voffA);
            PG8_WAIT_V(8); PG8_WAIT_L(0); PG8_BAR; PG8_MMA(1, 0, At, B0); PG8_MMA(1, 1, At, B1); PG8_BAR; PG8_SCHED;
            } else {
            PG8_LDB(B0, 0, 0); PG8_SCHED; PG8_LDA(At, 0, 0); PG8_STAGE(PG8_SA(1, 1), a1 + hstep, voffA);
            PG8_WAIT_L(8); PG8_BAR; PG8_WAIT_L(0); PG8_MMA(0, 0, At, B0); PG8_BAR; PG8_SCHED;
            PG8_LDB(B1, 0, 1); PG8_STAGE(PG8_SB(0, 0), b2, voffB);
            PG8_BAR; PG8_WAIT_L(0); PG8_MMA(0, 1, At, B1); PG8_BAR;
            PG8_LDA(At, 0, 1); PG8_STAGE(PG8_SA(0, 0), a2, voffA);
            PG8_BAR; PG8_WAIT_L(0); PG8_MMA(1, 0, At, B0); PG8_BAR; PG8_SCHED;
            PG8_STAGE(PG8_SB(0, 1), b2 + hstep, voffB);
            PG8_WAIT_V(6); PG8_BAR; PG8_MMA(1, 1, At, B1); PG8_BAR;
            PG8_LDB(B0, 1, 0); PG8_SCHED; PG8_LDA(At, 1, 0); PG8_STAGE(PG8_SA(0, 1), a2 + hstep, voffA);
            PG8_WAIT_L(8); PG8_BAR; PG8_WAIT_L(0); PG8_MMA(0, 0, At, B0); PG8_BAR; PG8_SCHED;
            PG8_LDB(B1, 1, 1); PG8_STAGE(PG8_SB(1, 0), b3, voffB);
            PG8_BAR; PG8_WAIT_L(0); PG8_MMA(0, 1, At, B1); PG8_BAR;
            PG8_LDA(At, 1, 1); PG8_STAGE(PG8_SA(1, 0), a3, voffA);
            PG8_BAR; PG8_WAIT_L(0); PG8_MMA(1, 0, At, B0); PG8_BAR; PG8_SCHED;
            PG8_STAGE(PG8_SB(1, 1), b3 + hstep, voffB);
            PG8_WAIT_V(6); PG8_BAR; PG8_MMA(1, 1, At, B1); PG8_BAR;
            }
        }
        if constexpr (ALIGN_EPI) { if (wr == 0) PG8_BAR; }
        if constexpr (!Epi::AFTER_DRAIN) { E(acc, cur, wr, wc, fr, fq); S.done(cur); }
        if (!has_next) break;
#pragma unroll
        for (int a = 0; a < 2; ++a)
#pragma unroll
            for (int b = 0; b < 2; ++b)
#pragma unroll
                for (int m = 0; m < 4; ++m)
#pragma unroll
                    for (int n = 0; n < 2; ++n) acc[a][b][m][n] = (f32x4){0.f, 0.f, 0.f, 0.f};
        cur = nxt; cA = nA; cB = nB; ++ui;
        if constexpr (ALIGN_EPI) { if (wr == 1) PG8_BAR; }
    }
    PG8_WAIT_V(0);
    if constexpr (!ALIGN_EPI) { if (wr == 0) PG8_BAR; }
    PG8_BAR;
    if constexpr (Epi::AFTER_DRAIN) { E.fused(acc, cur, wr, wc, fr, fq, lds, wid, lane); S.done(cur); }
#undef PG8_SA
#undef PG8_SB
#undef PG8_STAGE
#undef PG8_LDA
#undef PG8_LDB
#undef PG8_MMA
#undef PG8_WAIT_V
#undef PG8_WAIT_L
#undef PG8_BAR
#undef PG8_SCHED
}
}
#define LAS __attribute__((address_space(3)))
#define XB_TMO      128
#define XB_XCNT(j)  (256  + 64 * (j))
#define XB_XSUB(j)  (1280 + 64 * (j))
#define XB_XGEN(j)  (2304 + 64 * (j))
#define XB_TOP      3328
#define XB_TOPGEN   3392
#define XCD_BAR_WORDS 3456
#define XB_SPIN_CAP (1u << 18)

__device__ __forceinline__ unsigned xb_ld(unsigned* p)              { return __hip_atomic_load(p, __ATOMIC_RELAXED, __HIP_MEMORY_SCOPE_AGENT); }
__device__ __forceinline__ unsigned xb_add(unsigned* p, unsigned v) { return __hip_atomic_fetch_add(p, v, __ATOMIC_RELAXED, __HIP_MEMORY_SCOPE_AGENT); }
__device__ __forceinline__ unsigned xb_xcc_id() { return (unsigned)__builtin_amdgcn_s_getreg((3 << 11) | 20) & 0xFu; }
#define XB_SPIN(cond, bar) do { unsigned _sp = 0; while (cond) { __builtin_amdgcn_s_sleep(1); \
    if ((++_sp & 255u) == 0u) { if (xb_ld(&(bar)[XB_TMO])) break; if (_sp > XB_SPIN_CAP) { atomicAdd(&(bar)[XB_TMO], 1u); break; } } } } while (0)

__device__ __forceinline__ int xb_lane() { int l; asm volatile("v_mbcnt_lo_u32_b32 %0, -1, 0\n\tv_mbcnt_hi_u32_b32 %0, -1, %0" : "=v"(l)); return l; }
struct XcdBarrier {
    bool w0;
    unsigned* bar; unsigned x;
    volatile LAS unsigned* st;
};

__device__ __forceinline__ XcdBarrier xcd_barrier_post(unsigned* bar, volatile LAS unsigned* st, bool w0) {
    XcdBarrier b; b.w0 = w0; b.bar = bar; b.x = xb_xcc_id(); b.st = st;
    if (b.w0 && xb_lane() == 0) (void)xb_add(&bar[XB_XCNT(b.x)], 1u);
    return b;
}
__device__ __forceinline__ void xcd_barrier_complete(unsigned* bar, unsigned x, unsigned& nloc, unsigned& nx) {
    const unsigned G = gridDim.x * gridDim.y * gridDim.z;
    unsigned sum, cnt, mine, sp = 0u;
    for (;;) {
        sum = 0u; cnt = 0u; mine = 0u;
#pragma unroll
        for (unsigned j = 0; j < 16; ++j) { const unsigned c = xb_ld(&bar[XB_XCNT(j)]); sum += c; cnt += (c > 0u) ? 1u : 0u; mine = (j == x) ? c : mine; }
        if (sum == G) break;
        __builtin_amdgcn_s_sleep(1);
        if ((++sp & 255u) == 0u) { if (xb_ld(&bar[XB_TMO])) break; if (sp > XB_SPIN_CAP) { atomicAdd(&bar[XB_TMO], 1u); break; } }
    }
    nloc = mine > 0u ? mine : 1u; nx = cnt > 0u ? cnt : 1u;
}

__device__ __forceinline__ void xcd_barrier(const XcdBarrier& b) {
    asm volatile("s_waitcnt vmcnt(0)" ::: "memory");
    __syncthreads();
    if (b.w0 && xb_lane() == 0) {
        unsigned* bar = b.bar;
        __builtin_amdgcn_s_waitcnt(0);
        unsigned nloc = b.st[0], nx = b.st[1];
        if (nloc == 0u) { xcd_barrier_complete(bar, b.x, nloc, nx); b.st[0] = nloc; b.st[1] = nx; }
        const unsigned old = xb_add(&bar[XB_XSUB(b.x)], 1u);
        const unsigned gen = old / nloc;
        if (old + 1u == (gen + 1u) * nloc) {
            __builtin_amdgcn_fence(__ATOMIC_RELEASE, "agent");
            asm volatile("s_waitcnt vmcnt(0)" ::: "memory");
            const unsigned og = xb_add(&bar[XB_TOP], 1u);
            const unsigned tg = og / nx;
            if (og + 1u == (tg + 1u) * nx) xb_add(&bar[XB_TOPGEN], 1u);
            else XB_SPIN(xb_ld(&bar[XB_TOPGEN]) == tg, bar);
            __builtin_amdgcn_fence(__ATOMIC_ACQUIRE, "agent");
            xb_add(&bar[XB_XGEN(b.x)], 1u);
            asm volatile("s_waitcnt vmcnt(0)" ::: "memory");
        } else {
            XB_SPIN(xb_ld(&bar[XB_XGEN(b.x)]) == gen, bar);
            __builtin_amdgcn_fence(__ATOMIC_ACQUIRE, "agent");
            asm volatile("s_waitcnt vmcnt(0)" ::: "memory");
        }
    }
    __syncthreads();
}
#define GAS __attribute__((address_space(1)))
#ifndef LAS
#define LAS __attribute__((address_space(3)))
#endif
typedef unsigned short bf16;
typedef unsigned v4u __attribute__((ext_vector_type(4)));
typedef unsigned v2u __attribute__((ext_vector_type(2)));
typedef float f32x4 __attribute__((ext_vector_type(4)));
typedef float f32x2 __attribute__((ext_vector_type(2)));
typedef float f32x16 __attribute__((ext_vector_type(16)));
typedef short bf16x8 __attribute__((ext_vector_type(8)));
typedef __bf16 bf2_t __attribute__((ext_vector_type(2)));

constexpr int NWAVES = 8, NTHR = 512;
constexpr int NB = 4, SEQ = 8192, NTOK = NB * SEQ, DM = 1024, MEML = 256, NMEM = NB * MEML;
constexpr int EVW = 1792;
constexpr int C_CQ = 0, C_KA = 256, C_VA = 384, C_KI = 512, C_QB = 576, C_KB = 1088, C_WI = 1600;
constexpr int NEXP = 32, TOPK = 4;
constexpr int NROWS_MAX = NTOK * TOPK + NEXP * 256;
constexpr int NRT_MAX = NROWS_MAX / 256;
constexpr float LN_EPS = 1e-5f;
constexpr float DN_ALPHA = 1.4142135623730951f;
constexpr int SCH = 64, NCHUNK = SEQ / SCH;

constexpr size_t MiB = 1u << 20;
constexpr size_t WS_CTL = 0, CTL_ZERO_BYTES = 1 * MiB;
constexpr size_t WS_ROPE = 1 * MiB;
constexpr size_t WS_APOW = 2 * MiB;
constexpr size_t WS_BB = 5 * MiB;
constexpr size_t WS_WTQ = 6 * MiB;
constexpr size_t WS_WTVB = 7 * MiB;
constexpr size_t WS_WTIN0 = 8 * MiB;
constexpr size_t WS_WTOUT0 = 13 * MiB;
constexpr size_t WS_WTS5IN = 15 * MiB;
constexpr size_t WS_WTS5OUT = 17 * MiB;
constexpr size_t WS_WTXQ = 21 * MiB;
constexpr size_t WS_WTXK = 25 * MiB;
constexpr size_t WS_WTXV = 29 * MiB;
constexpr size_t WS_WTXO = 33 * MiB;
constexpr size_t WS_MEMB = 37 * MiB;
constexpr size_t WS_KX = 39 * MiB;
constexpr size_t WS_VXT = 43 * MiB;
constexpr size_t WS_W1 = 47 * MiB;
constexpr size_t WS_W3 = 63 * MiB;
constexpr size_t WS_KT = 79 * MiB;
constexpr size_t WS_ELOC = 81 * MiB;
constexpr size_t WS_HS = 97 * MiB;
constexpr size_t WS_KI = 105 * MiB;
constexpr size_t WS_KA = 109 * MiB;
constexpr size_t WS_VA = 117 * MiB;
constexpr size_t WS_WI = 125 * MiB;
constexpr size_t WS_TOKE = 126 * MiB;
constexpr size_t WS_TOKP = 127 * MiB;
constexpr size_t WS_WTGU = 128 * MiB;
constexpr size_t WS_WTDN = 384 * MiB;
constexpr size_t WS_XB = 512 * MiB;
constexpr size_t WS_HF = 576 * MiB;
constexpr size_t WS_T = 704 * MiB;
constexpr size_t WS_SCR = 832 * MiB;
constexpr size_t WS_P1 = WS_SCR;
constexpr size_t WS_CQ = WS_SCR + 144 * MiB;
constexpr size_t WS_QAI = WS_SCR + 160 * MiB;
constexpr size_t WS_OAB = WS_SCR + 224 * MiB;
constexpr size_t WS_VBT = WS_SCR + 288 * MiB;
constexpr size_t WS_QX = WS_SCR;
constexpr size_t WS_AX = WS_SCR + 64 * MiB;
constexpr size_t WS_ELIST = WS_SCR + 128 * MiB;
constexpr size_t WS_EGATE = WS_SCR + 132 * MiB;
constexpr size_t WS_RGATE = WS_SCR + 136 * MiB;
constexpr size_t WS_XG = WS_SCR + 144 * MiB;
constexpr size_t WS_ACT = WS_SCR + 416 * MiB;
constexpr size_t WS_U = WS_SCR;
constexpr size_t WS_YG = WS_SCR + 64 * MiB;
constexpr size_t WS_END = WS_SCR + 688 * MiB;
static_assert(WS_END <= (size_t)2047 * MiB, "workspace map");

constexpr int CW_BAR = 4096;
constexpr int CW_CNT = 16384;

constexpr int RING_BYTES = 131072;
constexpr int UP_OFF = RING_BYTES;
constexpr int UP_MISC = UP_OFF;
constexpr int UP_PTR = UP_OFF + 256;
constexpr int UP_SEL = UP_OFF + 1024;
constexpr int UP_TILEE = UP_OFF + 6144;
constexpr int UP_TSTART = UP_TILEE + 576 * 4;
constexpr int UP_CNT = UP_TSTART + 64 * 4;
constexpr int LDS_BYTES = 147456;
static_assert(UP_CNT + 32 * 4 <= LDS_BYTES, "LDS map");

#define LDS_WAIT() asm volatile("s_waitcnt lgkmcnt(0)" ::: "memory")
#define VM_WAIT() asm volatile("s_waitcnt vmcnt(0)" ::: "memory")
__device__ __forceinline__ unsigned f2bf(float f) { unsigned u = __builtin_bit_cast(unsigned, f); return (u + 0x7fffu + ((u >> 16) & 1u)) >> 16; }
__device__ __forceinline__ unsigned pk2(float lo, float hi) { return f2bf(lo) | (f2bf(hi) << 16); }
__device__ __forceinline__ float bflo(unsigned w) { return __builtin_bit_cast(float, w << 16); }
__device__ __forceinline__ float bfhi(unsigned w) { return __builtin_bit_cast(float, w & 0xffff0000u); }
__device__ __forceinline__ float bf2f(bf16 h) { return __builtin_bit_cast(float, (unsigned)h << 16); }
__device__ __forceinline__ float dot2bf(unsigned a, unsigned b, float c) { return __builtin_amdgcn_fdot2_f32_bf16(__builtin_bit_cast(bf2_t, a), __builtin_bit_cast(bf2_t, b), c, false); }
__device__ __forceinline__ float dot8bf(v4u a, v4u b, float c) { c = dot2bf(a.x, b.x, c); c = dot2bf(a.y, b.y, c); c = dot2bf(a.z, b.z, c); return dot2bf(a.w, b.w, c); }
__device__ __forceinline__ float shx(float v, int o, int lane) { return __builtin_bit_cast(float, __builtin_amdgcn_ds_bpermute((lane ^ o) << 2, __builtin_bit_cast(int, v))); }
__device__ __forceinline__ int shxi(int v, int o, int lane) { return __builtin_amdgcn_ds_bpermute((lane ^ o) << 2, v); }
__device__ __forceinline__ float wave_sum(float v, int lane) {
#pragma unroll
    for (int o = 1; o < 64; o <<= 1) v += shx(v, o, lane);
    return v;
}
__device__ __forceinline__ float wave_max(float v, int lane) {
#pragma unroll
    for (int o = 1; o < 64; o <<= 1) v = fmaxf(v, shx(v, o, lane));
    return v;
}
__device__ __forceinline__ int wave_sum_i(int v, int lane) {
#pragma unroll
    for (int o = 1; o < 64; o <<= 1) v += shxi(v, o, lane);
    return v;
}
__device__ __forceinline__ int crow(int r, int hf) { return (r & 3) + 8 * (r >> 2) + 4 * hf; }
__device__ __forceinline__ int rperm(int j) { return j < 16 ? ((j & 1) ? 8 + (j >> 1) : (j >> 1)) : j; }

struct Frame {
    LAS unsigned char* lds;
    int tid, lane, wave, vcu, G;
    float* out;
    unsigned char* ws;
};
__device__ __forceinline__ Frame pframe(const Frame& F) {
    Frame P = F;
    { int l; asm volatile("v_mbcnt_lo_u32_b32 %0, -1, 0\n\tv_mbcnt_hi_u32_b32 %0, -1, %0" : "=v"(l)); P.tid = P.wave * 64 + l; }
    asm volatile("" : "+s"(P.ws), "+s"(P.out), "+v"(P.tid), "+s"(P.vcu), "+s"(P.G));
    P.lane = P.tid & 63;
    return P;
}
__device__ __forceinline__ const float* inp(const Frame& F, int i) {
    const unsigned long long p = *(const LAS unsigned long long*)(F.lds + UP_PTR + 8 * i);
    const unsigned lo = (unsigned)__builtin_amdgcn_readfirstlane((int)(unsigned)p), hi = (unsigned)__builtin_amdgcn_readfirstlane((int)(unsigned)(p >> 32));
    return (const float*)(((unsigned long long)hi << 32) | lo);
}
template <class T> __device__ __forceinline__ T* wsp(const Frame& F, size_t off) { return (T*)(F.ws + off); }

namespace pg8 {
struct EpiRope {
    static constexpr bool PERM = true, AFTER_DRAIN = false;
    bf16_t* O; int ldc; const f32x2* rope;
    __device__ __forceinline__ void operator()(const f32x4 (&acc)[2][2][4][2], const Unit& u, int wr, int wc, int fr, int fq) const {
        const int row0 = u.pm * BM + wr * 64 + fr; const int col0 = u.pn * BM + wc * 32 + 8 * fq;
#pragma unroll
        for (int ai = 0; ai < 2; ++ai)
#pragma unroll
            for (int m = 0; m < 4; ++m) { const int row = row0 + ai * HALF + m * 16; const int pos = row & (SEQ - 1); bf16_t* rowp = O + (size_t)row * ldc + col0;
#pragma unroll
                for (int bj = 0; bj < 2; ++bj) { f32x4 v0 = acc[ai][bj][m][0], v1 = acc[ai][bj][m][1];
                    const int c64 = (col0 + bj * HALF) & 63;
                    if (c64 < 16) { const f32x2* rp = rope + pos * 8 + (c64 >> 1);
                        const f32x2 r0 = rp[0], r1 = rp[1], r2 = rp[2], r3 = rp[3];
                        f32x4 w0, w1;
                        w0[0] = v0[0] * r0.x - v0[1] * r0.y; w0[1] = v0[1] * r0.x + v0[0] * r0.y;
                        w0[2] = v0[2] * r1.x - v0[3] * r1.y; w0[3] = v0[3] * r1.x + v0[2] * r1.y;
                        w1[0] = v1[0] * r2.x - v1[1] * r2.y; w1[1] = v1[1] * r2.x + v1[0] * r2.y;
                        w1[2] = v1[2] * r3.x - v1[3] * r3.y; w1[3] = v1[3] * r3.x + v1[2] * r3.y;
                        v0 = w0; v1 = w1; }
                    u32x4 w; w.x = cvt_pk_bf16(v0[0], v0[1]); w.y = cvt_pk_bf16(v0[2], v0[3]); w.z = cvt_pk_bf16(v1[0], v1[1]); w.w = cvt_pk_bf16(v1[2], v1[3]);
                    *(u32x4*)(rowp + bj * HALF) = w; } }
    }
};
struct EpiResF32 {
    static constexpr bool PERM = false, AFTER_DRAIN = false;
    const float* R; float* T; int ldc; float alpha;
    __device__ __forceinline__ void operator()(const f32x4 (&acc)[2][2][4][2], const Unit& u, int wr, int wc, int fr, int fq) const {
        const int row0 = u.pm * BM + wr * 64 + fr; const int col0 = u.pn * BM + wc * 32 + 4 * fq;
#pragma unroll
        for (int ai = 0; ai < 2; ++ai)
#pragma unroll
            for (int m = 0; m < 4; ++m) { const size_t off = (size_t)(row0 + ai * HALF + m * 16) * ldc + col0;
#pragma unroll
                for (int bj = 0; bj < 2; ++bj)
#pragma unroll
                    for (int n = 0; n < 2; ++n) { const f32x4 r = *(const f32x4*)(R + off + bj * HALF + n * 16); *(f32x4*)(T + off + bj * HALF + n * 16) = r * alpha + acc[ai][bj][m][n]; } }
    }
};
struct EpiGluRes {
    static constexpr bool PERM = false, AFTER_DRAIN = false;
    const float* R; float* T; int ldc; float alpha;
    __device__ __forceinline__ void operator()(const f32x4 (&acc)[2][2][4][2], const Unit& u, int wr, int wc, int fr, int fq) const {
        const int row0 = u.pm * BM + wr * 64 + fr; const int col0 = u.pn * HALF + wc * 32 + 4 * fq;
#pragma unroll
        for (int ai = 0; ai < 2; ++ai)
#pragma unroll
            for (int m = 0; m < 4; ++m) { const size_t off = (size_t)(row0 + ai * HALF + m * 16) * ldc + col0;
#pragma unroll
                for (int n = 0; n < 2; ++n) { const f32x4 r = *(const f32x4*)(R + off + n * 16); const f32x4 v = acc[ai][0][m][n], g = acc[ai][1][m][n]; f32x4 o;
#pragma unroll
                    for (int i = 0; i < 4; ++i) o[i] = r[i] * alpha + v[i] * __builtin_amdgcn_rcpf(1.0f + __expf(-g[i]));
                    *(f32x4*)(T + off + n * 16) = o; } }
    }
};
struct EpiSwiGlu {
    static constexpr bool PERM = true, AFTER_DRAIN = false;
    bf16_t* O; const float* bgu;
    __device__ __forceinline__ void operator()(const f32x4 (&acc)[2][2][4][2], const Unit& u, int wr, int wc, int fr, int fq) const {
        const int e = u.pn >> 3, ct = u.pn & 7; const int row0 = u.pm * BM + wr * 64 + fr; const int col0 = ct * HALF + wc * 32 + 8 * fq;
        const float* bg = bgu + (size_t)e * 2048 + col0; const float* bu = bg + 1024;
        f32x4 g0 = *(const f32x4*)bg, g1 = *(const f32x4*)(bg + 4), u0 = *(const f32x4*)bu, u1 = *(const f32x4*)(bu + 4);
#pragma unroll
        for (int ai = 0; ai < 2; ++ai)
#pragma unroll
            for (int m = 0; m < 4; ++m) { bf16_t* rowp = O + (size_t)(row0 + ai * HALF + m * 16) * 1024 + col0;
                f32x4 a0 = acc[ai][0][m][0] + g0, a1 = acc[ai][0][m][1] + g1, b0 = acc[ai][1][m][0] + u0, b1 = acc[ai][1][m][1] + u1; float o[8];
#pragma unroll
                for (int i = 0; i < 4; ++i) { float g = fminf(a0[i], 7.0f), up = fminf(fmaxf(b0[i], -7.0f), 7.0f); o[i] = g * __builtin_amdgcn_rcpf(1.0f + __expf(-1.702f * g)) * (up + 1.0f);
                    g = fminf(a1[i], 7.0f); up = fminf(fmaxf(b1[i], -7.0f), 7.0f); o[4 + i] = g * __builtin_amdgcn_rcpf(1.0f + __expf(-1.702f * g)) * (up + 1.0f); }
                u32x4 w; w.x = cvt_pk_bf16(o[0], o[1]); w.y = cvt_pk_bf16(o[2], o[3]); w.z = cvt_pk_bf16(o[4], o[5]); w.w = cvt_pk_bf16(o[6], o[7]);
                *(u32x4*)rowp = w; }
    }
};
struct EpiDown {
    static constexpr bool PERM = true, AFTER_DRAIN = false;
    bf16_t* O; const float* bdn; const float* rgate;
    __device__ __forceinline__ void operator()(const f32x4 (&acc)[2][2][4][2], const Unit& u, int wr, int wc, int fr, int fq) const {
        const int e = u.pn >> 2, ct = u.pn & 3; const int row0 = u.pm * BM + wr * 64 + fr; const int col0 = ct * BM + wc * 32 + 8 * fq;
        const float* bp = bdn + (size_t)e * 1024 + col0;
        f32x4 bv[2][2];
#pragma unroll
        for (int bj = 0; bj < 2; ++bj)
#pragma unroll
            for (int n = 0; n < 2; ++n) bv[bj][n] = *(const f32x4*)(bp + bj * HALF + 4 * n);
#pragma unroll
        for (int ai = 0; ai < 2; ++ai)
#pragma unroll
            for (int m = 0; m < 4; ++m) { const int row = row0 + ai * HALF + m * 16; const float gt = rgate[row]; bf16_t* rowp = O + (size_t)row * 1024 + col0;
#pragma unroll
                for (int bj = 0; bj < 2; ++bj) { const f32x4 v0 = (acc[ai][bj][m][0] + bv[bj][0]) * gt, v1 = (acc[ai][bj][m][1] + bv[bj][1]) * gt;
                    u32x4 w; w.x = cvt_pk_bf16(v0[0], v0[1]); w.y = cvt_pk_bf16(v0[2], v0[3]); w.z = cvt_pk_bf16(v1[0], v1[1]); w.w = cvt_pk_bf16(v1[2], v1[3]);
                    *(u32x4*)(rowp + bj * HALF) = w; } }
    }
};
template <int NCT> struct MoeOrder {
    const PG8_LAS int* tile_e; int nrt, G, vc;
    __device__ __forceinline__ bool next(int i, Unit& u) const {
        const int L = i * G + vc; const int rt = L / NCT, ct = L % NCT; if (rt >= nrt) return false;
        u.pm = rt; u.pn = __builtin_amdgcn_readfirstlane(tile_e[rt]) * NCT + ct; return true;
    }
    __device__ __forceinline__ void a_ready(const Unit&) const {}
    __device__ __forceinline__ void done(const Unit&) const {}
};
}
__device__ __forceinline__ int map_col(int id, int r) {
    switch (id) {
    default: return r;
    case 1: {
        if (r < 256) return r;
        if (r < 384) { const int q = r - 256; return 256 + (q & ~63) + rperm(q & 63); }
        if (r < 576) return r;
        if (r < 1088) return 584 + (r - 576);
        if (r < 1600) return 1096 + (r - 1088);
        if (r < 1608) return 576 + (r - 1600);
        return -1; }
    case 2: return (r & ~63) + rperm(r & 63);
    case 3: { const int t = r >> 8, w = r & 255; return w < 128 ? 128 * t + w : 1024 + 128 * t + (w - 128); }
    case 4: return 1024 + r;
    case 5: return 1608 + r;
    }
}
__device__ __forceinline__ void tr_item(const float* W, int K, int Nsrc, bf16* WT, LAS float* scr, int kb, int nb, int lane, int mapid, float scale) {
    const int k0 = 64 * kb, n0 = 32 * nb;
    const int sc = map_col(mapid, n0 + (lane & 31));
#pragma unroll 8
    for (int i = 0; i < 32; ++i) { const int kk = 2 * i + (lane >> 5); scr[kk * 33 + (lane & 31)] = (sc >= 0) ? W[(size_t)(k0 + kk) * Nsrc + sc] * scale : 0.f; }
    LDS_WAIT(); asm volatile("" ::: "memory");
    const int c = lane & 7;
#pragma unroll
    for (int j = 0; j < 4; ++j) { const int n = (lane >> 3) + 8 * j; const LAS float* s = scr + (8 * c) * 33 + n;
        v4u o; o.x = pk2(s[0 * 33], s[1 * 33]); o.y = pk2(s[2 * 33], s[3 * 33]); o.z = pk2(s[4 * 33], s[5 * 33]); o.w = pk2(s[6 * 33], s[7 * 33]);
        *(v4u*)(WT + (size_t)(n0 + n) * K + k0 + 8 * c) = o; }
    LDS_WAIT(); asm volatile("" ::: "memory");
}
__device__ __forceinline__ void tr_item_v4(const float* W, int K, int Nsrc, bf16* WT, LAS float* scr, int kb, int nb, int lane, int mapid, float scale) {
    const int k0 = 64 * kb, n0 = 32 * nb, n4 = 4 * (lane & 7);
    const int sc = map_col(mapid, n0 + n4);
    f32x4 v[8];
#pragma unroll
    for (int i = 0; i < 8; ++i) v[i] = *(const f32x4*)(W + (size_t)(k0 + 8 * i + (lane >> 3)) * Nsrc + sc);
#pragma unroll
    for (int i = 0; i < 8; ++i) { LAS float* d = scr + (8 * i + (lane >> 3)) * 33 + n4; d[0] = v[i][0] * scale; d[1] = v[i][1] * scale; d[2] = v[i][2] * scale; d[3] = v[i][3] * scale; }
    LDS_WAIT(); asm volatile("" ::: "memory");
    const int c = lane & 7;
#pragma unroll
    for (int j = 0; j < 4; ++j) { const int n = (lane >> 3) + 8 * j; const LAS float* s = scr + (8 * c) * 33 + n;
        v4u o; o.x = pk2(s[0 * 33], s[1 * 33]); o.y = pk2(s[2 * 33], s[3 * 33]); o.z = pk2(s[4 * 33], s[5 * 33]); o.w = pk2(s[6 * 33], s[7 * 33]);
        *(v4u*)(WT + (size_t)(n0 + n) * K + k0 + 8 * c) = o; }
    LDS_WAIT(); asm volatile("" ::: "memory");
}
struct TrJob { const float* src; bf16* dst; int K, Nsrc, Ndst, batch, mapid; float scale; };
__device__ __forceinline__ TrJob tr_job(const Frame& F, int j) {
    TrJob t; t.batch = 1; t.mapid = 0; t.scale = 1.f; t.K = 1024; t.Nsrc = 1024; t.Ndst = 1024;
    switch (j) {
    case 0: t.src = inp(F, 2); t.dst = wsp<bf16>(F, WS_WTIN0); t.Nsrc = 2120; t.Ndst = EVW; t.mapid = 1; break;
    case 1: t.src = inp(F, 4); t.dst = wsp<bf16>(F, WS_WTQ); t.K = 256; t.Nsrc = 512; t.Ndst = 512; t.mapid = 2; break;
    case 2: t.src = inp(F, 5); t.dst = wsp<bf16>(F, WS_WTQ) + 512 * 256; t.K = 256; t.Nsrc = 512; t.Ndst = 512; t.mapid = 2; t.scale = 0.125f; break;
    case 3: t.src = inp(F, 8); t.dst = wsp<bf16>(F, WS_WTOUT0); break;
    case 4: t.src = inp(F, 9); t.dst = wsp<bf16>(F, WS_WTS5IN); break;
    case 5: t.src = inp(F, 18); t.dst = wsp<bf16>(F, WS_WTS5OUT); t.Nsrc = 2048; t.Ndst = 2048; t.mapid = 3; break;
    case 6: t.src = inp(F, 21); t.dst = wsp<bf16>(F, WS_WTXQ); t.batch = 2; t.scale = 0.0625f; break;
    case 7: t.src = inp(F, 22); t.dst = wsp<bf16>(F, WS_WTXK); t.Nsrc = 2048; t.batch = 2; break;
    case 8: t.src = inp(F, 22); t.dst = wsp<bf16>(F, WS_WTXV); t.Nsrc = 2048; t.batch = 2; t.mapid = 4; break;
    case 9: t.src = inp(F, 23); t.dst = wsp<bf16>(F, WS_WTXO); t.batch = 2; break;
    case 10: t.src = inp(F, 28); t.dst = wsp<bf16>(F, WS_WTGU); t.Nsrc = 2048; t.Ndst = 2048; t.mapid = 3; t.batch = 64; break;
    case 11: t.src = inp(F, 30); t.dst = wsp<bf16>(F, WS_WTDN); t.batch = 64; break;
    default: t.src = inp(F, 2); t.dst = wsp<bf16>(F, WS_WTVB); t.Nsrc = 2120; t.Ndst = 512; t.mapid = 5; break;
    }
    return t;
}
__device__ __forceinline__ void p0_prologue(const Frame& F) {
    LAS float* scr = (LAS float*)(F.lds + F.wave * 16384);
    const int gw = F.vcu * NWAVES + F.wave, NGW = F.G * NWAVES;
    for (int j = 12; j >= 0; --j) {
        const TrJob t = tr_job(F, j);
        const int nkb = t.K / 64, nnb = t.Ndst / 32, per = nkb * nnb, total = per * t.batch;
        for (int it = gw; it < total; it += NGW) {
            const int bi = it / per, r = it - bi * per, kb = r / nnb, nb = r - kb * nnb;
            if (t.mapid == 1 || t.mapid == 2) tr_item(t.src + (size_t)bi * t.K * t.Nsrc, t.K, t.Nsrc, t.dst + (size_t)bi * t.Ndst * t.K, scr, kb, nb, F.lane, t.mapid, t.scale);
            else tr_item_v4(t.src + (size_t)bi * t.K * t.Nsrc, t.K, t.Nsrc, t.dst + (size_t)bi * t.Ndst * t.K, scr, kb, nb, F.lane, t.mapid, t.scale);
        }
    }
    const int gt = F.vcu * NTHR + F.tid, NGT = F.G * NTHR;
    { const float* x = inp(F, 0); bf16* xb = wsp<bf16>(F, WS_XB);
      for (int i = gt; i < NTOK * DM / 8; i += NGT) { const f32x4 a = *(const f32x4*)(x + (size_t)i * 8), b = *(const f32x4*)(x + (size_t)i * 8 + 4);
          v4u o; o.x = pk2(a[0], a[1]); o.y = pk2(a[2], a[3]); o.z = pk2(b[0], b[1]); o.w = pk2(b[2], b[3]); *(v4u*)(xb + (size_t)i * 8) = o; }
      const float* mm = inp(F, 1); bf16* mb = wsp<bf16>(F, WS_MEMB);
      for (int i = gt; i < NMEM * DM / 8; i += NGT) { const f32x4 a = *(const f32x4*)(mm + (size_t)i * 8), b = *(const f32x4*)(mm + (size_t)i * 8 + 4);
          v4u o; o.x = pk2(a[0], a[1]); o.y = pk2(a[2], a[3]); o.z = pk2(b[0], b[1]); o.w = pk2(b[2], b[3]); *(v4u*)(mb + (size_t)i * 8) = o; } }
    { f32x2* rope = wsp<f32x2>(F, WS_ROPE);
      for (int i = gt; i < SEQ * 8; i += NGT) { const int pos = i >> 3, k = i & 7; const float inv = (float)pow(500000.0, -(double)k / 8.0); const float ang = (float)pos * inv;
          rope[i] = (f32x2){(float)cos((double)ang), (float)sin((double)ang)}; } }
    { const float* log_dt = inp(F, 10); const float* lre = inp(F, 11); const float* lim = inp(F, 12); const float* bre = inp(F, 13); const float* bim = inp(F, 14);
      f32x2* apow = wsp<f32x2>(F, WS_APOW); f32x2* bb = wsp<f32x2>(F, WS_BB);
      for (int i = gt; i < 64 * 64 * 65; i += NGT) { const int gp = i / 65, k = i - gp * 65, g = gp >> 6;
          const double dt = exp((double)log_dt[g]), lr = lre[gp], li = lim[gp]; const double mag = exp(lr * dt * k), ang = li * dt * k;
          apow[i] = (f32x2){(float)(mag * cos(ang)), (float)(mag * sin(ang))}; }
      for (int i = gt; i < 64 * 64 * 16; i += NGT) { const int gp = i >> 4, g = gp >> 6;
          const double dt = exp((double)log_dt[g]), lr = lre[gp], li = lim[gp]; const double mag = exp(lr * dt), ar = mag * cos(li * dt), ai = mag * sin(li * dt);
          const double den = lr * lr + li * li, cr = ((ar - 1.0) * lr + ai * li) / den, ci = (ai * lr - (ar - 1.0) * li) / den; const double br = bre[i], bi = bim[i];
          bb[i] = (f32x2){(float)(cr * br - ci * bi), (float)(cr * bi + ci * br)}; } }
}

__device__ __forceinline__ void ln_row_store(const Frame& F, f32x4 (&v)[4], const float* g, const float* b, float* dstF, bf16* dstB) {
    float s = 0.f;
#pragma unroll
    for (int j = 0; j < 4; ++j) s += (v[j][0] + v[j][1]) + (v[j][2] + v[j][3]);
    const float mean = wave_sum(s, F.lane) * (1.f / DM); float s2 = 0.f;
#pragma unroll
    for (int j = 0; j < 4; ++j) { v[j] = v[j] - mean; s2 += (v[j][0] * v[j][0] + v[j][1] * v[j][1]) + (v[j][2] * v[j][2] + v[j][3] * v[j][3]); }
    const float rstd = 1.f / sqrtf(wave_sum(s2, F.lane) * (1.f / DM) + LN_EPS);
#pragma unroll
    for (int j = 0; j < 4; ++j) { const int c = 4 * F.lane + 256 * j; const f32x4 gg = *(const f32x4*)(g + c), bv = *(const f32x4*)(b + c);
        const f32x4 o = v[j] * rstd * gg + bv; *(f32x4*)(dstF + c) = o;
        v2u w; w.x = pk2(o[0], o[1]); w.y = pk2(o[2], o[3]); *(v2u*)(dstB + c) = w; }
}
__device__ __forceinline__ void ln_phase(const Frame& F, const float* T, const float* g, const float* b, float* dstF, bf16* dstB) {
    const int gw = F.vcu * NWAVES + F.wave, NGW = F.G * NWAVES;
    for (int m = gw; m < NTOK; m += NGW) { f32x4 v[4];
#pragma unroll
        for (int j = 0; j < 4; ++j) v[j] = *(const f32x4*)(T + (size_t)m * DM + 4 * F.lane + 256 * j);
        ln_row_store(F, v, g, b, dstF + (size_t)m * DM, dstB + (size_t)m * DM); }
}

__device__ __forceinline__ void p2_postproc(const Frame& F) {
    const int gw = F.vcu * NWAVES + F.wave, NGW = F.G * NWAVES, lane = F.lane;
    const bf16* P1 = wsp<bf16>(F, WS_P1); bf16* CQ = wsp<bf16>(F, WS_CQ); bf16* KI = wsp<bf16>(F, WS_KI); bf16* KA = wsp<bf16>(F, WS_KA); bf16* VA = wsp<bf16>(F, WS_VA);
    float* WI = wsp<float>(F, WS_WI); const f32x2* rope = wsp<f32x2>(F, WS_ROPE);
    const float* qg = inp(F, 3); const float* kg = inp(F, 6); const float* kb = inp(F, 7);
    const f32x4 qg4 = *(const f32x4*)(qg + 4 * lane); const float kgl = kg[lane], kbl = kb[lane];
    for (int tok = gw; tok < NTOK; tok += NGW) {
        const bf16* row = P1 + (size_t)tok * EVW; const int pos = tok & (SEQ - 1);
        { const v2u w = *(const v2u*)(row + C_CQ + 4 * lane); float v0 = bflo(w.x), v1 = bfhi(w.x), v2 = bflo(w.y), v3 = bfhi(w.y);
          const float ss = wave_sum(v0 * v0 + v1 * v1 + v2 * v2 + v3 * v3, lane); const float rs = 1.f / sqrtf(ss * (1.f / 256.f) + LN_EPS);
          v2u o; o.x = pk2(v0 * rs * qg4[0], v1 * rs * qg4[1]); o.y = pk2(v2 * rs * qg4[2], v3 * rs * qg4[3]); *(v2u*)(CQ + (size_t)tok * 256 + 4 * lane) = o; }
        { const float v = bf2f(row[C_KI + lane]); const float mean = wave_sum(v, lane) * (1.f / 64.f); const float d = v - mean; const float var = wave_sum(d * d, lane) * (1.f / 64.f);
          const float y = d * (1.f / sqrtf(var + LN_EPS)) * kgl + kbl; const float partner = shx(y, 8, lane);
          float o = y; int dst = lane;
          if (lane < 16) { const int i = lane & 7; const f32x2 cs = rope[pos * 8 + i];
              if (lane < 8) { o = y * cs.x - partner * cs.y; dst = 2 * lane; } else { o = y * cs.x + partner * cs.y; dst = 2 * (lane - 8) + 1; } }
          KI[(size_t)tok * 64 + dst] = (bf16)f2bf(o); }
        { const unsigned w = *(const unsigned*)(row + C_KA + 2 * lane); float t1 = bflo(w), t2 = bfhi(w); const int j = (2 * lane) & 63;
          if (j < 16) { const f32x2 cs = rope[pos * 8 + (j >> 1)]; const float a = t1 * cs.x - t2 * cs.y, b = t2 * cs.x + t1 * cs.y; t1 = a; t2 = b; }
          *(unsigned*)(KA + (size_t)tok * 128 + 2 * lane) = pk2(t1, t2);
          *(unsigned*)(VA + (size_t)tok * 128 + 2 * lane) = *(const unsigned*)(row + C_VA + 2 * lane); }
        if (lane < 8) WI[(size_t)tok * 8 + lane] = bf2f(row[C_WI + lane]) * 0.35355339059327373f;
    }
    const int gt = F.vcu * NTHR + F.tid, NGT = F.G * NTHR;
    const f32x2* apow = wsp<f32x2>(F, WS_APOW); const f32x2* bb = wsp<f32x2>(F, WS_BB);
    const float* cre = inp(F, 15); const float* cim = inp(F, 16);
    bf16* W1 = wsp<bf16>(F, WS_W1); bf16* W3 = wsp<bf16>(F, WS_W3); bf16* KT = wsp<bf16>(F, WS_KT);
    for (int i = gt; i < 64 * 128 * 1024 / 8; i += NGT) { const int e0 = i * 8, g = e0 >> 17, rem = e0 & 131071, rp = rem >> 10, k = rem & 1023, ri = rp >> 6, p = rp & 63, s = k >> 4, c0 = k & 15;
        const f32x2 a = apow[(g * 64 + p) * 65 + (63 - s)]; float o[8];
#pragma unroll
        for (int q = 0; q < 8; ++q) { const f32x2 b = bb[(g * 64 + p) * 16 + c0 + q]; o[q] = ri == 0 ? a.x * b.x - a.y * b.y : a.x * b.y + a.y * b.x; }
        v4u w; w.x = pk2(o[0], o[1]); w.y = pk2(o[2], o[3]); w.z = pk2(o[4], o[5]); w.w = pk2(o[6], o[7]); *(v4u*)(W1 + (size_t)e0) = w; }
    for (int i = gt; i < 64 * 1024 * 128 / 8; i += NGT) { const int e0 = i * 8, g = e0 >> 17, rem = e0 & 131071, tc = rem >> 7, k = rem & 127, t = tc >> 4, c = tc & 15, ri = k >> 6, p0 = k & 63; float o[8];
#pragma unroll
        for (int q = 0; q < 8; ++q) { const int p = p0 + q; const f32x2 a = apow[(g * 64 + p) * 65 + (t + 1)]; const float cr = cre[(g * 16 + c) * 64 + p], ci = cim[(g * 16 + c) * 64 + p];
            o[q] = ri == 0 ? cr * a.x - ci * a.y : -(cr * a.y + ci * a.x); }
        v4u w; w.x = pk2(o[0], o[1]); w.y = pk2(o[2], o[3]); w.z = pk2(o[4], o[5]); w.w = pk2(o[6], o[7]); *(v4u*)(W3 + (size_t)e0) = w; }
    for (int i = gt; i < 64 * 64 * 256; i += NGT) { const int g = i >> 14, tau = (i >> 8) & 63, c = (i >> 4) & 15, c2 = i & 15; float acc = 0.f;
        for (int p = 0; p < 64; ++p) { const f32x2 a = apow[(g * 64 + p) * 65 + tau]; const float cr = cre[(g * 16 + c) * 64 + p], ci = cim[(g * 16 + c) * 64 + p]; const f32x2 b = bb[(g * 64 + p) * 16 + c2];
            const float xr = cr * a.x - ci * a.y, xi = cr * a.y + ci * a.x; acc += xr * b.x - xi * b.y; }
        KT[i] = (bf16)f2bf(acc); }
}

__device__ __forceinline__ unsigned rope1(unsigned w, f32x2 cs) { const float t1 = bflo(w), t2 = bfhi(w); return pk2(t1 * cs.x - t2 * cs.y, t2 * cs.x + t1 * cs.y); }
__device__ __forceinline__ bf16x8 rope8(bf16x8 f, const f32x2* cs) { v4u w = __builtin_bit_cast(v4u, f); w.x = rope1(w.x, cs[0]); w.y = rope1(w.y, cs[1]); w.z = rope1(w.z, cs[2]); w.w = rope1(w.w, cs[3]); return __builtin_bit_cast(bf16x8, w); }
__device__ __forceinline__ unsigned f16key(float s) {
    const _Float16 h = (_Float16)s; unsigned u = (unsigned)__builtin_bit_cast(unsigned short, h);
    return (u & 0x8000u) ? (~u & 0xffffu) : (u | 0x8000u);
}
__device__ __forceinline__ int count_ge(const LAS bf16* row, int L, unsigned X, int lane) {
    int cnt = 0;
    for (int c = lane; c < (L >> 3); c += 64) { const v4u w = *(const LAS v4u*)(row + 8 * c);
        cnt += ((w.x & 0xffffu) >= X) + ((w.x >> 16) >= X) + ((w.y & 0xffffu) >= X) + ((w.y >> 16) >= X) + ((w.z & 0xffffu) >= X) + ((w.z >> 16) >= X) + ((w.w & 0xffffu) >= X) + ((w.w >> 16) >= X); }
    return wave_sum_i(cnt, lane);
}
__device__ __forceinline__ void dsa_unit(const Frame& F, int b, int qg) {
    const int lane = F.lane, wave = F.wave, m = lane & 31, hf = lane >> 5;
    const bf16* QAI = wsp<bf16>(F, WS_QAI); const bf16* KI = wsp<bf16>(F, WS_KI); const bf16* KA = wsp<bf16>(F, WS_KA); const bf16* VA = wsp<bf16>(F, WS_VA);
    const float* WI = wsp<float>(F, WS_WI); bf16* OAB = wsp<bf16>(F, WS_OAB); const f32x2* rope = wsp<f32x2>(F, WS_ROPE);
    LAS bf16* SC = (LAS bf16*)F.lds;
    LAS bf16* SEL = (LAS bf16*)(F.lds + UP_SEL);
    const int t0 = qg * 8, nkeys = t0 + 8, ntile = (nkeys + 31) >> 5, L = ntile * 32;
    const size_t tb = (size_t)b * SEQ;
    {
        const int qq = 2 * ((m >> 2) & 1) + (m >> 4), head = (m & 3) + 4 * ((m >> 3) & 1);
        bf16x8 Af[2][4]; float wv[2][2][8];
#pragma unroll
        for (int mt = 0; mt < 2; ++mt) { const bf16* qp = QAI + (tb + t0 + 4 * mt + qq) * 1024 + 512 + head * 64 + 8 * hf;
#pragma unroll
            for (int kk = 0; kk < 4; ++kk) Af[mt][kk] = *(const bf16x8*)(qp + 16 * kk);
            Af[mt][0] = rope8(Af[mt][0], rope + (size_t)(t0 + 4 * mt + qq) * 8 + 4 * hf);
#pragma unroll
            for (int q2 = 0; q2 < 2; ++q2) { const float* wp = WI + (tb + t0 + 4 * mt + 2 * hf + q2) * 8; const f32x4 a = *(const f32x4*)wp, c = *(const f32x4*)(wp + 4);
                wv[mt][q2][0] = a[0]; wv[mt][q2][1] = a[1]; wv[mt][q2][2] = a[2]; wv[mt][q2][3] = a[3]; wv[mt][q2][4] = c[0]; wv[mt][q2][5] = c[1]; wv[mt][q2][6] = c[2]; wv[mt][q2][7] = c[3]; } }
        for (int tile = wave; tile < ntile; tile += NWAVES) {
            const int key = 32 * tile + m; const bf16* kp = KI + (tb + key) * 64 + 8 * hf;
            bf16x8 Bf[4];
#pragma unroll
            for (int kk = 0; kk < 4; ++kk) Bf[kk] = *(const bf16x8*)(kp + 16 * kk);
#pragma unroll
            for (int mt = 0; mt < 2; ++mt) { f32x16 acc;
#pragma unroll
                for (int r = 0; r < 16; ++r) acc[r] = 0.f;
#pragma unroll
                for (int kk = 0; kk < 4; ++kk) acc = __builtin_amdgcn_mfma_f32_32x32x16_bf16(Af[mt][kk], Bf[kk], acc, 0, 0, 0);
#pragma unroll
                for (int q2 = 0; q2 < 2; ++q2) { float s = 0.f;
#pragma unroll
                    for (int h = 0; h < 8; ++h) s += wv[mt][q2][h] * fmaxf(acc[8 * q2 + h], 0.f);
                    const int ql = 4 * mt + 2 * hf + q2;
                    SC[ql * SEQ + key] = (bf16)((key <= t0 + ql) ? f16key(s) : 0u); } }
        }
    }
    __syncthreads();
    const int ql = wave, t = t0 + ql, n = t + 1; int nsel;
    const LAS bf16* row = SC + ql * SEQ; LAS bf16* sel = SEL + ql * 256;
    if (n <= 256) { for (int i = lane; i < n; i += 64) sel[i] = (bf16)i; nsel = n; }
    else {
        unsigned T = 0;
        for (int bit = 15; bit >= 0; --bit) { const unsigned cand = T | (1u << bit); if (count_ge(row, L, cand, lane) >= 256) T = cand; }
        const int cgt = count_ge(row, L, T + 1u, lane), need = 256 - cgt;
        int bgt = 0, beq = 0; const unsigned long long lt = (1ull << lane) - 1ull;
        for (int i0 = 0; i0 < L; i0 += 64) { const int i = i0 + lane; const unsigned k = (i < L) ? (unsigned)row[i] : 0u; const bool gt = k > T, eq = (k == T);
            const unsigned long long mg = __ballot(gt), me = __ballot(eq); const int pg = __popcll(mg & lt), pe = __popcll(me & lt);
            if (gt) sel[bgt + pg] = (bf16)i;
            if (eq && (beq + pe) < need) sel[cgt + beq + pe] = (bf16)i;
            bgt += __popcll(mg); beq += __popcll(me); }
        nsel = 256;
    }
    LDS_WAIT(); asm volatile("" ::: "memory");
    {
        LAS bf16* qs = (LAS bf16*)(F.lds + ql * (SEQ * 2));
        LAS float* P = (LAS float*)(F.lds + ql * (SEQ * 2) + 1024);
        { v4u w = *(const v4u*)(QAI + (tb + t) * 1024 + 8 * lane);
          if ((lane & 7) < 2) w = __builtin_bit_cast(v4u, rope8(__builtin_bit_cast(bf16x8, w), rope + (size_t)t * 8 + 4 * (lane & 7)));
          *(LAS v4u*)(qs + 8 * lane) = w; }
        LDS_WAIT(); asm volatile("" ::: "memory");
#pragma unroll 1
        for (int j = 0; j < 4; ++j) { const int slot = lane + 64 * j; const bool valid = slot < nsel; const int key = valid ? (int)sel[slot] : 0; const bf16* kp = KA + (tb + key) * 128; float lg[8];
#pragma unroll
            for (int g = 0; g < 2; ++g) { v4u kr[8];
#pragma unroll
                for (int c = 0; c < 8; ++c) kr[c] = *(const v4u*)(kp + 64 * g + 8 * c);
#pragma unroll
                for (int hh = 0; hh < 4; ++hh) { const int h = 4 * g + hh; float acc = 0.f;
#pragma unroll
                    for (int c = 0; c < 8; ++c) acc = dot8bf(kr[c], *(const LAS v4u*)(qs + h * 64 + 8 * c), acc);
                    lg[h] = valid ? acc * 0.125f : -INFINITY; }
                asm volatile("" ::: "memory"); }
            *(LAS f32x4*)(P + slot * 8) = (f32x4){lg[0], lg[1], lg[2], lg[3]}; *(LAS f32x4*)(P + slot * 8 + 4) = (f32x4){lg[4], lg[5], lg[6], lg[7]}; }
        LDS_WAIT(); asm volatile("" ::: "memory");
#pragma unroll
        for (int h = 0; h < 8; ++h) { float l4[4];
#pragma unroll
            for (int j = 0; j < 4; ++j) l4[j] = P[(lane + 64 * j) * 8 + h];
            const float mx = wave_max(fmaxf(fmaxf(l4[0], l4[1]), fmaxf(l4[2], l4[3])), lane); float s = 0.f;
#pragma unroll
            for (int j = 0; j < 4; ++j) { l4[j] = __expf(l4[j] - mx); s += l4[j]; }
            const float inv = 1.f / wave_sum(s, lane);
#pragma unroll
            for (int j = 0; j < 4; ++j) P[(lane + 64 * j) * 8 + h] = l4[j] * inv; }
        LDS_WAIT(); asm volatile("" ::: "memory");
        const int qd = lane >> 4, c16 = lane & 15, g = c16 >> 3; float o[4][8];
#pragma unroll
        for (int hh = 0; hh < 4; ++hh)
#pragma unroll
            for (int dd = 0; dd < 8; ++dd) o[hh][dd] = 0.f;
        const int nit = (nsel + 3) >> 2;
#pragma unroll 8
        for (int i = 0; i < nit; ++i) { const int slot = 4 * i + qd; const int key = (slot < nsel) ? (int)sel[slot] : 0; const v4u vv = *(const v4u*)(VA + (tb + key) * 128 + 8 * c16); const f32x4 p4 = *(const LAS f32x4*)(P + slot * 8 + 4 * g);
            const float v0 = bflo(vv.x), v1 = bfhi(vv.x), v2 = bflo(vv.y), v3 = bfhi(vv.y), v4 = bflo(vv.z), v5 = bfhi(vv.z), v6 = bflo(vv.w), v7 = bfhi(vv.w);
#pragma unroll
            for (int hh = 0; hh < 4; ++hh) { const float p = (slot < nsel) ? p4[hh] : 0.f; o[hh][0] += p * v0; o[hh][1] += p * v1; o[hh][2] += p * v2; o[hh][3] += p * v3; o[hh][4] += p * v4; o[hh][5] += p * v5; o[hh][6] += p * v6; o[hh][7] += p * v7; } }
#pragma unroll
        for (int hh = 0; hh < 4; ++hh)
#pragma unroll
            for (int dd = 0; dd < 8; ++dd) { float x = o[hh][dd]; x += shx(x, 16, lane); x += shx(x, 32, lane); o[hh][dd] = x; }
        if (qd == 0) {
#pragma unroll
            for (int hh = 0; hh < 4; ++hh) { v4u w; w.x = pk2(o[hh][0], o[hh][1]); w.y = pk2(o[hh][2], o[hh][3]); w.z = pk2(o[hh][4], o[hh][5]); w.w = pk2(o[hh][6], o[hh][7]);
                *(v4u*)(OAB + (tb + t) * 1024 + (4 * g + hh) * 64 + ((8 * c16) & 63)) = w; } }
    }
    __syncthreads();
}
__device__ __forceinline__ void dsa_phase(const Frame& F) {
    if (F.G == 256) { const int c = F.vcu, b = c & 3, j = c >> 2;
        for (int i = 0; i < 16; ++i) dsa_unit(F, b, 64 * i + ((i & 1) ? 63 - j : j)); }
    else { for (int u = F.vcu; u < NB * (SEQ / 8); u += F.G) dsa_unit(F, u & 3, u >> 2); }
}
__device__ __forceinline__ void sb_phase(const Frame& F) {
    const int gw = F.wave * F.G + F.vcu, NGW = F.G * NWAVES, lane = F.lane, m = lane & 31, hf = lane >> 5;
    const bf16* P1 = wsp<bf16>(F, WS_P1); const bf16* VBT = wsp<bf16>(F, WS_VBT); bf16* OAB = wsp<bf16>(F, WS_OAB);
    for (int task = gw; task < NB * 8 * (SEQ / 32); task += NGW) {
        const int qt = task & 255, h = (task >> 8) & 7, b = task >> 11, t0 = qt * 32, t = t0 + m; const size_t tb = (size_t)b * SEQ;
        bf16x8 qf[4], kf[4];
        { const bf16* qp = P1 + (tb + t0 + m) * EVW + C_QB + h * 64 + 8 * hf; const bf16* kp = P1 + (tb + t0 + m) * EVW + C_KB + h * 64 + 8 * hf;
#pragma unroll
          for (int kk = 0; kk < 4; ++kk) { qf[kk] = *(const bf16x8*)(qp + 16 * kk); kf[kk] = *(const bf16x8*)(kp + 16 * kk); } }
        f32x16 O[2];
#pragma unroll
        for (int r = 0; r < 16; ++r) { O[0][r] = 0.f; O[1][r] = 0.f; }
        float carry = 1.f;
#pragma unroll 1
        for (int kt = qt; kt >= 0; --kt) {
            f32x16 S;
#pragma unroll
            for (int r = 0; r < 16; ++r) S[r] = 0.f;
#pragma unroll
            for (int kk = 0; kk < 4; ++kk) S = __builtin_amdgcn_mfma_f32_32x32x16_bf16(kf[kk], qf[kk], S, 0, 0, 0);
            if (kt > 0) { const bf16* kp = P1 + (tb + 32 * (kt - 1) + m) * EVW + C_KB + h * 64 + 8 * hf;
#pragma unroll
                for (int kk = 0; kk < 4; ++kk) kf[kk] = *(const bf16x8*)(kp + 16 * kk); }
            v2u vlo[2][2], vhi[2][2];
#pragma unroll
            for (int dt = 0; dt < 2; ++dt) { const bf16* vp = VBT + (size_t)(h * 64 + 32 * dt + m) * NTOK + tb + 32 * kt + 4 * hf;
#pragma unroll
                for (int s = 0; s < 2; ++s) { vlo[dt][s] = *(const v2u*)(vp + 16 * s); vhi[dt][s] = *(const v2u*)(vp + 16 * s + 8); } }
            float rr[16], be[16];
#pragma unroll
            for (int r = 0; r < 16; ++r) { const int key = 32 * kt + crow(r, hf); const bool valid = key < t; const float z = S[r] * 0.125f;
                const float ez = __expf(fminf(z, 80.f)), rv = __builtin_amdgcn_rcpf(1.f + ez); rr[r] = valid ? rv : 1.f; be[r] = valid ? ez * rv : 0.f; }
            float g[4], og[4], T[5];
#pragma unroll
            for (int q = 0; q < 4; ++q) { g[q] = (rr[4 * q] * rr[4 * q + 1]) * (rr[4 * q + 2] * rr[4 * q + 3]); og[q] = shx(g[q], 32, lane); }
            T[4] = 1.f;
#pragma unroll
            for (int q = 3; q >= 0; --q) T[q] = g[q] * og[q] * T[q + 1];
#pragma unroll
            for (int q = 0; q < 4; ++q) { float aft = (hf == 0 ? og[q] : 1.f) * T[q + 1] * carry;
                S[4 * q + 3] = be[4 * q + 3] * aft; aft *= rr[4 * q + 3]; S[4 * q + 2] = be[4 * q + 2] * aft; aft *= rr[4 * q + 2];
                S[4 * q + 1] = be[4 * q + 1] * aft; aft *= rr[4 * q + 1]; S[4 * q] = be[4 * q] * aft; }
            carry *= T[0];
            bf16x8 pf[2];
#pragma unroll
            for (int s = 0; s < 2; ++s) { v4u w; w.x = pk2(S[8 * s + 0], S[8 * s + 1]); w.y = pk2(S[8 * s + 2], S[8 * s + 3]); w.z = pk2(S[8 * s + 4], S[8 * s + 5]); w.w = pk2(S[8 * s + 6], S[8 * s + 7]); pf[s] = __builtin_bit_cast(bf16x8, w); }
#pragma unroll
            for (int dt = 0; dt < 2; ++dt)
#pragma unroll
                for (int s = 0; s < 2; ++s) { v4u a; a.x = vlo[dt][s].x; a.y = vlo[dt][s].y; a.z = vhi[dt][s].x; a.w = vhi[dt][s].y;
                    O[dt] = __builtin_amdgcn_mfma_f32_32x32x16_bf16(__builtin_bit_cast(bf16x8, a), pf[s], O[dt], 0, 0, 0); }
            if (__all(carry < 1e-30f)) break;
        }
        bf16* op = OAB + (tb + t) * 1024 + 512 + h * 64 + 4 * hf;
#pragma unroll
        for (int dt = 0; dt < 2; ++dt)
#pragma unroll
            for (int rg = 0; rg < 4; ++rg) { v2u w; w.x = pk2(O[dt][4 * rg], O[dt][4 * rg + 1]); w.y = pk2(O[dt][4 * rg + 2], O[dt][4 * rg + 3]); *(v2u*)(op + 32 * dt + 8 * rg) = w; }
    }
}
__device__ __forceinline__ void xattn_phase(const Frame& F, int layer) {
    const int gw = F.wave * F.G + F.vcu, NGW = F.G * NWAVES, lane = F.lane, m = lane & 31, hf = lane >> 5;
    const bf16* QX = wsp<bf16>(F, WS_QX); const bf16* KX = wsp<bf16>(F, WS_KX) + layer * 1024; const bf16* VXT = wsp<bf16>(F, WS_VXT) + (size_t)layer * 1024 * 1024; bf16* AX = wsp<bf16>(F, WS_AX);
    for (int task = gw; task < (NTOK / 32) * 4; task += NGW) {
        const int h = task & 3, qtile = task >> 2, q0 = qtile * 32, b = q0 / SEQ;
        bf16x8 qf[16];
        { const bf16* qp = QX + (size_t)(q0 + m) * 1024 + h * 256 + 8 * hf;
#pragma unroll
          for (int kk = 0; kk < 16; ++kk) qf[kk] = *(const bf16x8*)(qp + 16 * kk); }
        f32x16 S[8];
#pragma unroll
        for (int kt = 0; kt < 8; ++kt) {
#pragma unroll
            for (int r = 0; r < 16; ++r) S[kt][r] = 0.f;
            const bf16* kp = KX + (size_t)(b * MEML + 32 * kt + m) * 2048 + h * 256 + 8 * hf;
#pragma unroll
            for (int kk = 0; kk < 16; ++kk) { const bf16x8 kf = *(const bf16x8*)(kp + 16 * kk); S[kt] = __builtin_amdgcn_mfma_f32_32x32x16_bf16(kf, qf[kk], S[kt], 0, 0, 0); }
        }
        float mx = -INFINITY;
#pragma unroll
        for (int kt = 0; kt < 8; ++kt)
#pragma unroll
            for (int r = 0; r < 16; ++r) mx = fmaxf(mx, S[kt][r]);
        mx = fmaxf(mx, shx(mx, 32, lane));
        float sum = 0.f;
#pragma unroll
        for (int kt = 0; kt < 8; ++kt)
#pragma unroll
            for (int r = 0; r < 16; ++r) { const float p = __expf(S[kt][r] - mx); S[kt][r] = p; sum += p; }
        sum += shx(sum, 32, lane);
        const float inv = 1.f / sum;
        bf16x8 pf[8][2];
#pragma unroll
        for (int kt = 0; kt < 8; ++kt)
#pragma unroll
            for (int s = 0; s < 2; ++s) { v4u w; w.x = pk2(S[kt][8 * s + 0], S[kt][8 * s + 1]); w.y = pk2(S[kt][8 * s + 2], S[kt][8 * s + 3]); w.z = pk2(S[kt][8 * s + 4], S[kt][8 * s + 5]); w.w = pk2(S[kt][8 * s + 6], S[kt][8 * s + 7]);
                pf[kt][s] = __builtin_bit_cast(bf16x8, w); }
#pragma unroll
        for (int half = 0; half < 2; ++half) {
            f32x16 O[4];
#pragma unroll
            for (int d4 = 0; d4 < 4; ++d4) {
#pragma unroll
                for (int r = 0; r < 16; ++r) O[d4][r] = 0.f;
                const bf16* vp = VXT + (size_t)(h * 256 + 32 * (4 * half + d4) + m) * 1024 + b * MEML + 4 * hf;
#pragma unroll
                for (int kt = 0; kt < 8; ++kt)
#pragma unroll
                    for (int s = 0; s < 2; ++s) { const v2u lo = *(const v2u*)(vp + 32 * kt + 16 * s), hi = *(const v2u*)(vp + 32 * kt + 16 * s + 8);
                        v4u a; a.x = lo.x; a.y = lo.y; a.z = hi.x; a.w = hi.y;
                        O[d4] = __builtin_amdgcn_mfma_f32_32x32x16_bf16(__builtin_bit_cast(bf16x8, a), pf[kt][s], O[d4], 0, 0, 0); }
            }
            bf16* op = AX + (size_t)(q0 + m) * 1024 + h * 256 + 4 * hf;
#pragma unroll
            for (int d4 = 0; d4 < 4; ++d4)
#pragma unroll
                for (int rg = 0; rg < 4; ++rg) { v2u w; w.x = pk2(O[d4][4 * rg] * inv, O[d4][4 * rg + 1] * inv); w.y = pk2(O[d4][4 * rg + 2] * inv, O[d4][4 * rg + 3] * inv);
                    *(v2u*)(op + 32 * (4 * half + d4) + 8 * rg) = w; }
        }
    }
}

__device__ __forceinline__ void router_phase(const Frame& F, int layer) {
    const int gw = F.wave * F.G + F.vcu, NGW = F.G * NWAVES, lane = F.lane, m = lane & 31, hf = lane >> 5;
    const float* HF = wsp<float>(F, WS_HF); const float* Wr = inp(F, 26) + (size_t)layer * DM * NEXP; const float* br = inp(F, 27) + layer * NEXP;
    unsigned* cnt = wsp<unsigned>(F, WS_CTL) + CW_CNT + layer * 32 * 64;
    int* elist = wsp<int>(F, WS_ELIST); float* egate = wsp<float>(F, WS_EGATE); int* toke = wsp<int>(F, WS_TOKE); int* tokp = wsp<int>(F, WS_TOKP);
    LAS float* scr = (LAS float*)(F.lds + F.wave * 8192);
    for (int tile = gw; tile < NTOK / 32; tile += NGW) {
        const int tok0 = tile * 32;
        f32x16 acc;
#pragma unroll
        for (int r = 0; r < 16; ++r) acc[r] = 0.f;
        const float* ap = HF + (size_t)(tok0 + m) * DM + 4 * hf; const float* bp = Wr + (size_t)(4 * hf) * NEXP + m;
#pragma unroll 4
        for (int j = 0; j < 128; ++j) { const f32x4 a = *(const f32x4*)(ap + 8 * j);
#pragma unroll
            for (int s = 0; s < 4; ++s) acc = __builtin_amdgcn_mfma_f32_32x32x2f32(a[s], bp[(size_t)(8 * j + s) * NEXP], acc, 0, 0, 0); }
#pragma unroll
        for (int r = 0; r < 16; ++r) scr[crow(r, hf) * 33 + m] = acc[r];
        LDS_WAIT(); asm volatile("" ::: "memory");
        int e4[4]; float g4[4];
        { float lg[32];
#pragma unroll
          for (int e = 0; e < 32; ++e) lg[e] = scr[m * 33 + e] + br[e];
          unsigned taken = 0u; float v4[4];
#pragma unroll
          for (int k = 0; k < 4; ++k) { float best = -INFINITY; int bi = 0;
#pragma unroll
              for (int e = 0; e < 32; ++e) { const bool ok = !((taken >> e) & 1u) && (lg[e] > best); best = ok ? lg[e] : best; bi = ok ? e : bi; }
              taken |= 1u << bi; e4[k] = bi; v4[k] = best; }
          float s = 0.f;
#pragma unroll
          for (int k = 0; k < 4; ++k) { g4[k] = __expf(v4[k] - v4[0]); s += g4[k]; }
          const float inv = 1.f / s;
#pragma unroll
          for (int k = 0; k < 4; ++k) g4[k] *= inv; }
        LDS_WAIT(); asm volatile("" ::: "memory");
        int pos4[4];
        const bool act = lane < 32;
        for (int e = 0; e < 32; ++e) {
            unsigned long long mk[4]; int tot = 0;
#pragma unroll
            for (int k = 0; k < 4; ++k) { mk[k] = __ballot(act && e4[k] == e); tot += __popcll(mk[k]); }
            if (tot == 0) continue;
            unsigned base = 0u;
            if (lane == 0) base = __hip_atomic_fetch_add(cnt + e * 64, (unsigned)tot, __ATOMIC_RELAXED, __HIP_MEMORY_SCOPE_AGENT);
            base = (unsigned)__builtin_amdgcn_readfirstlane((int)base);
            const unsigned long long lt = (1ull << lane) - 1ull; int off = 0;
#pragma unroll
            for (int k = 0; k < 4; ++k) { if (act && e4[k] == e) pos4[k] = (int)base + off + __popcll(mk[k] & lt); off += __popcll(mk[k]); }
        }
        if (act) { const int tok = tok0 + lane;
#pragma unroll
            for (int k = 0; k < 4; ++k) { elist[(size_t)e4[k] * NTOK + pos4[k]] = tok; egate[(size_t)e4[k] * NTOK + pos4[k]] = g4[k]; }
            *(int4*)(toke + (size_t)tok * 4) = make_int4(e4[0], e4[1], e4[2], e4[3]); *(int4*)(tokp + (size_t)tok * 4) = make_int4(pos4[0], pos4[1], pos4[2], pos4[3]); }
    }
}
__device__ __forceinline__ void moe_tables(const Frame& F, int layer) {
    LAS int* tile_e = (LAS int*)(F.lds + UP_TILEE); LAS int* tstart = (LAS int*)(F.lds + UP_TSTART); LAS int* cntl = (LAS int*)(F.lds + UP_CNT);
    unsigned* cnt = wsp<unsigned>(F, WS_CTL) + CW_CNT + layer * 32 * 64;
    __syncthreads();
    if (F.tid < 32) cntl[F.tid] = (int)__hip_atomic_load(cnt + F.tid * 64, __ATOMIC_RELAXED, __HIP_MEMORY_SCOPE_AGENT);
    __syncthreads();
    if (F.tid == 0) { int s = 0; for (int e = 0; e < 32; ++e) { tstart[e] = s; s += (cntl[e] + 255) >> 8; } tstart[32] = s; }
    __syncthreads();
    for (int e = 0; e < 32; ++e) { const int a = tstart[e], b = tstart[e + 1]; for (int rt = a + F.tid; rt < b; rt += NTHR) tile_e[rt] = e; }
    __syncthreads();
}
__device__ __forceinline__ void gather_phase(const Frame& F, int layer) {
    moe_tables(F, layer);
    const LAS int* tile_e = (const LAS int*)(F.lds + UP_TILEE); const LAS int* tstart = (const LAS int*)(F.lds + UP_TSTART); const LAS int* cntl = (const LAS int*)(F.lds + UP_CNT);
    const int gw = F.vcu * NWAVES + F.wave, NGW = F.G * NWAVES, lane = F.lane; const int nrows = tstart[32] * 256;
    const int* elist = wsp<int>(F, WS_ELIST); const float* egate = wsp<float>(F, WS_EGATE); float* rgate = wsp<float>(F, WS_RGATE);
    const bf16* XB = wsp<bf16>(F, WS_XB); bf16* XG = wsp<bf16>(F, WS_XG);
    for (int row = gw; row < nrows; row += NGW) {
        const int rt = row >> 8, e = tile_e[rt], pos = (rt - tstart[e]) * 256 + (row & 255); const bool valid = pos < cntl[e];
        v4u a = (v4u){0u, 0u, 0u, 0u}, b = a; float gt = 0.f;
        if (valid) { const int tok = elist[(size_t)e * NTOK + pos]; gt = egate[(size_t)e * NTOK + pos]; const bf16* src = XB + (size_t)tok * DM + 16 * lane; a = *(const v4u*)src; b = *(const v4u*)(src + 8); }
        bf16* dst = XG + (size_t)row * DM + 16 * lane; *(v4u*)dst = a; *(v4u*)(dst + 8) = b;
        if (lane == 0) rgate[row] = gt;
    }
}
__device__ __forceinline__ void combine_phase(const Frame& F, int layer, float* dstF) {
    moe_tables(F, layer);
    const LAS int* tstart = (const LAS int*)(F.lds + UP_TSTART);
    const int gw = F.vcu * NWAVES + F.wave, NGW = F.G * NWAVES, lane = F.lane;
    const int* toke = wsp<int>(F, WS_TOKE); const int* tokp = wsp<int>(F, WS_TOKP); const bf16* Y = wsp<bf16>(F, WS_XG); const float* HF = wsp<float>(F, WS_HF); bf16* XB = wsp<bf16>(F, WS_XB);
    const float* g = inp(F, 32) + layer * DM; const float* b = inp(F, 33) + layer * DM;
    for (int tok = gw; tok < NTOK; tok += NGW) {
        const int4 e4 = *(const int4*)(toke + (size_t)tok * 4), p4 = *(const int4*)(tokp + (size_t)tok * 4);
        const int r0 = tstart[e4.x] * 256 + p4.x, r1 = tstart[e4.y] * 256 + p4.y, r2 = tstart[e4.z] * 256 + p4.z, r3 = tstart[e4.w] * 256 + p4.w;
        f32x4 v[4];
#pragma unroll
        for (int j = 0; j < 4; ++j) { const int c = 4 * lane + 256 * j; v[j] = *(const f32x4*)(HF + (size_t)tok * DM + c) * DN_ALPHA;
            const v2u y0 = *(const v2u*)(Y + (size_t)r0 * DM + c), y1 = *(const v2u*)(Y + (size_t)r1 * DM + c), y2 = *(const v2u*)(Y + (size_t)r2 * DM + c), y3 = *(const v2u*)(Y + (size_t)r3 * DM + c);
            v[j][0] += ((bflo(y0.x) + bflo(y1.x)) + bflo(y2.x)) + bflo(y3.x); v[j][1] += ((bfhi(y0.x) + bfhi(y1.x)) + bfhi(y2.x)) + bfhi(y3.x);
            v[j][2] += ((bflo(y0.y) + bflo(y1.y)) + bflo(y2.y)) + bflo(y3.y); v[j][3] += ((bfhi(y0.y) + bfhi(y1.y)) + bfhi(y2.y)) + bfhi(y3.y); }
        ln_row_store(F, v, g, b, dstF + (size_t)tok * DM, XB + (size_t)tok * DM);
    }
}

constexpr int S5_APITCH = 2064, S5_HPITCH = 272, S5_AOFF = 0, S5_HOFF = 32 * S5_APITCH  , S5_ROFF = 81920  ;
__device__ __forceinline__ void s5_stage_u(const Frame& F, int g, int mt) {
    const bf16* U = wsp<bf16>(F, WS_U); const int b = mt >> 2, ch0 = (mt & 3) * 32;
    for (int pc = F.tid; pc < 32 * 64; pc += NTHR) { const int i = pc >> 6, s = pc & 63; const bf16* src = U + ((size_t)b * SEQ + (size_t)(ch0 + i) * SCH + s) * DM + 16 * g;
        const v4u a = *(const v4u*)src, c = *(const v4u*)(src + 8); LAS unsigned char* d = F.lds + S5_AOFF + i * S5_APITCH + s * 32; *(LAS v4u*)d = a; *(LAS v4u*)(d + 16) = c; }
}
__device__ __forceinline__ void s5_local_phase(const Frame& F) {
    const int lane = F.lane, wave = F.wave, m = lane & 31, hf = lane >> 5;
    const bf16* W1 = wsp<bf16>(F, WS_W1); float* ELOC = wsp<float>(F, WS_ELOC);
    for (int unit = F.vcu; unit < 64 * 16; unit += F.G) {
        const int g = unit & 63, mt = unit >> 6, b = mt >> 2, ch0 = (mt & 3) * 32;
        __syncthreads();
        s5_stage_u(F, g, mt);
        LDS_WAIT(); __syncthreads();
        const int nt = wave & 3, kh = wave >> 2;
        f32x16 acc;
#pragma unroll
        for (int r = 0; r < 16; ++r) acc[r] = 0.f;
        const bf16* wp = W1 + ((size_t)g * 128 + 32 * nt + m) * 1024 + 8 * hf; const LAS unsigned char* ap = F.lds + S5_AOFF + m * S5_APITCH + 16 * hf;
#pragma unroll 8
        for (int kk = 32 * kh; kk < 32 * kh + 32; ++kk) { const bf16x8 af = *(const LAS bf16x8*)(ap + 32 * kk); const bf16x8 bf = *(const bf16x8*)(wp + 16 * kk);
            acc = __builtin_amdgcn_mfma_f32_32x32x16_bf16(af, bf, acc, 0, 0, 0); }
        LAS float* red = (LAS float*)(F.lds + S5_ROFF) + (nt * 64 + lane) * 16;
        if (kh == 1) {
#pragma unroll
            for (int r = 0; r < 16; r += 4) *(LAS f32x4*)(red + r) = (f32x4){acc[r], acc[r + 1], acc[r + 2], acc[r + 3]}; }
        LDS_WAIT(); __syncthreads();
        if (kh == 0) {
#pragma unroll
            for (int r = 0; r < 16; ++r) { const int i = crow(r, hf); ELOC[(((size_t)b * 64 + g) * NCHUNK + ch0 + i) * 128 + 32 * nt + m] = acc[r] + red[r]; } }
    }
}
__device__ __forceinline__ void s5_scan_phase(const Frame& F) {
    if (F.wave != 0) return;
    const f32x2* apow = wsp<f32x2>(F, WS_APOW); const float* ELOC = wsp<float>(F, WS_ELOC); bf16* HS = wsp<bf16>(F, WS_HS);
    for (int idx = F.vcu * 64 + F.lane; idx < NB * 64 * 64; idx += F.G * 64) {
        const int p = idx & 63, g = (idx >> 6) & 63, b = idx >> 12; const f32x2 a = apow[(g * 64 + p) * 65 + 64];
        const size_t base = ((size_t)b * 64 + g) * NCHUNK * 128; float hr = 0.f, hi = 0.f;
#pragma unroll 8
        for (int k = 0; k < NCHUNK; ++k) { HS[base + (size_t)k * 128 + p] = (bf16)f2bf(hr); HS[base + (size_t)k * 128 + 64 + p] = (bf16)f2bf(hi);
            const float er = ELOC[base + (size_t)k * 128 + p], ei = ELOC[base + (size_t)k * 128 + 64 + p];
            const float nr = a.x * hr - a.y * hi + er, ni = a.x * hi + a.y * hr + ei; hr = nr; hi = ni; }
    }
}
__device__ __forceinline__ void s5_out_phase(const Frame& F) {
    const int lane = F.lane, wave = F.wave, m = lane & 31, hf = lane >> 5;
    const bf16* KT = wsp<bf16>(F, WS_KT); const bf16* W3 = wsp<bf16>(F, WS_W3); const bf16* HS = wsp<bf16>(F, WS_HS); const bf16* U = wsp<bf16>(F, WS_U); bf16* YG = wsp<bf16>(F, WS_YG);
    const float* dvec = inp(F, 17);
    for (int unit = F.vcu; unit < 64 * 16; unit += F.G) {
        const int g = unit & 63, mt = unit >> 6, b = mt >> 2, ch0 = (mt & 3) * 32;
        __syncthreads();
        s5_stage_u(F, g, mt);
        for (int pc = F.tid; pc < 32 * 16; pc += NTHR) { const int i = pc >> 4, q = pc & 15;
            *(LAS v4u*)(F.lds + S5_HOFF + i * S5_HPITCH + q * 16) = *(const v4u*)(HS + (((size_t)b * 64 + g) * NCHUNK + ch0 + i) * 128 + 8 * q); }
        LDS_WAIT(); __syncthreads();
        const int tl = m >> 4, c = m & 15; const float dv = dvec[16 * g + c];
        const LAS unsigned char* ap = F.lds + S5_AOFF + m * S5_APITCH + 16 * hf; const LAS unsigned char* hp = F.lds + S5_HOFF + m * S5_HPITCH + 16 * hf;
#pragma unroll 1
        for (int q = 0; q < 4; ++q) {
            const int j = (q == 0) ? wave : (q == 1) ? 15 - wave : (q == 2) ? 16 + wave : 31 - wave; const int t = 2 * j + tl;
            f32x16 acc;
#pragma unroll
            for (int r = 0; r < 16; ++r) acc[r] = 0.f;
            const bf16* kt = KT + ((size_t)g * 64 * 16 + c) * 16 + 8 * hf;
#pragma unroll 2
            for (int s = 0; s <= 2 * j + 1; ++s) { const int tau = t - s; bf16x8 bf = (bf16x8){0, 0, 0, 0, 0, 0, 0, 0}; if (tau >= 0) bf = *(const bf16x8*)(kt + tau * 256);
                const bf16x8 af = *(const LAS bf16x8*)(ap + 32 * s); acc = __builtin_amdgcn_mfma_f32_32x32x16_bf16(af, bf, acc, 0, 0, 0); }
            const bf16* w3 = W3 + ((size_t)g * 1024 + 16 * t + c) * 128 + 8 * hf;
#pragma unroll
            for (int kk = 0; kk < 8; ++kk) { const bf16x8 af = *(const LAS bf16x8*)(hp + 32 * kk); const bf16x8 bf = *(const bf16x8*)(w3 + 16 * kk); acc = __builtin_amdgcn_mfma_f32_32x32x16_bf16(af, bf, acc, 0, 0, 0); }
#pragma unroll
            for (int r = 0; r < 16; ++r) { const int i = crow(r, hf); const size_t off = ((size_t)b * SEQ + (size_t)(ch0 + i) * SCH + t) * DM + 16 * g + c;
                const float y = acc[r] + dv * bf2f(U[off]); const float x = 0.7978845608028654f * (y + 0.044715f * y * y * y); const float th = 1.f - 2.f / (1.f + __expf(2.f * x));
                YG[off] = (bf16)f2bf(0.5f * y * (1.f + th)); }
        }
    }
}
#ifndef MK_PER_PHASE
#define MK_PER_PHASE 0
#endif
constexpr int NPH = 31;
__device__ __forceinline__ bool in_ph(int k, int lo, int hi) { asm volatile("" : "+s"(lo), "+s"(hi)); return lo <= k && k < hi; }
struct Args { const float* in[34]; float* out; unsigned char* ws; int ph_lo, ph_hi; };
__global__ void __launch_bounds__(NTHR, 2) fwd_kernel(Args args) {
    extern __shared__ __attribute__((aligned(16))) unsigned char lds_raw[];
    Frame F;
    F.lds = (LAS unsigned char*)lds_raw;
    F.tid = threadIdx.x; F.lane = F.tid & 63; F.wave = __builtin_amdgcn_readfirstlane(F.tid >> 6);
    F.G = gridDim.x; { const int bx = blockIdx.x; F.vcu = (F.G % 8 == 0) ? (bx % 8) * (F.G / 8) + bx / 8 : bx; }
    F.out = args.out; F.ws = args.ws;
    for (int u = F.tid; u < 64; u += NTHR) ((LAS unsigned*)(F.lds + UP_MISC))[u] = 0u;
    if (F.tid < 34) *(LAS unsigned long long*)(F.lds + UP_PTR + 8 * F.tid) = (unsigned long long)args.in[F.tid];
    const bool is_w0 = (F.wave == 0);
    F.tid = 0; F.lane = 0;
    __syncthreads();
    XcdBarrier bar; bar.w0 = is_w0; bar.bar = wsp<unsigned>(F, WS_CTL) + CW_BAR; bar.x = 0; bar.st = nullptr;
#if !MK_PER_PHASE
    bar = xcd_barrier_post(wsp<unsigned>(F, WS_CTL) + CW_BAR, (volatile LAS unsigned*)(F.lds + UP_MISC) + 8, is_w0);
#endif
    const int lo = args.ph_lo, hi = args.ph_hi;
#define IN(k) in_ph((k), lo, hi)
#ifndef REPMASK
#define REPMASK 0ull
#endif
#define REPS(n) ((((unsigned long long)(REPMASK)) >> (n)) & 1ull ? 2 : 1)
#ifndef ONLY_SITE
#define EN(n) true
#else
#define EN(n) ((n) == ONLY_SITE)
#endif
#if MK_PER_PHASE
#define SEAM(k) do { } while (0)
#else
#define SEAM(k) do { if (IN(k) && IN((k) + 1)) xcd_barrier(bar); } while (0)
#endif
    const int bx = (int)blockIdx.x;
    typedef pg8::EpiBf16<0> EpiB;
    if (IN(0) && EN(0)) _Pragma("unroll") for (int rep_ = 0; rep_ < REPS(0); ++rep_) { const Frame P = pframe(F); p0_prologue(P); }
    SEAM(0);

            if (IN(1) && EN(1)) _Pragma("unroll") for (int rep_ = 0; rep_ < REPS(1); ++rep_) { const Frame P = pframe(F);
                { pg8::Gemm g{wsp<bf16>(P, WS_XB), wsp<bf16>(P, WS_WTIN0), NTOK, EVW, DM, P.wave}; pg8::StaticOrder S; S.init(NTOK, EVW, P.G, bx);
                  EpiB E{wsp<bf16>(P, WS_P1), EVW, nullptr, 0, 0, 1.f}; pg8::gemm_phase<EpiB, pg8::StaticOrder, true, true>(P.lds, g, S, E); }
                { pg8::Gemm g{wsp<bf16>(P, WS_MEMB), wsp<bf16>(P, WS_WTXK), NMEM, 2048, DM, P.wave}; pg8::StaticOrder S; S.init(NMEM, 2048, P.G, (bx + P.G - P.G / 2) % P.G);
                  EpiB E{wsp<bf16>(P, WS_KX), 2048, nullptr, 0, 0, 1.f}; pg8::gemm_phase<EpiB, pg8::StaticOrder, true, true>(P.lds, g, S, E); }
                { pg8::Gemm g{wsp<bf16>(P, WS_WTXV), wsp<bf16>(P, WS_MEMB), 2048, NMEM, DM, P.wave}; pg8::StaticOrder S; S.init(2048, NMEM, P.G, (bx + P.G - P.G / 2 - 32) % P.G);
                  EpiB E{wsp<bf16>(P, WS_VXT), NMEM, nullptr, 0, 0, 1.f}; pg8::gemm_phase<EpiB, pg8::StaticOrder, true, true>(P.lds, g, S, E); }
                { pg8::Gemm g{wsp<bf16>(P, WS_WTVB), wsp<bf16>(P, WS_XB), 512, NTOK, DM, P.wave}; pg8::StaticOrder S; S.init(512, NTOK, P.G, (bx + P.G - P.G / 2 - 64) % P.G);
                  EpiB E{wsp<bf16>(P, WS_VBT), NTOK, nullptr, 0, 0, 1.f}; pg8::gemm_phase<EpiB, pg8::StaticOrder, true, true>(P.lds, g, S, E); }
            }
            SEAM(1);
            if (IN(2) && EN(2)) _Pragma("unroll") for (int rep_ = 0; rep_ < REPS(2); ++rep_) { const Frame P = pframe(F); p2_postproc(P); }
            SEAM(2);
            if (IN(3) && EN(3)) _Pragma("unroll") for (int rep_ = 0; rep_ < REPS(3); ++rep_) { const Frame P = pframe(F); const int kq = (lo < 0) ? 512 : 256;     pg8::Gemm g{wsp<bf16>(P, WS_CQ), wsp<bf16>(P, WS_WTQ), NTOK, 1024, kq, P.wave}; pg8::StaticOrder S; S.init(NTOK, 1024, P.G, bx);
                EpiB E{wsp<bf16>(P, WS_QAI), 1024, nullptr, 0, 0, 1.f}; pg8::gemm_phase<EpiB, pg8::StaticOrder, true, true>(P.lds, g, S, E); }
            SEAM(3);
            if (IN(4)) { if (EN(4)) _Pragma("unroll") for (int rep_ = 0; rep_ < REPS(4); ++rep_) { const Frame P = pframe(F); dsa_phase(P); } if (EN(22)) _Pragma("unroll") for (int rep_ = 0; rep_ < REPS(22); ++rep_) { const Frame P = pframe(F); sb_phase(P); } }
            SEAM(4);
            if (IN(5) && EN(5)) _Pragma("unroll") for (int rep_ = 0; rep_ < REPS(5); ++rep_) { const Frame P = pframe(F); pg8::Gemm g{wsp<bf16>(P, WS_OAB), wsp<bf16>(P, WS_WTOUT0), NTOK, DM, DM, P.wave}; pg8::StaticOrder S; S.init(NTOK, DM, P.G, bx);
                pg8::EpiResF32 E{inp(P, 0), wsp<float>(P, WS_T), DM, DN_ALPHA}; pg8::gemm_phase<pg8::EpiResF32, pg8::StaticOrder, true, true>(P.lds, g, S, E); }
            SEAM(5);
            if (IN(6) && EN(6)) _Pragma("unroll") for (int rep_ = 0; rep_ < REPS(6); ++rep_) { const Frame P = pframe(F); ln_phase(P, wsp<float>(P, WS_T), inp(P, 19), inp(P, 20), wsp<float>(P, WS_HF), wsp<bf16>(P, WS_XB)); }
            SEAM(6);
    {
        constexpr int cb = 7;
        if (IN(cb + 0) && EN(7)) _Pragma("unroll") for (int rep_ = 0; rep_ < REPS(7); ++rep_) { const Frame P = pframe(F); pg8::Gemm g{wsp<bf16>(P, WS_XB), wsp<bf16>(P, WS_WTXQ) + (size_t)0 * DM * DM, NTOK, DM, DM, P.wave}; pg8::StaticOrder S; S.init(NTOK, DM, P.G, bx);
            EpiB E{wsp<bf16>(P, WS_QX), DM, nullptr, 0, 0, 1.f}; pg8::gemm_phase<EpiB, pg8::StaticOrder, true, true>(P.lds, g, S, E); }
        SEAM(cb + 0);
        if (IN(cb + 1) && EN(8)) _Pragma("unroll") for (int rep_ = 0; rep_ < REPS(8); ++rep_) { const Frame P = pframe(F); xattn_phase(P, 0); }
        SEAM(cb + 1);
        if (IN(cb + 2) && EN(9)) _Pragma("unroll") for (int rep_ = 0; rep_ < REPS(9); ++rep_) { const Frame P = pframe(F); pg8::Gemm g{wsp<bf16>(P, WS_AX), wsp<bf16>(P, WS_WTXO) + (size_t)0 * DM * DM, NTOK, DM, DM, P.wave}; pg8::StaticOrder S; S.init(NTOK, DM, P.G, bx);
            pg8::EpiResF32 E{wsp<float>(P, WS_HF), wsp<float>(P, WS_T), DM, DN_ALPHA}; pg8::gemm_phase<pg8::EpiResF32, pg8::StaticOrder, true, true>(P.lds, g, S, E); }
        SEAM(cb + 2);
        if (IN(cb + 3) && EN(10)) _Pragma("unroll") for (int rep_ = 0; rep_ < REPS(10); ++rep_) { const Frame P = pframe(F); ln_phase(P, wsp<float>(P, WS_T), inp(P, 24) + 0 * DM, inp(P, 25) + 0 * DM, wsp<float>(P, WS_HF), wsp<bf16>(P, WS_XB)); }
        SEAM(cb + 3);
        if (IN(cb + 4) && EN(11)) _Pragma("unroll") for (int rep_ = 0; rep_ < REPS(11); ++rep_) { const Frame P = pframe(F); router_phase(P, 0); }
        SEAM(cb + 4);
        if (IN(cb + 5) && EN(12)) _Pragma("unroll") for (int rep_ = 0; rep_ < REPS(12); ++rep_) { const Frame P = pframe(F); gather_phase(P, 0); }
        SEAM(cb + 5);
        if (IN(cb + 6) && EN(13)) _Pragma("unroll") for (int rep_ = 0; rep_ < REPS(13); ++rep_) { const Frame P0 = pframe(F); moe_tables(P0, 0); }
        if (IN(cb + 6) && EN(13)) _Pragma("unroll") for (int rep_ = 0; rep_ < REPS(13); ++rep_) { const Frame P = pframe(F); const int nrt = __builtin_amdgcn_readfirstlane(((const LAS int*)(P.lds + UP_TSTART))[32]);
            pg8::Gemm g{wsp<bf16>(P, WS_XG), wsp<bf16>(P, WS_WTGU) + (size_t)0 * NEXP * 2048 * DM, nrt * 256, NEXP * 2048, DM, P.wave};
            pg8::MoeOrder<8> S{(const LAS int*)(P.lds + UP_TILEE), nrt, P.G, P.vcu};
            pg8::EpiSwiGlu E{wsp<bf16>(P, WS_ACT), inp(P, 29) + (size_t)0 * NEXP * 2048}; pg8::gemm_phase<pg8::EpiSwiGlu, pg8::MoeOrder<8>, true, true>(P.lds, g, S, E); }
        SEAM(cb + 6);
        if (IN(cb + 7) && EN(14)) _Pragma("unroll") for (int rep_ = 0; rep_ < REPS(14); ++rep_) { const Frame P0 = pframe(F); moe_tables(P0, 0); }
        if (IN(cb + 7) && EN(14)) _Pragma("unroll") for (int rep_ = 0; rep_ < REPS(14); ++rep_) { const Frame P = pframe(F); const int nrt = __builtin_amdgcn_readfirstlane(((const LAS int*)(P.lds + UP_TSTART))[32]);
            pg8::Gemm g{wsp<bf16>(P, WS_ACT), wsp<bf16>(P, WS_WTDN) + (size_t)0 * NEXP * DM * DM, nrt * 256, NEXP * DM, DM, P.wave};
            pg8::MoeOrder<4> S{(const LAS int*)(P.lds + UP_TILEE), nrt, P.G, P.vcu};
            pg8::EpiDown E{wsp<bf16>(P, WS_XG), inp(P, 31) + (size_t)0 * NEXP * DM, wsp<float>(P, WS_RGATE)}; pg8::gemm_phase<pg8::EpiDown, pg8::MoeOrder<4>, true, true>(P.lds, g, S, E); }
        SEAM(cb + 7);
        if (IN(cb + 8) && EN(15)) _Pragma("unroll") for (int rep_ = 0; rep_ < REPS(15); ++rep_) { const Frame P = pframe(F); combine_phase(P, 0, 0 == 0 ? wsp<float>(P, WS_HF) : P.out); }
        SEAM(cb + 8);
    }

            if (IN(16) && EN(16)) _Pragma("unroll") for (int rep_ = 0; rep_ < REPS(16); ++rep_) { const Frame P = pframe(F); pg8::Gemm g{wsp<bf16>(P, WS_XB), wsp<bf16>(P, WS_WTS5IN), NTOK, DM, DM, P.wave}; pg8::StaticOrder S; S.init(NTOK, DM, P.G, bx);
                EpiB E{wsp<bf16>(P, WS_U), DM, nullptr, 0, 0, 1.f}; pg8::gemm_phase<EpiB, pg8::StaticOrder, true, true>(P.lds, g, S, E); }
            SEAM(16);
            if (IN(17) && EN(17)) _Pragma("unroll") for (int rep_ = 0; rep_ < REPS(17); ++rep_) { const Frame P = pframe(F); s5_local_phase(P); }
            SEAM(17);
            if (IN(18) && EN(18)) _Pragma("unroll") for (int rep_ = 0; rep_ < REPS(18); ++rep_) { const Frame P = pframe(F); s5_scan_phase(P); }
            SEAM(18);
            if (IN(19) && EN(19)) _Pragma("unroll") for (int rep_ = 0; rep_ < REPS(19); ++rep_) { const Frame P = pframe(F); s5_out_phase(P); }
            SEAM(19);
            if (IN(20) && EN(20)) _Pragma("unroll") for (int rep_ = 0; rep_ < REPS(20); ++rep_) { const Frame P = pframe(F); pg8::Gemm g{wsp<bf16>(P, WS_YG), wsp<bf16>(P, WS_WTS5OUT), NTOK, 2048, DM, P.wave}; pg8::StaticOrder S; S.init(NTOK, 2048, P.G, bx);
                pg8::EpiGluRes E{wsp<float>(P, WS_HF), wsp<float>(P, WS_T), DM, DN_ALPHA}; pg8::gemm_phase<pg8::EpiGluRes, pg8::StaticOrder, true, true>(P.lds, g, S, E); }
            SEAM(20);
            if (IN(21) && EN(21)) _Pragma("unroll") for (int rep_ = 0; rep_ < REPS(21); ++rep_) { const Frame P = pframe(F); ln_phase(P, wsp<float>(P, WS_T), inp(P, 19) + DM, inp(P, 20) + DM, wsp<float>(P, WS_HF), wsp<bf16>(P, WS_XB)); }
            SEAM(21);
    {
        constexpr int cb = 22;
        if (IN(cb + 0) && EN(7)) _Pragma("unroll") for (int rep_ = 0; rep_ < REPS(7); ++rep_) { const Frame P = pframe(F); pg8::Gemm g{wsp<bf16>(P, WS_XB), wsp<bf16>(P, WS_WTXQ) + (size_t)1 * DM * DM, NTOK, DM, DM, P.wave}; pg8::StaticOrder S; S.init(NTOK, DM, P.G, bx);
            EpiB E{wsp<bf16>(P, WS_QX), DM, nullptr, 0, 0, 1.f}; pg8::gemm_phase<EpiB, pg8::StaticOrder, true, true>(P.lds, g, S, E); }
        SEAM(cb + 0);
        if (IN(cb + 1) && EN(8)) _Pragma("unroll") for (int rep_ = 0; rep_ < REPS(8); ++rep_) { const Frame P = pframe(F); xattn_phase(P, 1); }
        SEAM(cb + 1);
        if (IN(cb + 2) && EN(9)) _Pragma("unroll") for (int rep_ = 0; rep_ < REPS(9); ++rep_) { const Frame P = pframe(F); pg8::Gemm g{wsp<bf16>(P, WS_AX), wsp<bf16>(P, WS_WTXO) + (size_t)1 * DM * DM, NTOK, DM, DM, P.wave}; pg8::StaticOrder S; S.init(NTOK, DM, P.G, bx);
            pg8::EpiResF32 E{wsp<float>(P, WS_HF), wsp<float>(P, WS_T), DM, DN_ALPHA}; pg8::gemm_phase<pg8::EpiResF32, pg8::StaticOrder, true, true>(P.lds, g, S, E); }
        SEAM(cb + 2);
        if (IN(cb + 3) && EN(10)) _Pragma("unroll") for (int rep_ = 0; rep_ < REPS(10); ++rep_) { const Frame P = pframe(F); ln_phase(P, wsp<float>(P, WS_T), inp(P, 24) + 1 * DM, inp(P, 25) + 1 * DM, wsp<float>(P, WS_HF), wsp<bf16>(P, WS_XB)); }
        SEAM(cb + 3);
        if (IN(cb + 4) && EN(11)) _Pragma("unroll") for (int rep_ = 0; rep_ < REPS(11); ++rep_) { const Frame P = pframe(F); router_phase(P, 1); }
        SEAM(cb + 4);
        if (IN(cb + 5) && EN(12)) _Pragma("unroll") for (int rep_ = 0; rep_ < REPS(12); ++rep_) { const Frame P = pframe(F); gather_phase(P, 1); }
        SEAM(cb + 5);
        if (IN(cb + 6) && EN(13)) _Pragma("unroll") for (int rep_ = 0; rep_ < REPS(13); ++rep_) { const Frame P0 = pframe(F); moe_tables(P0, 1); }
        if (IN(cb + 6) && EN(13)) _Pragma("unroll") for (int rep_ = 0; rep_ < REPS(13); ++rep_) { const Frame P = pframe(F); const int nrt = __builtin_amdgcn_readfirstlane(((const LAS int*)(P.lds + UP_TSTART))[32]);
            pg8::Gemm g{wsp<bf16>(P, WS_XG), wsp<bf16>(P, WS_WTGU) + (size_t)1 * NEXP * 2048 * DM, nrt * 256, NEXP * 2048, DM, P.wave};
            pg8::MoeOrder<8> S{(const LAS int*)(P.lds + UP_TILEE), nrt, P.G, P.vcu};
            pg8::EpiSwiGlu E{wsp<bf16>(P, WS_ACT), inp(P, 29) + (size_t)1 * NEXP * 2048}; pg8::gemm_phase<pg8::EpiSwiGlu, pg8::MoeOrder<8>, true, true>(P.lds, g, S, E); }
        SEAM(cb + 6);
        if (IN(cb + 7) && EN(14)) _Pragma("unroll") for (int rep_ = 0; rep_ < REPS(14); ++rep_) { const Frame P0 = pframe(F); moe_tables(P0, 1); }
        if (IN(cb + 7) && EN(14)) _Pragma("unroll") for (int rep_ = 0; rep_ < REPS(14); ++rep_) { const Frame P = pframe(F); const int nrt = __builtin_amdgcn_readfirstlane(((const LAS int*)(P.lds + UP_TSTART))[32]);
            pg8::Gemm g{wsp<bf16>(P, WS_ACT), wsp<bf16>(P, WS_WTDN) + (size_t)1 * NEXP * DM * DM, nrt * 256, NEXP * DM, DM, P.wave};
            pg8::MoeOrder<4> S{(const LAS int*)(P.lds + UP_TILEE), nrt, P.G, P.vcu};
            pg8::EpiDown E{wsp<bf16>(P, WS_XG), inp(P, 31) + (size_t)1 * NEXP * DM, wsp<float>(P, WS_RGATE)}; pg8::gemm_phase<pg8::EpiDown, pg8::MoeOrder<4>, true, true>(P.lds, g, S, E); }
        SEAM(cb + 7);
        if (IN(cb + 8) && EN(15)) _Pragma("unroll") for (int rep_ = 0; rep_ < REPS(15); ++rep_) { const Frame P = pframe(F); combine_phase(P, 1, 1 == 0 ? wsp<float>(P, WS_HF) : P.out); }

    }
#undef IN
#undef SEAM
}

extern "C" void kernel_launch(void* const* d_in, const int* in_sizes, int n_in, void* d_out, int out_size, void* d_ws, size_t ws_size, hipStream_t stream) {
    static int grid = 0;
    if (grid == 0) {
        if (n_in != 34 || in_sizes[0] != NTOK * DM || out_size != NTOK * DM || ws_size < WS_END) {
            fprintf(stderr, "kernel_launch: built for 34 inputs, x/out of %d floats, >= %zu bytes of workspace; got n_in %d, in0 %d, out %d, ws %zu; nothing launched\n", NTOK * DM, (size_t)WS_END, n_in, n_in > 0 ? in_sizes[0] : -1, out_size, ws_size);
            grid = -1; return; }
        int dev = 0, cus = 0, per_cu = 0;
        if (hipGetDevice(&dev) != hipSuccess || hipDeviceGetAttribute(&cus, hipDeviceAttributeMultiprocessorCount, dev) != hipSuccess) { fprintf(stderr, "kernel_launch: device query failed\n"); grid = -1; return; }
        if (hipFuncSetAttribute((const void*)fwd_kernel, hipFuncAttributeMaxDynamicSharedMemorySize, LDS_BYTES) != hipSuccess) { fprintf(stderr, "kernel_launch: hipFuncSetAttribute failed\n"); grid = -1; return; }
        if (hipOccupancyMaxActiveBlocksPerMultiprocessor(&per_cu, (const void*)fwd_kernel, NTHR, LDS_BYTES) != hipSuccess || per_cu < 1)
            fprintf(stderr, "kernel_launch: note: occupancy query reports %d workgroups per CU\n", per_cu);
        (void)hipGetLastError();
        grid = cus;
    }
    if (grid < 0) return;
    if (hipMemsetAsync((char*)d_ws + WS_CTL, 0, CTL_ZERO_BYTES, stream) != hipSuccess) { fprintf(stderr, "kernel_launch: memset failed\n"); return; }
    Args a{};
    for (int i = 0; i < 34; ++i) a.in[i] = (const float*)d_in[i];
    a.out = (float*)d_out; a.ws = (unsigned char*)d_ws;
#if MK_PER_PHASE
    for (int p = 0; p < NPH; ++p) { a.ph_lo = p; a.ph_hi = p + 1; hipLaunchKernelGGL(fwd_kernel, dim3(grid), dim3(NTHR), LDS_BYTES, stream, a); }
#else
    a.ph_lo = 0; a.ph_hi = NPH;
    hipLaunchKernelGGL(fwd_kernel, dim3(grid), dim3(NTHR), LDS_BYTES, stream, a);
#endif
    const hipError_t le = hipPeekAtLastError();
    if (le != hipSuccess) fprintf(stderr, "kernel_launch: launch failed: %s\n", hipGetErrorName(le));
}
```

```cpp
#include <hip/hip_runtime.h>
#include <cstdio>
#include <cstdint>
namespace pg8 {
#define PG8_LAS __attribute__((address_space(3)))
typedef unsigned short bf16_t;
typedef short bf16x8 __attribute__((ext_vector_type(8)));
typedef float f32x4 __attribute__((ext_vector_type(4)));
typedef unsigned u32x4 __attribute__((ext_vector_type(4)));
constexpr int BM = 256, BK = 64, HALF = 128, HTB = HALF * BK * 2  , STAGE_BYTES = 8 * HTB, NXCD = 8, WGM = 8;

__host__ __device__ __forceinline__ int lds_byte(int r, int c) { const int st = (r >> 4) * 2 + (c >> 5), rr = r & 15, cc = c & 31, ob = rr * 64 + cc * 2; return st * 1024 + (ob ^ (((ob >> 9) & 1) << 5)); }
__host__ __device__ __forceinline__ void stage_rc(int b, int& R, int& C) { const int st = b / 1024, sb = b % 1024, swz = sb ^ (((sb >> 9) & 1) << 5); R = (st >> 1) * 16 + swz / 64; C = (st & 1) * 32 + (swz % 64) / 2; }
__host__ __device__ __forceinline__ int perm32(int rho) { const int n = rho >> 4, i = rho & 15; return 8 * (i >> 2) + 4 * n + (i & 3); }

struct Unit { int pm, pn; };
struct Gemm { const bf16_t* A; const bf16_t* Bt; int M, N, K; int wid; };

struct StaticOrder {
    int nM, nN, nwg, G, c;
    __host__ __device__ void init(int M, int N, int G_, int c_) { nM = M / BM; nN = N / BM; nwg = nM * nN; G = G_; c = c_; }
    __host__ __device__ bool next(int i, Unit& u) const {
        const long L = (long)i * G + c; if (L >= nwg) return false;
        int wgid = (int)L; { const int q = nwg / NXCD, r = nwg % NXCD, xcd = wgid % NXCD, off = wgid / NXCD; wgid = (xcd < r ? xcd * (q + 1) : r * (q + 1) + (xcd - r) * q) + off; }
        const int nig = WGM * nN, gid = wgid / nig, fm = gid * WGM, gsz = (nM - fm) < WGM ? (nM - fm) : WGM;
        u.pm = fm + ((wgid % nig) % gsz); u.pn = (wgid % nig) / gsz; return true;
    }
    __device__ __forceinline__ void a_ready(const Unit&) const {}
    __device__ __forceinline__ void done(const Unit&) const {}
};

__device__ __forceinline__ unsigned cvt_pk_bf16(float lo, float hi) { unsigned r; asm volatile("v_cvt_pk_bf16_f32 %0, %1, %2" : "=v"(r) : "v"(lo), "v"(hi)); return r; }
typedef float f32x2 __attribute__((ext_vector_type(2)));
__device__ __forceinline__ f32x2 gelu_pk(f32x2 v) {
    const f32x2 av = __builtin_elementwise_abs(v), d = av * 0.2316418882f + 1.0f;
    f32x2 t; t.x = __builtin_amdgcn_rcpf(d.x); t.y = __builtin_amdgcn_rcpf(d.y);
    f32x2 q = t * 0.5307027145f + (-0.7265760135f); q = q * t + 0.7107068705f; q = q * t + (-0.142248368f); q = q * t + 0.127414796f; q = q * t;
    const f32x2 s = (v * v) * (-0.72134752044f);
    f32x2 e; e.x = __builtin_amdgcn_exp2f(s.x); e.y = __builtin_amdgcn_exp2f(s.y);
    const f32x2 m = v * (q * e), r = v - m;
    f32x2 o; o.x = v.x < 0.f ? m.x : r.x; o.y = v.y < 0.f ? m.y : r.y; return o;
}

template <int ACT  > struct EpiBf16 {
    static constexpr bool PERM = true, AFTER_DRAIN = false; static_assert(ACT == 0 || ACT == 1, "EpiBf16: ACT is 0 (none) or 1 (gelu_pk)");
    bf16_t* O; int ldc; const float* bias; int split_cols; size_t split_stride; float scale0;
    __device__ __forceinline__ void operator()(const f32x4 (&acc)[2][2][4][2], const Unit& u, int wr, int wc, int fr, int fq) const {
        const int row0 = u.pm * BM + wr * 64 + fr; int colt = u.pn * BM; bf16_t* base = O;
        float sc = 1.f; if (split_cols) { const int t = colt / split_cols; base += (size_t)t * split_stride; colt -= t * split_cols; if (t == 0) sc = scale0; }
        const int col0 = colt + wc * 32 + 8 * fq, bcol0 = u.pn * BM + wc * 32 + 8 * fq;
        f32x4 bv[2][2];
#pragma unroll
        for (int bj = 0; bj < 2; ++bj)
#pragma unroll
            for (int n = 0; n < 2; ++n) bv[bj][n] = bias ? *(const f32x4*)(bias + bcol0 + bj * HALF + 4 * n) : (f32x4){0.f, 0.f, 0.f, 0.f};
#pragma unroll
        for (int ai = 0; ai < 2; ++ai)
#pragma unroll
            for (int m = 0; m < 4; ++m) { bf16_t* rowp = base + (size_t)(row0 + ai * HALF + m * 16) * ldc + col0;
#pragma unroll
                for (int bj = 0; bj < 2; ++bj) { f32x4 v0 = acc[ai][bj][m][0] + bv[bj][0], v1 = acc[ai][bj][m][1] + bv[bj][1];
                    if (ACT == 1) { f32x2 a = gelu_pk((f32x2){v0[0], v0[1]}), b = gelu_pk((f32x2){v0[2], v0[3]}), c = gelu_pk((f32x2){v1[0], v1[1]}), d = gelu_pk((f32x2){v1[2], v1[3]});
                        v0 = (f32x4){a.x, a.y, b.x, b.y}; v1 = (f32x4){c.x, c.y, d.x, d.y}; }
                    v0 = v0 * sc; v1 = v1 * sc; u32x4 w; w.x = cvt_pk_bf16(v0[0], v0[1]); w.y = cvt_pk_bf16(v0[2], v0[3]); w.z = cvt_pk_bf16(v1[0], v1[1]); w.w = cvt_pk_bf16(v1[2], v1[3]);
                    *(u32x4*)(rowp + bj * HALF) = w; } }
    }
};
template <class Epi, class Sched, bool ALIGN_EPI = false, bool SP2 = false>
__device__ __forceinline__ void gemm_phase(PG8_LAS unsigned char* lds, const Gemm g, const Sched& S, const Epi& E) {
    int tid_; asm volatile("v_mbcnt_lo_u32_b32 %0, -1, 0\n\tv_mbcnt_hi_u32_b32 %0, -1, %0" : "=v"(tid_)); tid_ += g.wid * 64;
    const int tid = tid_, wid = __builtin_amdgcn_readfirstlane(tid >> 6), lane = tid & 63, wr = wid >> 2, wc = wid & 3, fr = lane & 15, fq = lane >> 4;
    const int K = g.K, nt = K / BK;
    unsigned voffA[2], voffB[2];
#pragma unroll
    for (int i = 0; i < 2; ++i) { int R, C; stage_rc(tid * 16 + i * 8192, R, C); const int Rb = Epi::PERM ? ((R & ~31) + perm32(R & 31)) : R;
        voffA[i] = (unsigned)(R * K + C) * 2u; voffB[i] = (unsigned)(Rb * K + C) * 2u; }
    const size_t kstep = (size_t)(BK * 2);
    const size_t hstep = (size_t)HALF * K * 2;
    const size_t tstep = 2 * hstep;
    const unsigned ldsw = (unsigned)wid * 1024u;
    const int aoff = lds_byte(wr * 64 + fr, fq * 8), boff = lds_byte(wc * 32 + fr, fq * 8);
#define PG8_SA(b, h) (((b) * 2 + (h)) * HTB)
#define PG8_SB(b, h) ((4 + (b) * 2 + (h)) * HTB)
#define PG8_STAGE(bufoff, gbase, voff) do { _Pragma("unroll") for (int _i = 0; _i < 2; ++_i) \
        __builtin_amdgcn_global_load_lds((const unsigned*)((const char*)(gbase) + (voff)[_i]), (PG8_LAS unsigned*)(lds + (bufoff) + ldsw + _i * 8192), 16, 0, 0); } while (0)
#define PG8_LDA(dst, b, h) do { _Pragma("unroll") for (int m = 0; m < 4; ++m) _Pragma("unroll") for (int k = 0; k < 2; ++k) dst[m][k] = *(const PG8_LAS bf16x8*)(lds + PG8_SA(b, h) + aoff + m * 2048 + k * 1024); } while (0)
#define PG8_LDB(dst, b, h) do { _Pragma("unroll") for (int n = 0; n < 2; ++n) _Pragma("unroll") for (int k = 0; k < 2; ++k) dst[n][k] = *(const PG8_LAS bf16x8*)(lds + PG8_SB(b, h) + boff + n * 2048 + k * 1024); } while (0)
#define PG8_MMA(ai, bj, At, Bt) do { __builtin_amdgcn_s_setprio(1); _Pragma("unroll") for (int m = 0; m < 4; ++m) _Pragma("unroll") for (int n = 0; n < 2; ++n) _Pragma("unroll") for (int k = 0; k < 2; ++k) \
        acc[ai][bj][m][n] = __builtin_amdgcn_mfma_f32_16x16x32_bf16(Bt[n][k], At[m][k], acc[ai][bj][m][n], 0, 0, 0); __builtin_amdgcn_s_setprio(0); } while (0)
#define PG8_WAIT_V(n) asm volatile("s_waitcnt vmcnt(" #n ")" ::: "memory")
#define PG8_WAIT_L(n) asm volatile("s_waitcnt lgkmcnt(" #n ")" ::: "memory")
#define PG8_BAR __builtin_amdgcn_s_barrier()
#define PG8_SCHED __builtin_amdgcn_sched_barrier(0)
    Unit cur, nxt; int ui = 0;
    if (!S.next(0, cur)) return;
    f32x4 acc[2][2][4][2];
#pragma unroll
    for (int a = 0; a < 2; ++a)
#pragma unroll
        for (int b = 0; b < 2; ++b)
#pragma unroll
            for (int m = 0; m < 4; ++m)
#pragma unroll
                for (int n = 0; n < 2; ++n) acc[a][b][m][n] = (f32x4){0.f, 0.f, 0.f, 0.f};
    bf16x8 At[4][2], B0[2][2], B1[2][2];
    const char* cA = (const char*)g.A + (size_t)cur.pm * tstep; const char* cB = (const char*)g.Bt + (size_t)cur.pn * tstep;
    S.a_ready(cur);
    if constexpr (SP2) {
        PG8_STAGE(PG8_SB(0, 0), cB, voffB); PG8_STAGE(PG8_SB(0, 1), cB + hstep, voffB); PG8_STAGE(PG8_SA(0, 0), cA, voffA); PG8_STAGE(PG8_SA(0, 1), cA + hstep, voffA);
        if (wr == 1) PG8_BAR;
        PG8_WAIT_V(2); PG8_BAR;
        PG8_STAGE(PG8_SB(1, 0), cB + kstep, voffB); PG8_STAGE(PG8_SA(1, 0), cA + kstep, voffA); PG8_STAGE(PG8_SB(1, 1), cB + hstep + kstep, voffB);
        PG8_WAIT_V(6); PG8_BAR;
    } else {
        PG8_STAGE(PG8_SB(0, 0), cB, voffB); PG8_STAGE(PG8_SA(0, 0), cA, voffA); PG8_STAGE(PG8_SB(0, 1), cB + hstep, voffB); PG8_STAGE(PG8_SA(0, 1), cA + hstep, voffA);
        if (wr == 1) PG8_BAR;
        PG8_WAIT_V(4); PG8_BAR;
        PG8_STAGE(PG8_SB(1, 0), cB + kstep, voffB); PG8_STAGE(PG8_SA(1, 0), cA + kstep, voffA); PG8_STAGE(PG8_SB(1, 1), cB + hstep + kstep, voffB);
        PG8_WAIT_V(6); PG8_BAR;
    }
    for (;;) {
        const bool has_next = S.next(ui + 1, nxt);
        const char* nA = has_next ? (const char*)g.A + (size_t)nxt.pm * tstep : cA; const char* nB = has_next ? (const char*)g.Bt + (size_t)nxt.pn * tstep : cB;
        for (int t = 0; t < nt; t += 2) {
            const bool last = (t == nt - 2);
            const char* a1 = cA + (size_t)(t + 1) * kstep;
            const char* a2 = last ? nA : cA + (size_t)(t + 2) * kstep; const char* b2 = last ? nB : cB + (size_t)(t + 2) * kstep;
            const char* a3 = a2 + kstep; const char* b3 = b2 + kstep;
            if (last && has_next) S.a_ready(nxt);
            if constexpr (SP2) {
            PG8_LDB(B0, 0, 0); PG8_LDB(B1, 0, 1); PG8_SCHED; PG8_LDA(At, 0, 0); PG8_STAGE(PG8_SA(1, 1), a1 + hstep, voffA);
            PG8_WAIT_V(8); PG8_WAIT_L(0); PG8_BAR; PG8_MMA(0, 0, At, B0); PG8_MMA(0, 1, At, B1); PG8_BAR; PG8_SCHED;
            PG8_LDA(At, 0, 1); PG8_STAGE(PG8_SB(0, 0), b2, voffB); PG8_STAGE(PG8_SB(0, 1), b2 + hstep, voffB); PG8_STAGE(PG8_SA(0, 0), a2, voffA);
            PG8_WAIT_V(8); PG8_WAIT_L(0); PG8_BAR; PG8_MMA(1, 0, At, B0); PG8_MMA(1, 1, At, B1); PG8_BAR; PG8_SCHED;
            PG8_LDB(B0, 1, 0); PG8_LDB(B1, 1, 1); PG8_SCHED; PG8_LDA(At, 1, 0); PG8_STAGE(PG8_SA(0, 1), a2 + hstep, voffA);
            PG8_WAIT_V(8); PG8_WAIT_L(0); PG8_BAR; PG8_MMA(0, 0, At, B0); PG8_MMA(0, 1, At, B1); PG8_BAR; PG8_SCHED;
            PG8_LDA(At, 1, 1); PG8_STAGE(PG8_SB(1, 0), b3, voffB); PG8_STAGE(PG8_SB(1, 1), b3 + hstep, voffB); PG8_STAGE(PG8_SA(1, 0), a3, voffA);
            PG8_WAIT_V(8); PG8_WAIT_L(0); PG8_BAR; PG8_MMA(1, 0, At, B0); PG8_MMA(1, 1, At, B1); PG8_BAR; PG8_SCHED;
            } else {
            PG8_LDB(B0, 0, 0); PG8_SCHED; PG8_LDA(At, 0, 0); PG8_STAGE(PG8_SA(1, 1), a1 + hstep, voffA);
            PG8_WAIT_L(8); PG8_BAR; PG8_WAIT_L(0); PG8_MMA(0, 0, At, B0); PG8_BAR; PG8_SCHED;
            PG8_LDB(B1, 0, 1); PG8_STAGE(PG8_SB(0, 0), b2, voffB);
            PG8_BAR; PG8_WAIT_L(0); PG8_MMA(0, 1, At, B1); PG8_BAR;
            PG8_LDA(At, 0, 1); PG8_STAGE(PG8_SA(0, 0), a2, voffA);
            PG8_BAR; PG8_WAIT_L(0); PG8_MMA(1, 0, At, B0); PG8_BAR; PG8_SCHED;
            PG8_STAGE(PG8_SB(0, 1), b2 + hstep, voffB);
            PG8_WAIT_V(6); PG8_BAR; PG8_MMA(1, 1, At, B1); PG8_BAR;
            PG8_LDB(B0, 1, 0); PG8_SCHED; PG8_LDA(At, 1, 0); PG8_STAGE(PG8_SA(0, 1), a2 + hstep, voffA);
            PG8_WAIT_L(8); PG8_BAR; PG8_WAIT_L(0); PG8_MMA(0, 0, At, B0); PG8_BAR; PG8_SCHED;
            PG8_LDB(B1, 1, 1); PG8_STAGE(PG8_SB(1, 0), b3, voffB);
            PG8_BAR; PG8_WAIT_L(0); PG8_MMA(0, 1, At, B1); PG8_BAR;
            PG8_LDA(At, 1, 1); PG8_STAGE(PG8_SA(1, 0), a3, voffA);
            PG8_BAR; PG8_WAIT_L(0); PG8_MMA(1, 0, At, B0); PG8_BAR; PG8_SCHED;
            PG8_STAGE(PG8_SB(1, 1), b3 + hstep, voffB);
            PG8_WAIT_V(6); PG8_BAR; PG8_MMA(1, 1, At, B1); PG8_BAR;
            }
        }
        if constexpr (ALIGN_EPI) { if (wr == 0) PG8_BAR; }
        if constexpr (!Epi::AFTER_DRAIN) { E(acc, cur, wr, wc, fr, fq); S.done(cur); }
        if (!has_next) break;
#pragma unroll
        for (int a = 0; a < 2; ++a)
#pragma unroll
            for (int b = 0; b < 2; ++b)
#pragma unroll
                for (int m = 0; m < 4; ++m)
#pragma unroll
                    for (int n = 0; n < 2; ++n) acc[a][b][m][n] = (f32x4){0.f, 0.f, 0.f, 0.f};
        cur = nxt; cA = nA; cB = nB; ++ui;
        if constexpr (ALIGN_EPI) { if (wr == 1) PG8_BAR; }
    }
    PG8_WAIT_V(0);
    if constexpr (!ALIGN_EPI) { if (wr == 0) PG8_BAR; }
    PG8_BAR;
    if constexpr (Epi::AFTER_DRAIN) { E.fused(acc, cur, wr, wc, fr, fq, lds, wid, lane); S.done(cur); }
#undef PG8_SA
#undef PG8_SB
#undef PG8_STAGE
#undef PG8_LDA
#undef PG8_LDB
#undef PG8_MMA
#undef PG8_WAIT_V
#undef PG8_WAIT_L
#undef PG8_BAR
#undef PG8_SCHED
}
template <class Epi, class Sched, class AMap, bool ALIGN_EPI = false>
__device__ __forceinline__ void gemm_phase_g(PG8_LAS unsigned char* lds, const Gemm g, const Sched& S, const Epi& E, const AMap& AM) {
    constexpr bool SP2 = true;
    int tid_; asm volatile("v_mbcnt_lo_u32_b32 %0, -1, 0\n\tv_mbcnt_hi_u32_b32 %0, -1, %0" : "=v"(tid_)); tid_ += g.wid * 64;
    const int tid = tid_, wid = __builtin_amdgcn_readfirstlane(tid >> 6), lane = tid & 63, wr = wid >> 2, wc = wid & 3, fr = lane & 15, fq = lane >> 4;
    const int K = g.K, nt = K / BK;
    unsigned voffB[2]; int pR[2], pC[2]; unsigned gc[2][2], gn[2][2];
#pragma unroll
    for (int i = 0; i < 2; ++i) { int R, C; stage_rc(tid * 16 + i * 8192, R, C); const int Rb = Epi::PERM ? ((R & ~31) + perm32(R & 31)) : R;
        pR[i] = R; pC[i] = C; voffB[i] = (unsigned)(Rb * K + C) * 2u; }
    const size_t kstep = (size_t)(BK * 2);
    const size_t hstep = (size_t)HALF * K * 2;
    const size_t tstep = 2 * hstep;
    const unsigned ldsw = (unsigned)wid * 1024u;
    const int aoff = lds_byte(wr * 64 + fr, fq * 8), boff = lds_byte(wc * 32 + fr, fq * 8);
#define PG8_SA(b, h) (((b) * 2 + (h)) * HTB)
#define PG8_SB(b, h) ((4 + (b) * 2 + (h)) * HTB)
#define PG8_STAGE(bufoff, gbase, voff) do { _Pragma("unroll") for (int _i = 0; _i < 2; ++_i) \
        __builtin_amdgcn_global_load_lds((const unsigned*)((const char*)(gbase) + (voff)[_i]), (PG8_LAS unsigned*)(lds + (bufoff) + ldsw + _i * 8192), 16, 0, 0); } while (0)
#define PG8_LDA(dst, b, h) do { _Pragma("unroll") for (int m = 0; m < 4; ++m) _Pragma("unroll") for (int k = 0; k < 2; ++k) dst[m][k] = *(const PG8_LAS bf16x8*)(lds + PG8_SA(b, h) + aoff + m * 2048 + k * 1024); } while (0)
#define PG8_LDB(dst, b, h) do { _Pragma("unroll") for (int n = 0; n < 2; ++n) _Pragma("unroll") for (int k = 0; k < 2; ++k) dst[n][k] = *(const PG8_LAS bf16x8*)(lds + PG8_SB(b, h) + boff + n * 2048 + k * 1024); } while (0)
#define PG8_MMA(ai, bj, At, Bt) do { __builtin_amdgcn_s_setprio(1); _Pragma("unroll") for (int m = 0; m < 4; ++m) _Pragma("unroll") for (int n = 0; n < 2; ++n) _Pragma("unroll") for (int k = 0; k < 2; ++k) \
        acc[ai][bj][m][n] = __builtin_amdgcn_mfma_f32_16x16x32_bf16(Bt[n][k], At[m][k], acc[ai][bj][m][n], 0, 0, 0); __builtin_amdgcn_s_setprio(0); } while (0)
#define PG8_WAIT_V(n) asm volatile("s_waitcnt vmcnt(" #n ")" ::: "memory")
#define PG8_WAIT_L(n) asm volatile("s_waitcnt lgkmcnt(" #n ")" ::: "memory")
#define PG8_BAR __builtin_amdgcn_s_barrier()
#define PG8_SCHED __builtin_amdgcn_sched_barrier(0)
    Unit cur, nxt; int ui = 0;
    if (!S.next(0, cur)) return;
    f32x4 acc[2][2][4][2];
#pragma unroll
    for (int a = 0; a < 2; ++a)
#pragma unroll
        for (int b = 0; b < 2; ++b)
#pragma unroll
            for (int m = 0; m < 4; ++m)
#pragma unroll
                for (int n = 0; n < 2; ++n) acc[a][b][m][n] = (f32x4){0.f, 0.f, 0.f, 0.f};
    bf16x8 At[4][2], B0[2][2], B1[2][2];
    const char* const cA = (const char*)g.A; const char* cB = (const char*)g.Bt + (size_t)cur.pn * tstep;
    AM.prefetch(cur, 0, wid, lane);
    asm volatile("s_waitcnt vmcnt(0)" ::: "memory"); __builtin_amdgcn_s_barrier(); asm volatile("" ::: "memory");
#pragma unroll
    for (int h = 0; h < 2; ++h)
#pragma unroll
        for (int i = 0; i < 2; ++i) gc[h][i] = AM.off(cur, 0, h * HALF + pR[i], pC[i], K);
    S.a_ready(cur);
    if constexpr (SP2) {
        PG8_STAGE(PG8_SB(0, 0), cB, voffB); PG8_STAGE(PG8_SB(0, 1), cB + hstep, voffB); PG8_STAGE(PG8_SA(0, 0), cA, gc[0]); PG8_STAGE(PG8_SA(0, 1), cA, gc[1]);
        if (wr == 1) PG8_BAR;
        PG8_WAIT_V(2); PG8_BAR;
        PG8_STAGE(PG8_SB(1, 0), cB + kstep, voffB); PG8_STAGE(PG8_SA(1, 0), cA + kstep, gc[0]); PG8_STAGE(PG8_SB(1, 1), cB + hstep + kstep, voffB);
        PG8_WAIT_V(6); PG8_BAR;
    } else {
        PG8_STAGE(PG8_SB(0, 0), cB, voffB); PG8_STAGE(PG8_SA(0, 0), cA, gc[0]); PG8_STAGE(PG8_SB(0, 1), cB + hstep, voffB); PG8_STAGE(PG8_SA(0, 1), cA, gc[1]);
        if (wr == 1) PG8_BAR;
        PG8_WAIT_V(4); PG8_BAR;
        PG8_STAGE(PG8_SB(1, 0), cB + kstep, voffB); PG8_STAGE(PG8_SA(1, 0), cA + kstep, gc[0]); PG8_STAGE(PG8_SB(1, 1), cB + hstep + kstep, voffB);
        PG8_WAIT_V(6); PG8_BAR;
    }
    for (;;) {
        const bool has_next = S.next(ui + 1, nxt);
        const char* nB = has_next ? (const char*)g.Bt + (size_t)nxt.pn * tstep : cB;
        if (has_next) AM.prefetch(nxt, (ui + 1) & 1, wid, lane);
        for (int t = 0; t < nt; t += 2) {
            const bool last = (t == nt - 2);
            const char* a1 = cA + (size_t)(t + 1) * kstep;
            const char* a2 = last ? cA : cA + (size_t)(t + 2) * kstep; const char* b2 = last ? nB : cB + (size_t)(t + 2) * kstep;
            if (last) {
#pragma unroll
                for (int h = 0; h < 2; ++h)
#pragma unroll
                    for (int i = 0; i < 2; ++i) gn[h][i] = has_next ? AM.off(nxt, (ui + 1) & 1, h * HALF + pR[i], pC[i], K) : gc[h][i]; }
            unsigned o2[2][2];
#pragma unroll
            for (int h = 0; h < 2; ++h)
#pragma unroll
                for (int i = 0; i < 2; ++i) o2[h][i] = last ? gn[h][i] : gc[h][i];
            const char* a3 = a2 + kstep; const char* b3 = b2 + kstep;
            if (last && has_next) S.a_ready(nxt);
            if constexpr (SP2) {
            PG8_LDB(B0, 0, 0); PG8_LDB(B1, 0, 1); PG8_SCHED; PG8_LDA(At, 0, 0); PG8_STAGE(PG8_SA(1, 1), a1, gc[1]);
            PG8_WAIT_V(8); PG8_WAIT_L(0); PG8_BAR; PG8_MMA(0, 0, At, B0); PG8_MMA(0, 1, At, B1); PG8_BAR; PG8_SCHED;
            PG8_LDA(At, 0, 1); PG8_STAGE(PG8_SB(0, 0), b2, voffB); PG8_STAGE(PG8_SB(0, 1), b2 + hstep, voffB); PG8_STAGE(PG8_SA(0, 0), a2, o2[0]);
            PG8_WAIT_V(8); PG8_WAIT_L(0); PG8_BAR; PG8_MMA(1, 0, At, B0); PG8_MMA(1, 1, At, B1); PG8_BAR; PG8_SCHED;
            PG8_LDB(B0, 1, 0); PG8_LDB(B1, 1, 1); PG8_SCHED; PG8_LDA(At, 1, 0); PG8_STAGE(PG8_SA(0, 1), a2, o2[1]);
            PG8_WAIT_V(8); PG8_WAIT_L(0); PG8_BAR; PG8_MMA(0, 0, At, B0); PG8_MMA(0, 1, At, B1); PG8_BAR; PG8_SCHED;
            PG8_LDA(At, 1, 1); PG8_STAGE(PG8_SB(1, 0), b3, voffB); PG8_STAGE(PG8_SB(1, 1), b3 + hstep, voffB); PG8_STAGE(PG8_SA(1, 0), a3, o2[0]);
            PG8_WAIT_V(8); PG8_WAIT_L(0); PG8_BAR; PG8_MMA(1, 0, At, B0); PG8_MMA(1, 1, At, B1); PG8_BAR; PG8_SCHED;
            } else {
            PG8_LDB(B0, 0, 0); PG8_SCHED; PG8_LDA(At, 0, 0); PG8_STAGE(PG8_SA(1, 1), a1, gc[1]);
            PG8_WAIT_L(8); PG8_BAR; PG8_WAIT_L(0); PG8_MMA(0, 0, At, B0); PG8_BAR; PG8_SCHED;
            PG8_LDB(B1, 0, 1); PG8_STAGE(PG8_SB(0, 0), b2, voffB);
            PG8_BAR; PG8_WAIT_L(0); PG8_MMA(0, 1, At, B1); PG8_BAR;
            PG8_LDA(At, 0, 1); PG8_STAGE(PG8_SA(0, 0), a2, o2[0]);
            PG8_BAR; PG8_WAIT_L(0); PG8_MMA(1, 0, At, B0); PG8_BAR; PG8_SCHED;
            PG8_STAGE(PG8_SB(0, 1), b2 + hstep, voffB);
            PG8_WAIT_V(6); PG8_BAR; PG8_MMA(1, 1, At, B1); PG8_BAR;
            PG8_LDB(B0, 1, 0); PG8_SCHED; PG8_LDA(At, 1, 0); PG8_STAGE(PG8_SA(0, 1), a2, o2[1]);
            PG8_WAIT_L(8); PG8_BAR; PG8_WAIT_L(0); PG8_MMA(0, 0, At, B0); PG8_BAR; PG8_SCHED;
            PG8_LDB(B1, 1, 1); PG8_STAGE(PG8_SB(1, 0), b3, voffB);
            PG8_BAR; PG8_WAIT_L(0); PG8_MMA(0, 1, At, B1); PG8_BAR;
            PG8_LDA(At, 1, 1); PG8_STAGE(PG8_SA(1, 0), a3, o2[0]);
            PG8_BAR; PG8_WAIT_L(0); PG8_MMA(1, 0, At, B0); PG8_BAR; PG8_SCHED;
            PG8_STAGE(PG8_SB(1, 1), b3 + hstep, voffB);
            PG8_WAIT_V(6); PG8_BAR; PG8_MMA(1, 1, At, B1); PG8_BAR;
            }
        }
        if constexpr (ALIGN_EPI) { if (wr == 0) PG8_BAR; }
        if constexpr (!Epi::AFTER_DRAIN) { E(acc, cur, wr, wc, fr, fq); S.done(cur); }
        if (!has_next) break;
#pragma unroll
        for (int a = 0; a < 2; ++a)
#pragma unroll
            for (int b = 0; b < 2; ++b)
#pragma unroll
                for (int m = 0; m < 4; ++m)
#pragma unroll
                    for (int n = 0; n < 2; ++n) acc[a][b][m][n] = (f32x4){0.f, 0.f, 0.f, 0.f};
        cur = nxt; cB = nB; ++ui;
#pragma unroll
        for (int h = 0; h < 2; ++h)
#pragma unroll
            for (int i = 0; i < 2; ++i) gc[h][i] = gn[h][i];
        if constexpr (ALIGN_EPI) { if (wr == 1) PG8_BAR; }
    }
    PG8_WAIT_V(0);
    if constexpr (!ALIGN_EPI) { if (wr == 0) PG8_BAR; }
    PG8_BAR;
    if constexpr (Epi::AFTER_DRAIN) { E.fused(acc, cur, wr, wc, fr, fq, lds, wid, lane); S.done(cur); }
#undef PG8_SA
#undef PG8_SB
#undef PG8_STAGE
#undef PG8_LDA
#undef PG8_LDB
#undef PG8_MMA
#undef PG8_WAIT_V
#undef PG8_WAIT_L
#undef PG8_BAR
#undef PG8_SCHED
}
}
#define LAS __attribute__((address_space(3)))
#define XB_TMO      128
#define XB_XCNT(j)  (256  + 64 * (j))
#define XB_XSUB(j)  (1280 + 64 * (j))
#define XB_XGEN(j)  (2304 + 64 * (j))
#define XB_TOP      3328
#define XB_TOPGEN   3392
#define XCD_BAR_WORDS 3456
#define XB_SPIN_CAP (1u << 18)

__device__ __forceinline__ unsigned xb_ld(unsigned* p)              { return __hip_atomic_load(p, __ATOMIC_RELAXED, __HIP_MEMORY_SCOPE_AGENT); }
__device__ __forceinline__ unsigned xb_add(unsigned* p, unsigned v) { return __hip_atomic_fetch_add(p, v, __ATOMIC_RELAXED, __HIP_MEMORY_SCOPE_AGENT); }
__device__ __forceinline__ unsigned xb_xcc_id() { return (unsigned)__builtin_amdgcn_s_getreg((3 << 11) | 20) & 0xFu; }
#define XB_SPIN(cond, bar) do { unsigned _sp = 0; while (cond) { __builtin_amdgcn_s_sleep(1); \
    if ((++_sp & 255u) == 0u) { if (xb_ld(&(bar)[XB_TMO])) break; if (_sp > XB_SPIN_CAP) { atomicAdd(&(bar)[XB_TMO], 1u); break; } } } } while (0)

__device__ __forceinline__ int xb_lane() { int l; asm volatile("v_mbcnt_lo_u32_b32 %0, -1, 0\n\tv_mbcnt_hi_u32_b32 %0, -1, %0" : "=v"(l)); return l; }
struct XcdBarrier {
    bool w0;
    unsigned* bar; unsigned x;
    volatile LAS unsigned* st;
};

__device__ __forceinline__ XcdBarrier xcd_barrier_post(unsigned* bar, volatile LAS unsigned* st, bool w0) {
    XcdBarrier b; b.w0 = w0; b.bar = bar; b.x = xb_xcc_id(); b.st = st;
    if (b.w0 && xb_lane() == 0) (void)xb_add(&bar[XB_XCNT(b.x)], 1u);
    return b;
}
__device__ __forceinline__ void xcd_barrier_complete(unsigned* bar, unsigned x, unsigned& nloc, unsigned& nx) {
    const unsigned G = gridDim.x * gridDim.y * gridDim.z;
    unsigned sum, cnt, mine, sp = 0u;
    for (;;) {
        sum = 0u; cnt = 0u; mine = 0u;
#pragma unroll
        for (unsigned j = 0; j < 16; ++j) { const unsigned c = xb_ld(&bar[XB_XCNT(j)]); sum += c; cnt += (c > 0u) ? 1u : 0u; mine = (j == x) ? c : mine; }
        if (sum == G) break;
        __builtin_amdgcn_s_sleep(1);
        if ((++sp & 255u) == 0u) { if (xb_ld(&bar[XB_TMO])) break; if (sp > XB_SPIN_CAP) { atomicAdd(&bar[XB_TMO], 1u); break; } }
    }
    nloc = mine > 0u ? mine : 1u; nx = cnt > 0u ? cnt : 1u;
}

__device__ __forceinline__ void xcd_barrier(const XcdBarrier& b) {
    asm volatile("s_waitcnt vmcnt(0)" ::: "memory");
    __syncthreads();
    if (b.w0 && xb_lane() == 0) {
        unsigned* bar = b.bar;
        __builtin_amdgcn_s_waitcnt(0);
        unsigned nloc = b.st[0], nx = b.st[1];
        if (nloc == 0u) { xcd_barrier_complete(bar, b.x, nloc, nx); b.st[0] = nloc; b.st[1] = nx; }
        const unsigned old = xb_add(&bar[XB_XSUB(b.x)], 1u);
        const unsigned gen = old / nloc;
        if (old + 1u == (gen + 1u) * nloc) {
            __builtin_amdgcn_fence(__ATOMIC_RELEASE, "agent");
            asm volatile("s_waitcnt vmcnt(0)" ::: "memory");
            const unsigned og = xb_add(&bar[XB_TOP], 1u);
            const unsigned tg = og / nx;
            if (og + 1u == (tg + 1u) * nx) xb_add(&bar[XB_TOPGEN], 1u);
            else XB_SPIN(xb_ld(&bar[XB_TOPGEN]) == tg, bar);
            __builtin_amdgcn_fence(__ATOMIC_ACQUIRE, "agent");
            xb_add(&bar[XB_XGEN(b.x)], 1u);
            asm volatile("s_waitcnt vmcnt(0)" ::: "memory");
        } else {
            XB_SPIN(xb_ld(&bar[XB_XGEN(b.x)]) == gen, bar);
            __builtin_amdgcn_fence(__ATOMIC_ACQUIRE, "agent");
            asm volatile("s_waitcnt vmcnt(0)" ::: "memory");
        }
    }
    __syncthreads();
}
#define GAS __attribute__((address_space(1)))
#ifndef LAS
#define LAS __attribute__((address_space(3)))
#endif
typedef unsigned short bf16;
typedef unsigned v4u __attribute__((ext_vector_type(4))) __attribute__((may_alias));
typedef unsigned v2u __attribute__((ext_vector_type(2))) __attribute__((may_alias));
typedef float f32x4 __attribute__((ext_vector_type(4))) __attribute__((may_alias));
typedef float f32x2 __attribute__((ext_vector_type(2))) __attribute__((may_alias));
typedef float f32x16 __attribute__((ext_vector_type(16)));
typedef short bf16x8 __attribute__((ext_vector_type(8))) __attribute__((may_alias));
typedef __bf16 bf2_t __attribute__((ext_vector_type(2)));

constexpr int NWAVES = 8, NTHR = 512;
constexpr int NB = 4, SEQ = 8192, NTOK = NB * SEQ, DM = 1024, MEML = 256, NMEM = NB * MEML;
constexpr int EVW = 1792;
constexpr int C_CQ = 0, C_KA = 256, C_VA = 384, C_KI = 512, C_QB = 576, C_KB = 1088, C_WI = 1600;
constexpr int NEXP = 32, TOPK = 4;
constexpr int NROWS_MAX = NTOK * TOPK + NEXP * 256;
constexpr int NRT_MAX = NROWS_MAX / 256;
constexpr float LN_EPS = 1e-5f;
constexpr float DN_ALPHA = 1.4142135623730951f;
constexpr int SCH = 64, NCHUNK = SEQ / SCH;

constexpr size_t MiB = 1u << 20;
constexpr size_t WS_CTL = 0, CTL_ZERO_BYTES = 1 * MiB;
constexpr size_t WS_ROPE = 1 * MiB;
constexpr size_t WS_APOW = 2 * MiB;
constexpr size_t WS_BB = 5 * MiB;
constexpr size_t WS_WTQ = 6 * MiB;
constexpr size_t WS_WTVB = 1536 * MiB;
constexpr size_t WS_WTIN0 = 8 * MiB;
constexpr size_t WS_WTOUT0 = 13 * MiB;
constexpr size_t WS_WTS5IN = 15 * MiB;
constexpr size_t WS_WTS5OUT = 17 * MiB;
constexpr size_t WS_WTXQ = 21 * MiB;
constexpr size_t WS_WTXK = 25 * MiB;
constexpr size_t WS_WTXV = 29 * MiB;
constexpr size_t WS_WTXO = 33 * MiB;
constexpr size_t WS_MEMB = 37 * MiB;
constexpr size_t WS_KX = 39 * MiB;
constexpr size_t WS_VXT = 43 * MiB;
constexpr size_t WS_W1 = 47 * MiB;
constexpr size_t WS_W3 = 63 * MiB;
constexpr size_t WS_KT = 79 * MiB;
constexpr size_t WS_ELOC = 81 * MiB;
constexpr size_t WS_HS = 97 * MiB;
constexpr size_t WS_KI = 105 * MiB;
constexpr size_t WS_KA = 109 * MiB;
constexpr size_t WS_VA = 117 * MiB;
constexpr size_t WS_WI = 125 * MiB;
constexpr size_t WS_TOKE = 126 * MiB;
constexpr size_t WS_TOKP = 127 * MiB;
constexpr size_t WS_WTGU = 128 * MiB;
constexpr size_t WS_WTDN = 384 * MiB;
constexpr size_t WS_XB = 512 * MiB;
constexpr size_t WS_HF = 576 * MiB;
constexpr size_t WS_T = 704 * MiB;
constexpr size_t WS_SCR = 832 * MiB;
constexpr size_t WS_P1 = WS_SCR;
constexpr size_t WS_CQ = WS_SCR + 144 * MiB;
constexpr size_t WS_QAI = WS_SCR + 160 * MiB;
constexpr size_t WS_OAB = WS_SCR + 224 * MiB;
constexpr size_t WS_VBT = WS_SCR + 288 * MiB;
constexpr size_t WS_QX = WS_SCR;
constexpr size_t WS_AX = WS_SCR + 64 * MiB;
constexpr size_t WS_ELIST = WS_SCR + 128 * MiB;
constexpr size_t WS_EGATE = WS_SCR + 132 * MiB;
constexpr size_t WS_RGATE = WS_SCR + 136 * MiB;
constexpr size_t WS_XG = WS_SCR + 144 * MiB;
constexpr size_t WS_ACT = WS_SCR + 416 * MiB;
constexpr size_t WS_U = WS_SCR;
constexpr size_t WS_YG = WS_SCR + 64 * MiB;
constexpr size_t WS_END = WS_SCR + 688 * MiB;
static_assert(WS_END <= (size_t)1536 * MiB && WS_WTVB + 2 * MiB <= (size_t)2047 * MiB, "workspace map");

constexpr int CW_BAR = 4096;
constexpr int CW_CNT = 16384;

constexpr int RING_BYTES = 131072;
constexpr int UP_OFF = RING_BYTES;
constexpr int UP_MISC = UP_OFF;
constexpr int UP_PTR = UP_OFF + 256;
constexpr int UP_SEL = UP_OFF + 1024;
constexpr int UP_TILEE = UP_OFF + 6144;
constexpr int UP_TSTART = UP_TILEE + 576 * 4;
constexpr int UP_CNT = UP_TSTART + 64 * 4;
constexpr int UP_TOK = UP_OFF + 12288;
constexpr int LDS_BYTES = 147456;
static_assert(UP_CNT + 32 * 4 <= LDS_BYTES, "LDS map");

#define LDS_WAIT() asm volatile("s_waitcnt lgkmcnt(0)" ::: "memory")
#define VM_WAIT() asm volatile("s_waitcnt vmcnt(0)" ::: "memory")
__device__ __forceinline__ unsigned f2bf(float f) { unsigned u = __builtin_bit_cast(unsigned, f); return (u + 0x7fffu + ((u >> 16) & 1u)) >> 16; }
typedef __bf16 bf2cv_t __attribute__((ext_vector_type(2)));
__device__ __forceinline__ unsigned pk2(float lo, float hi) { typedef float f2_t __attribute__((ext_vector_type(2))); const f2_t v = {lo, hi}; return __builtin_bit_cast(unsigned, __builtin_convertvector(v, bf2cv_t)); }
__device__ __forceinline__ float bflo(unsigned w) { return __builtin_bit_cast(float, w << 16); }
__device__ __forceinline__ float bfhi(unsigned w) { return __builtin_bit_cast(float, w & 0xffff0000u); }
__device__ __forceinline__ float bf2f(bf16 h) { return __builtin_bit_cast(float, (unsigned)h << 16); }
__device__ __forceinline__ float dot2bf(unsigned a, unsigned b, float c) { return __builtin_amdgcn_fdot2_f32_bf16(__builtin_bit_cast(bf2_t, a), __builtin_bit_cast(bf2_t, b), c, false); }
__device__ __forceinline__ float dot8bf(v4u a, v4u b, float c) { c = dot2bf(a.x, b.x, c); c = dot2bf(a.y, b.y, c); c = dot2bf(a.z, b.z, c); return dot2bf(a.w, b.w, c); }
__device__ __forceinline__ float shx(float v, int o, int lane) { return __builtin_bit_cast(float, __builtin_amdgcn_ds_bpermute((lane ^ o) << 2, __builtin_bit_cast(int, v))); }
__device__ __forceinline__ int shxi(int v, int o, int lane) { return __builtin_amdgcn_ds_bpermute((lane ^ o) << 2, v); }
__device__ __forceinline__ float wave_sum(float v, int lane) {
#pragma unroll
    for (int o = 1; o < 64; o <<= 1) v += shx(v, o, lane);
    return v;
}
__device__ __forceinline__ float wave_max(float v, int lane) {
#pragma unroll
    for (int o = 1; o < 64; o <<= 1) v = fmaxf(v, shx(v, o, lane));
    return v;
}
__device__ __forceinline__ int wave_sum_i(int v, int lane) {
#pragma unroll
    for (int o = 1; o < 64; o <<= 1) v += shxi(v, o, lane);
    return v;
}
__device__ __forceinline__ int crow(int r, int hf) { return (r & 3) + 8 * (r >> 2) + 4 * hf; }
__device__ __forceinline__ int rperm(int j) { return j < 16 ? ((j & 1) ? 8 + (j >> 1) : (j >> 1)) : j; }

struct Frame {
    LAS unsigned char* lds;
    int tid, lane, wave, vcu, G;
    float* out;
    unsigned char* ws;
};
__device__ __forceinline__ Frame pframe(const Frame& F) {
    Frame P = F;
    { int l; asm volatile("v_mbcnt_lo_u32_b32 %0, -1, 0\n\tv_mbcnt_hi_u32_b32 %0, -1, %0" : "=v"(l)); P.tid = P.wave * 64 + l; }
    asm volatile("" : "+s"(P.ws), "+s"(P.out), "+v"(P.tid), "+s"(P.vcu), "+s"(P.G));
    P.lane = P.tid & 63;
    return P;
}
__device__ __forceinline__ const float* inp(const Frame& F, int i) {
    const unsigned long long p = *(const LAS unsigned long long*)(F.lds + UP_PTR + 8 * i);
    const unsigned lo = (unsigned)__builtin_amdgcn_readfirstlane((int)(unsigned)p), hi = (unsigned)__builtin_amdgcn_readfirstlane((int)(unsigned)(p >> 32));
    return (const float*)(((unsigned long long)hi << 32) | lo);
}
template <class T> __device__ __forceinline__ T* wsp(const Frame& F, size_t off) { return (T*)(F.ws + off); }

namespace pg8 {
struct EpiRope {
    static constexpr bool PERM = true, AFTER_DRAIN = false;
    bf16_t* O; int ldc; const f32x2* rope;
    __device__ __forceinline__ void operator()(const f32x4 (&acc)[2][2][4][2], const Unit& u, int wr, int wc, int fr, int fq) const {
        const int row0 = u.pm * BM + wr * 64 + fr; const int col0 = u.pn * BM + wc * 32 + 8 * fq;
#pragma unroll
        for (int ai = 0; ai < 2; ++ai)
#pragma unroll
            for (int m = 0; m < 4; ++m) { const int row = row0 + ai * HALF + m * 16; const int pos = row & (SEQ - 1); bf16_t* rowp = O + (size_t)row * ldc + col0;
#pragma unroll
                for (int bj = 0; bj < 2; ++bj) { f32x4 v0 = acc[ai][bj][m][0], v1 = acc[ai][bj][m][1];
                    const int c64 = (col0 + bj * HALF) & 63;
                    if (c64 < 16) { const f32x2* rp = rope + pos * 8 + (c64 >> 1);
                        const f32x2 r0 = rp[0], r1 = rp[1], r2 = rp[2], r3 = rp[3];
                        f32x4 w0, w1;
                        w0[0] = v0[0] * r0.x - v0[1] * r0.y; w0[1] = v0[1] * r0.x + v0[0] * r0.y;
                        w0[2] = v0[2] * r1.x - v0[3] * r1.y; w0[3] = v0[3] * r1.x + v0[2] * r1.y;
                        w1[0] = v1[0] * r2.x - v1[1] * r2.y; w1[1] = v1[1] * r2.x + v1[0] * r2.y;
                        w1[2] = v1[2] * r3.x - v1[3] * r3.y; w1[3] = v1[3] * r3.x + v1[2] * r3.y;
                        v0 = w0; v1 = w1; }
                    u32x4 w; w.x = cvt_pk_bf16(v0[0], v0[1]); w.y = cvt_pk_bf16(v0[2], v0[3]); w.z = cvt_pk_bf16(v1[0], v1[1]); w.w = cvt_pk_bf16(v1[2], v1[3]);
                    *(u32x4*)(rowp + bj * HALF) = w; } }
    }
};
struct EpiVT {
    static constexpr bool PERM = true, AFTER_DRAIN = false;
    bf16_t* O; int nrows;
    __device__ __forceinline__ void operator()(const f32x4 (&acc)[2][2][4][2], const Unit& u, int wr, int wc, int fr, int fq) const {
        const int row0 = u.pm * BM + wr * 64 + fr; const int col0 = u.pn * BM + wc * 32 + 8 * fq;
#pragma unroll
        for (int ai = 0; ai < 2; ++ai)
#pragma unroll
            for (int m = 0; m < 4; ++m) { const int row = row0 + ai * HALF + m * 16;
#pragma unroll
                for (int bj = 0; bj < 2; ++bj) { const int col = col0 + bj * HALF; const f32x4 v0 = acc[ai][bj][m][0], v1 = acc[ai][bj][m][1];
                    u32x4 w; w.x = cvt_pk_bf16(v0[0], v0[1]); w.y = cvt_pk_bf16(v0[2], v0[3]); w.z = cvt_pk_bf16(v1[0], v1[1]); w.w = cvt_pk_bf16(v1[2], v1[3]);
                    *(u32x4*)(O + ((size_t)(col >> 5) * nrows + row) * 32 + (col & 31)) = w; } }
    }
};
struct EpiResF32 {
    static constexpr bool PERM = false, AFTER_DRAIN = false;
    const float* R; float* T; int ldc; float alpha;
    __device__ __forceinline__ void operator()(const f32x4 (&acc)[2][2][4][2], const Unit& u, int wr, int wc, int fr, int fq) const {
        const int row0 = u.pm * BM + wr * 64 + fr; const int col0 = u.pn * BM + wc * 32 + 4 * fq;
#pragma unroll
        for (int ai = 0; ai < 2; ++ai)
#pragma unroll
            for (int m = 0; m < 4; ++m) { const size_t off = (size_t)(row0 + ai * HALF + m * 16) * ldc + col0;
#pragma unroll
                for (int bj = 0; bj < 2; ++bj)
#pragma unroll
                    for (int n = 0; n < 2; ++n) { const f32x4 r = *(const f32x4*)(R + off + bj * HALF + n * 16); *(f32x4*)(T + off + bj * HALF + n * 16) = r * alpha + acc[ai][bj][m][n]; } }
    }
};
struct EpiGluRes {
    static constexpr bool PERM = false, AFTER_DRAIN = false;
    const float* R; float* T; int ldc; float alpha;
    __device__ __forceinline__ void operator()(const f32x4 (&acc)[2][2][4][2], const Unit& u, int wr, int wc, int fr, int fq) const {
        const int row0 = u.pm * BM + wr * 64 + fr; const int col0 = u.pn * HALF + wc * 32 + 4 * fq;
#pragma unroll
        for (int ai = 0; ai < 2; ++ai)
#pragma unroll
            for (int m = 0; m < 4; ++m) { const size_t off = (size_t)(row0 + ai * HALF + m * 16) * ldc + col0;
#pragma unroll
                for (int n = 0; n < 2; ++n) { const f32x4 r = *(const f32x4*)(R + off + n * 16); const f32x4 v = acc[ai][0][m][n], g = acc[ai][1][m][n]; f32x4 o;
#pragma unroll
                    for (int i = 0; i < 4; ++i) o[i] = r[i] * alpha + v[i] * __builtin_amdgcn_rcpf(1.0f + __expf(-g[i]));
                    *(f32x4*)(T + off + n * 16) = o; } }
    }
};
struct EpiSwiGlu {
    static constexpr bool PERM = true, AFTER_DRAIN = false;
    bf16_t* O; const float* bgu;
    __device__ __forceinline__ void operator()(const f32x4 (&acc)[2][2][4][2], const Unit& u, int wr, int wc, int fr, int fq) const {
        const int e = u.pn >> 3, ct = u.pn & 7; const int row0 = u.pm * BM + wr * 64 + fr; const int col0 = ct * HALF + wc * 32 + 8 * fq;
        const float* bg = bgu + (size_t)e * 2048 + col0; const float* bu = bg + 1024;
        f32x4 g0 = *(const f32x4*)bg, g1 = *(const f32x4*)(bg + 4), u0 = *(const f32x4*)bu, u1 = *(const f32x4*)(bu + 4);
#pragma unroll
        for (int ai = 0; ai < 2; ++ai)
#pragma unroll
            for (int m = 0; m < 4; ++m) { bf16_t* rowp = O + (size_t)(row0 + ai * HALF + m * 16) * 1024 + col0;
                f32x4 a0 = acc[ai][0][m][0] + g0, a1 = acc[ai][0][m][1] + g1, b0 = acc[ai][1][m][0] + u0, b1 = acc[ai][1][m][1] + u1; float o[8];
#pragma unroll
                for (int i = 0; i < 4; ++i) { float g = fminf(a0[i], 7.0f), up = fminf(fmaxf(b0[i], -7.0f), 7.0f); o[i] = g * __builtin_amdgcn_rcpf(1.0f + __expf(-1.702f * g)) * (up + 1.0f);
                    g = fminf(a1[i], 7.0f); up = fminf(fmaxf(b1[i], -7.0f), 7.0f); o[4 + i] = g * __builtin_amdgcn_rcpf(1.0f + __expf(-1.702f * g)) * (up + 1.0f); }
                u32x4 w; w.x = cvt_pk_bf16(o[0], o[1]); w.y = cvt_pk_bf16(o[2], o[3]); w.z = cvt_pk_bf16(o[4], o[5]); w.w = cvt_pk_bf16(o[6], o[7]);
                *(u32x4*)rowp = w; }
    }
};
struct EpiDown {
    static constexpr bool PERM = true, AFTER_DRAIN = false;
    bf16_t* O; const float* bdn; const float* egate; const PG8_LAS int* tstart; const PG8_LAS int* cnt;
    __device__ __forceinline__ void operator()(const f32x4 (&acc)[2][2][4][2], const Unit& u, int wr, int wc, int fr, int fq) const {
        const int e = u.pn >> 2, ct = u.pn & 3; const int row0 = u.pm * BM + wr * 64 + fr; const int col0 = ct * BM + wc * 32 + 8 * fq;
        const int pos0 = (u.pm - tstart[e]) * BM + wr * 64 + fr, ne = cnt[e]; const float* gp = egate + (size_t)e * NTOK;
        const float* bp = bdn + (size_t)e * 1024 + col0;
        f32x4 bv[2][2];
#pragma unroll
        for (int bj = 0; bj < 2; ++bj)
#pragma unroll
            for (int n = 0; n < 2; ++n) bv[bj][n] = *(const f32x4*)(bp + bj * HALF + 4 * n);
#pragma unroll
        for (int ai = 0; ai < 2; ++ai)
#pragma unroll
            for (int m = 0; m < 4; ++m) { const int row = row0 + ai * HALF + m * 16; const int pos = pos0 + ai * HALF + m * 16; const float gt = (pos < ne) ? gp[pos] : 0.f; bf16_t* rowp = O + (size_t)row * 1024 + col0;
#pragma unroll
                for (int bj = 0; bj < 2; ++bj) { const f32x4 v0 = (acc[ai][bj][m][0] + bv[bj][0]) * gt, v1 = (acc[ai][bj][m][1] + bv[bj][1]) * gt;
                    u32x4 w; w.x = cvt_pk_bf16(v0[0], v0[1]); w.y = cvt_pk_bf16(v0[2], v0[3]); w.z = cvt_pk_bf16(v1[0], v1[1]); w.w = cvt_pk_bf16(v1[2], v1[3]);
                    *(u32x4*)(rowp + bj * HALF) = w; } }
    }
};
template <int NCT> struct MoeRows {
    const int* elist; const PG8_LAS int* tstart; const PG8_LAS int* cnt; PG8_LAS int* tab;
    __device__ __forceinline__ void prefetch(const Unit& u, int slot, int wid, int lane) const {
        if (wid == 0) { const int e = u.pn / NCT, pos0 = (u.pm - tstart[e]) * BM;
            __builtin_amdgcn_global_load_lds((const unsigned*)(elist + (size_t)e * NTOK + pos0 + 4 * lane), (PG8_LAS unsigned*)(tab + slot * BM), 16, 0, 0); } }
    __device__ __forceinline__ unsigned off(const Unit& u, int slot, int row, int C, int K) const {
        const int e = u.pn / NCT, pos = (u.pm - tstart[e]) * BM + row; const int t = tab[slot * BM + row]; const int tok = (pos < cnt[e]) ? t : 0;
        return (unsigned)(tok * K + C) * 2u; }
};
template <int NCT> struct MoeOrder {
    const PG8_LAS int* tile_e; int nrt, G, vc;
    __device__ __forceinline__ bool next(int i, Unit& u) const {
        const int L = i * G + vc; const int rt = L / NCT, ct = L % NCT; if (rt >= nrt) return false;
        u.pm = rt; u.pn = __builtin_amdgcn_readfirstlane(tile_e[rt]) * NCT + ct; return true;
    }
    __device__ __forceinline__ void a_ready(const Unit&) const {}
    __device__ __forceinline__ void done(const Unit&) const {}
};
}
__device__ __forceinline__ int map_col(int id, int r) {
    switch (id) {
    default: return r;
    case 1: {
        if (r < 256) return r;
        if (r < 384) { const int q = r - 256; return 256 + (q & ~63) + rperm(q & 63); }
        if (r < 576) return r;
        if (r < 1088) return 584 + (r - 576);
        if (r < 1600) return 1096 + (r - 1088);
        if (r < 1608) return 576 + (r - 1600);
        return -1; }
    case 2: return (r & ~63) + rperm(r & 63);
    case 3: { const int t = r >> 8, w = r & 255; return w < 128 ? 128 * t + w : 1024 + 128 * t + (w - 128); }
    case 4: return 1024 + r;
    case 5: return r < 512 ? 1608 + r : (r < 640 ? 384 + (r - 512) : -1);
    }
}
__device__ __forceinline__ void tr_item(const float* W, int K, int Nsrc, bf16* WT, LAS float* scr, int kb, int nb, int lane, int mapid, float scale) {
    const int k0 = 64 * kb, n0 = 32 * nb;
    const int sc = map_col(mapid, n0 + (lane & 31));
#pragma unroll 8
    for (int i = 0; i < 32; ++i) { const int kk = 2 * i + (lane >> 5); scr[kk * 33 + (lane & 31)] = (sc >= 0) ? W[(size_t)(k0 + kk) * Nsrc + sc] * scale : 0.f; }
    LDS_WAIT(); asm volatile("" ::: "memory");
    const int c = lane & 7;
#pragma unroll
    for (int j = 0; j < 4; ++j) { const int n = (lane >> 3) + 8 * j; const LAS float* s = scr + (8 * c) * 33 + n;
        v4u o; o.x = pk2(s[0 * 33], s[1 * 33]); o.y = pk2(s[2 * 33], s[3 * 33]); o.z = pk2(s[4 * 33], s[5 * 33]); o.w = pk2(s[6 * 33], s[7 * 33]);
        *(v4u*)(WT + (size_t)(n0 + n) * K + k0 + 8 * c) = o; }
    LDS_WAIT(); asm volatile("" ::: "memory");
}
__device__ __forceinline__ void tr_item_v4(const float* W, int K, int Nsrc, bf16* WT, LAS float* scr, int kb, int nb, int lane, int mapid, float scale) {
    const int k0 = 64 * kb, n0 = 32 * nb, n4 = 4 * (lane & 7);
    const int sc = map_col(mapid, n0 + n4);
    f32x4 v[8];
#pragma unroll
    for (int i = 0; i < 8; ++i) v[i] = (sc >= 0) ? *(const f32x4*)(W + (size_t)(k0 + 8 * i + (lane >> 3)) * Nsrc + sc) : (f32x4){0.f, 0.f, 0.f, 0.f};
#pragma unroll
    for (int i = 0; i < 8; ++i) { LAS float* d = scr + (8 * i + (lane >> 3)) * 33 + n4; d[0] = v[i][0] * scale; d[1] = v[i][1] * scale; d[2] = v[i][2] * scale; d[3] = v[i][3] * scale; }
    LDS_WAIT(); asm volatile("" ::: "memory");
    const int c = lane & 7;
#pragma unroll
    for (int j = 0; j < 4; ++j) { const int n = (lane >> 3) + 8 * j; const LAS float* s = scr + (8 * c) * 33 + n;
        v4u o; o.x = pk2(s[0 * 33], s[1 * 33]); o.y = pk2(s[2 * 33], s[3 * 33]); o.z = pk2(s[4 * 33], s[5 * 33]); o.w = pk2(s[6 * 33], s[7 * 33]);
        *(v4u*)(WT + (size_t)(n0 + n) * K + k0 + 8 * c) = o; }
    LDS_WAIT(); asm volatile("" ::: "memory");
}
struct TrJob { const float* src; bf16* dst; int K, Nsrc, Ndst, batch, mapid; float scale; };
__device__ __forceinline__ TrJob tr_job(const Frame& F, int j) {
    TrJob t; t.batch = 1; t.mapid = 0; t.scale = 1.f; t.K = 1024; t.Nsrc = 1024; t.Ndst = 1024;
    switch (j) {
    case 0: t.src = inp(F, 2); t.dst = wsp<bf16>(F, WS_WTIN0); t.Nsrc = 2120; t.Ndst = EVW; t.mapid = 1; break;
    case 1: t.src = inp(F, 4); t.dst = wsp<bf16>(F, WS_WTQ); t.K = 256; t.Nsrc = 512; t.Ndst = 512; t.mapid = 2; t.scale = 0.125f; break;
    case 2: t.src = inp(F, 5); t.dst = wsp<bf16>(F, WS_WTQ) + 512 * 256; t.K = 256; t.Nsrc = 512; t.Ndst = 512; t.mapid = 2; t.scale = 0.125f; break;
    case 3: t.src = inp(F, 8); t.dst = wsp<bf16>(F, WS_WTOUT0); break;
    case 4: t.src = inp(F, 9); t.dst = wsp<bf16>(F, WS_WTS5IN); break;
    case 5: t.src = inp(F, 18); t.dst = wsp<bf16>(F, WS_WTS5OUT); t.Nsrc = 2048; t.Ndst = 2048; t.mapid = 3; break;
    case 6: t.src = inp(F, 21); t.dst = wsp<bf16>(F, WS_WTXQ); t.batch = 2; t.scale = 0.0625f; break;
    case 7: t.src = inp(F, 22); t.dst = wsp<bf16>(F, WS_WTXK); t.Nsrc = 2048; t.batch = 2; break;
    case 8: t.src = inp(F, 22); t.dst = wsp<bf16>(F, WS_WTXV); t.Nsrc = 2048; t.batch = 2; t.mapid = 4; break;
    case 9: t.src = inp(F, 23); t.dst = wsp<bf16>(F, WS_WTXO); t.batch = 2; break;
    case 10: t.src = inp(F, 28); t.dst = wsp<bf16>(F, WS_WTGU); t.Nsrc = 2048; t.Ndst = 2048; t.mapid = 3; t.batch = 64; break;
    case 11: t.src = inp(F, 30); t.dst = wsp<bf16>(F, WS_WTDN); t.batch = 64; break;
    default: t.src = inp(F, 2); t.dst = wsp<bf16>(F, WS_WTVB); t.Nsrc = 2120; t.Ndst = 768; t.mapid = 5; break;
    }
    return t;
}
__device__ __forceinline__ void p0_prologue(const Frame& F) {
    LAS float* scr = (LAS float*)(F.lds + F.wave * 16384);
    const int gw = F.vcu * NWAVES + F.wave, NGW = F.G * NWAVES;
    for (int j = 12; j >= 0; --j) {
        const TrJob t = tr_job(F, j);
        const int nkb = t.K / 64, nnb = t.Ndst / 32, per = nkb * nnb, total = per * t.batch;
        for (int it = gw; it < total; it += NGW) {
            const int bi = it / per, r = it - bi * per, kb = r / nnb, nb = r - kb * nnb;
            if (t.mapid == 1 || t.mapid == 2) tr_item(t.src + (size_t)bi * t.K * t.Nsrc, t.K, t.Nsrc, t.dst + (size_t)bi * t.Ndst * t.K, scr, kb, nb, F.lane, t.mapid, t.scale);
            else tr_item_v4(t.src + (size_t)bi * t.K * t.Nsrc, t.K, t.Nsrc, t.dst + (size_t)bi * t.Ndst * t.K, scr, kb, nb, F.lane, t.mapid, t.scale);
        }
    }
    const int gt = F.vcu * NTHR + F.tid, NGT = F.G * NTHR;
    { const float* x = inp(F, 0); bf16* xb = wsp<bf16>(F, WS_XB);
      for (int i = gt; i < NTOK * DM / 8; i += NGT) { const f32x4 a = *(const f32x4*)(x + (size_t)i * 8), b = *(const f32x4*)(x + (size_t)i * 8 + 4);
          v4u o; o.x = pk2(a[0], a[1]); o.y = pk2(a[2], a[3]); o.z = pk2(b[0], b[1]); o.w = pk2(b[2], b[3]); *(v4u*)(xb + (size_t)i * 8) = o; }
      const float* mm = inp(F, 1); bf16* mb = wsp<bf16>(F, WS_MEMB);
      for (int i = gt; i < NMEM * DM / 8; i += NGT) { const f32x4 a = *(const f32x4*)(mm + (size_t)i * 8), b = *(const f32x4*)(mm + (size_t)i * 8 + 4);
          v4u o; o.x = pk2(a[0], a[1]); o.y = pk2(a[2], a[3]); o.z = pk2(b[0], b[1]); o.w = pk2(b[2], b[3]); *(v4u*)(mb + (size_t)i * 8) = o; } }
    { f32x2* rope = wsp<f32x2>(F, WS_ROPE);
      for (int i = gt; i < SEQ * 8; i += NGT) { const int pos = i >> 3, k = i & 7; const float inv = (float)pow(500000.0, -(double)k / 8.0); const float ang = (float)pos * inv;
          rope[i] = (f32x2){(float)cos((double)ang), (float)sin((double)ang)}; } }
    { const float* log_dt = inp(F, 10); const float* lre = inp(F, 11); const float* lim = inp(F, 12); const float* bre = inp(F, 13); const float* bim = inp(F, 14);
      f32x2* apow = wsp<f32x2>(F, WS_APOW); f32x2* bb = wsp<f32x2>(F, WS_BB);
      for (int i = gt; i < 64 * 64 * 65; i += NGT) { const int gp = i / 65, k = i - gp * 65, g = gp >> 6;
          const double dt = exp((double)log_dt[g]), lr = lre[gp], li = lim[gp]; const double mag = exp(lr * dt * k), ang = li * dt * k;
          apow[i] = (f32x2){(float)(mag * cos(ang)), (float)(mag * sin(ang))}; }
      for (int i = gt; i < 64 * 64 * 16; i += NGT) { const int gp = i >> 4, g = gp >> 6;
          const double dt = exp((double)log_dt[g]), lr = lre[gp], li = lim[gp]; const double mag = exp(lr * dt), ar = mag * cos(li * dt), ai = mag * sin(li * dt);
          const double den = lr * lr + li * li, cr = ((ar - 1.0) * lr + ai * li) / den, ci = (ai * lr - (ar - 1.0) * li) / den; const double br = bre[i], bi = bim[i];
          bb[i] = (f32x2){(float)(cr * br - ci * bi), (float)(cr * bi + ci * br)}; } }
}

__device__ __forceinline__ void ln_row_store(const Frame& F, f32x4 (&v)[4], const float* g, const float* b, float* dstF, bf16* dstB) {
    float s = 0.f;
#pragma unroll
    for (int j = 0; j < 4; ++j) s += (v[j][0] + v[j][1]) + (v[j][2] + v[j][3]);
    const float mean = wave_sum(s, F.lane) * (1.f / DM); float s2 = 0.f;
#pragma unroll
    for (int j = 0; j < 4; ++j) { v[j] = v[j] - mean; s2 += (v[j][0] * v[j][0] + v[j][1] * v[j][1]) + (v[j][2] * v[j][2] + v[j][3] * v[j][3]); }
    const float rstd = 1.f / sqrtf(wave_sum(s2, F.lane) * (1.f / DM) + LN_EPS);
#pragma unroll
    for (int j = 0; j < 4; ++j) { const int c = 4 * F.lane + 256 * j; const f32x4 gg = *(const f32x4*)(g + c), bv = *(const f32x4*)(b + c);
        const f32x4 o = v[j] * rstd * gg + bv; *(f32x4*)(dstF + c) = o;
        v2u w; w.x = pk2(o[0], o[1]); w.y = pk2(o[2], o[3]); *(v2u*)(dstB + c) = w; }
}
__device__ __forceinline__ void ln_phase(const Frame& F, const float* T, const float* g, const float* b, float* dstF, bf16* dstB) {
    const int gw = F.vcu * NWAVES + F.wave, NGW = F.G * NWAVES;
    for (int m = gw; m < NTOK; m += NGW) { f32x4 v[4];
#pragma unroll
        for (int j = 0; j < 4; ++j) v[j] = *(const f32x4*)(T + (size_t)m * DM + 4 * F.lane + 256 * j);
        ln_row_store(F, v, g, b, dstF + (size_t)m * DM, dstB + (size_t)m * DM); }
}

__device__ __forceinline__ void p2_postproc(const Frame& F) {
    const int gw = F.vcu * NWAVES + F.wave, NGW = F.G * NWAVES, lane = F.lane;
    const bf16* P1 = wsp<bf16>(F, WS_P1); bf16* CQ = wsp<bf16>(F, WS_CQ); bf16* KI = wsp<bf16>(F, WS_KI); bf16* KA = wsp<bf16>(F, WS_KA); bf16* VA = wsp<bf16>(F, WS_VA);
    float* WI = wsp<float>(F, WS_WI); const f32x2* rope = wsp<f32x2>(F, WS_ROPE);
    const float* qg = inp(F, 3); const float* kg = inp(F, 6); const float* kb = inp(F, 7);
    const f32x4 qg4 = *(const f32x4*)(qg + 4 * lane); const float kgl = kg[lane], kbl = kb[lane];
    for (int tok = gw; tok < NTOK; tok += NGW) {
        const bf16* row = P1 + (size_t)tok * EVW; const int pos = tok & (SEQ - 1);
        { const v2u w = *(const v2u*)(row + C_CQ + 4 * lane); float v0 = bflo(w.x), v1 = bfhi(w.x), v2 = bflo(w.y), v3 = bfhi(w.y);
          const float ss = wave_sum(v0 * v0 + v1 * v1 + v2 * v2 + v3 * v3, lane); const float rs = 1.f / sqrtf(ss * (1.f / 256.f) + LN_EPS);
          v2u o; o.x = pk2(v0 * rs * qg4[0], v1 * rs * qg4[1]); o.y = pk2(v2 * rs * qg4[2], v3 * rs * qg4[3]); *(v2u*)(CQ + (size_t)tok * 256 + 4 * lane) = o; }
        { const float v = bf2f(row[C_KI + lane]); const float mean = wave_sum(v, lane) * (1.f / 64.f); const float d = v - mean; const float var = wave_sum(d * d, lane) * (1.f / 64.f);
          const float y = d * (1.f / sqrtf(var + LN_EPS)) * kgl + kbl; const float partner = shx(y, 8, lane);
          float o = y; int dst = lane;
          if (lane < 16) { const int i = lane & 7; const f32x2 cs = rope[pos * 8 + i];
              if (lane < 8) { o = y * cs.x - partner * cs.y; dst = 2 * lane; } else { o = y * cs.x + partner * cs.y; dst = 2 * (lane - 8) + 1; } }
          KI[(size_t)tok * 64 + dst] = (bf16)f2bf(o); }
        { const unsigned w = *(const unsigned*)(row + C_KA + 2 * lane); float t1 = bflo(w), t2 = bfhi(w); const int j = (2 * lane) & 63;
          if (j < 16) { const f32x2 cs = rope[pos * 8 + (j >> 1)]; const float a = t1 * cs.x - t2 * cs.y, b = t2 * cs.x + t1 * cs.y; t1 = a; t2 = b; }
          *(unsigned*)(KA + (size_t)tok * 128 + 2 * lane) = pk2(t1, t2);
          *(unsigned*)(VA + (size_t)tok * 128 + 2 * lane) = *(const unsigned*)(row + C_VA + 2 * lane); }
        if (lane < 8) WI[(size_t)tok * 8 + lane] = bf2f(row[C_WI + lane]) * 0.35355339059327373f;
    }
    const int gt = F.vcu * NTHR + F.tid, NGT = F.G * NTHR;
    const f32x2* apow = wsp<f32x2>(F, WS_APOW); const f32x2* bb = wsp<f32x2>(F, WS_BB);
    const float* cre = inp(F, 15); const float* cim = inp(F, 16);
    bf16* W1 = wsp<bf16>(F, WS_W1); bf16* W3 = wsp<bf16>(F, WS_W3); bf16* KT = wsp<bf16>(F, WS_KT);
    for (int i = gt; i < 64 * 128 * 1024 / 8; i += NGT) { const int e0 = i * 8, g = e0 >> 17, rem = e0 & 131071, rp = rem >> 10, k = rem & 1023, ri = rp >> 6, p = rp & 63, s = k >> 4, c0 = k & 15;
        const f32x2 a = apow[(g * 64 + p) * 65 + (63 - s)]; float o[8];
#pragma unroll
        for (int q = 0; q < 8; ++q) { const f32x2 b = bb[(g * 64 + p) * 16 + c0 + q]; o[q] = ri == 0 ? a.x * b.x - a.y * b.y : a.x * b.y + a.y * b.x; }
        v4u w; w.x = pk2(o[0], o[1]); w.y = pk2(o[2], o[3]); w.z = pk2(o[4], o[5]); w.w = pk2(o[6], o[7]); *(v4u*)(W1 + (size_t)e0) = w; }
    for (int i = gt; i < 64 * 1024 * 128 / 8; i += NGT) { const int e0 = i * 8, g = e0 >> 17, rem = e0 & 131071, tc = rem >> 7, k = rem & 127, t = tc >> 4, c = tc & 15, ri = k >> 6, p0 = k & 63; float o[8];
#pragma unroll
        for (int q = 0; q < 8; ++q) { const int p = p0 + q; const f32x2 a = apow[(g * 64 + p) * 65 + (t + 1)]; const float cr = cre[(g * 16 + c) * 64 + p], ci = cim[(g * 16 + c) * 64 + p];
            o[q] = ri == 0 ? cr * a.x - ci * a.y : -(cr * a.y + ci * a.x); }
        v4u w; w.x = pk2(o[0], o[1]); w.y = pk2(o[2], o[3]); w.z = pk2(o[4], o[5]); w.w = pk2(o[6], o[7]); *(v4u*)(W3 + (size_t)e0) = w; }
    for (int i = gt; i < 64 * 64 * 256; i += NGT) { const int g = i >> 14, tau = (i >> 8) & 63, c = (i >> 4) & 15, c2 = i & 15; float acc = 0.f;
        for (int p = 0; p < 64; ++p) { const f32x2 a = apow[(g * 64 + p) * 65 + tau]; const float cr = cre[(g * 16 + c) * 64 + p], ci = cim[(g * 16 + c) * 64 + p]; const f32x2 b = bb[(g * 64 + p) * 16 + c2];
            const float xr = cr * a.x - ci * a.y, xi = cr * a.y + ci * a.x; acc += xr * b.x - xi * b.y; }
        KT[i] = (bf16)f2bf(acc); }
}

__device__ __forceinline__ unsigned rope1(unsigned w, f32x2 cs) { const float t1 = bflo(w), t2 = bfhi(w); return pk2(t1 * cs.x - t2 * cs.y, t2 * cs.x + t1 * cs.y); }
__device__ __forceinline__ bf16x8 rope8(bf16x8 f, const f32x2* cs) { v4u w = __builtin_bit_cast(v4u, f); w.x = rope1(w.x, cs[0]); w.y = rope1(w.y, cs[1]); w.z = rope1(w.z, cs[2]); w.w = rope1(w.w, cs[3]); return __builtin_bit_cast(bf16x8, w); }
__device__ __forceinline__ unsigned f16key(float s) {
    const _Float16 h = (_Float16)s; unsigned u = (unsigned)__builtin_bit_cast(unsigned short, h);
    return (u & 0x8000u) ? (~u & 0xffffu) : (u | 0x8000u);
}
constexpr int UP_H1 = UP_OFF + 1024;
constexpr int UP_H2 = UP_H1 + 4096;
constexpr int UP_PAR = UP_H2 + 4096;
constexpr int UP_ML = UP_PAR + 256;
static_assert(UP_ML + 8 * 32 * 2 * 4 <= LDS_BYTES, "DSA LDS map");
__device__ __forceinline__ void pk_count(unsigned& acc, unsigned w, unsigned xm2, unsigned one2) {
    unsigned tmp; asm("v_pk_sub_u16 %1, %2, %3 clamp\n\tv_pk_min_u16 %1, %1, %4\n\tv_pk_add_u16 %0, %0, %1" : "+v"(acc), "=&v"(tmp) : "v"(w), "v"(xm2), "v"(one2)); }
__device__ __forceinline__ int wave_sum_dpp(int x, int lane) {
    x += __builtin_amdgcn_update_dpp(0, x, 0xB1, 0xF, 0xF, false);
    x += __builtin_amdgcn_update_dpp(0, x, 0x4E, 0xF, 0xF, false);
    x += __builtin_amdgcn_update_dpp(0, x, 0x124, 0xF, 0xF, false);
    x += __builtin_amdgcn_update_dpp(0, x, 0x128, 0xF, 0xF, false);
    x += shxi(x, 16, lane); x += shxi(x, 32, lane);
    return x;
}
__device__ __forceinline__ int count_ge_pk(const LAS bf16* row, int L, unsigned X, int lane) {
    const unsigned xm = (X - 1u) & 0xffffu, xm2 = xm | (xm << 16), one2 = 0x00010001u; unsigned a0 = 0u, a1 = 0u, a2 = 0u, a3 = 0u;
    const int nch = L >> 3; int c = lane;
    for (; c + 192 < nch; c += 256) {
        const v4u w0 = *(const LAS v4u*)(row + 8 * c), w1 = *(const LAS v4u*)(row + 8 * (c + 64)), w2 = *(const LAS v4u*)(row + 8 * (c + 128)), w3 = *(const LAS v4u*)(row + 8 * (c + 192));
        pk_count(a0, w0.x, xm2, one2); pk_count(a1, w0.y, xm2, one2); pk_count(a2, w0.z, xm2, one2); pk_count(a3, w0.w, xm2, one2);
        pk_count(a0, w1.x, xm2, one2); pk_count(a1, w1.y, xm2, one2); pk_count(a2, w1.z, xm2, one2); pk_count(a3, w1.w, xm2, one2);
        pk_count(a0, w2.x, xm2, one2); pk_count(a1, w2.y, xm2, one2); pk_count(a2, w2.z, xm2, one2); pk_count(a3, w2.w, xm2, one2);
        pk_count(a0, w3.x, xm2, one2); pk_count(a1, w3.y, xm2, one2); pk_count(a2, w3.z, xm2, one2); pk_count(a3, w3.w, xm2, one2); }
    for (; c < nch; c += 64) { const v4u w = *(const LAS v4u*)(row + 8 * c); pk_count(a0, w.x, xm2, one2); pk_count(a1, w.y, xm2, one2); pk_count(a2, w.z, xm2, one2); pk_count(a3, w.w, xm2, one2); }
    const unsigned acc = (a0 + a1) + (a2 + a3);
    return wave_sum_dpp((int)(acc & 0xffffu) + (int)(acc >> 16), lane);
}
__device__ __forceinline__ void dsa_unit(const Frame& F, int b, int qg) {
    const int lane = F.lane, wave = F.wave, m = lane & 31, hf = lane >> 5, tid = F.tid;
    const bf16* QAI = wsp<bf16>(F, WS_QAI); const bf16* KI = wsp<bf16>(F, WS_KI); const bf16* KA = wsp<bf16>(F, WS_KA); const bf16* VAT = wsp<bf16>(F, WS_VBT) + 512 * 32;
    const float* WI = wsp<float>(F, WS_WI); bf16* OAB = wsp<bf16>(F, WS_OAB); const f32x2* rope = wsp<f32x2>(F, WS_ROPE);
    LAS bf16* SC = (LAS bf16*)F.lds;
    LAS bf16* SEL = (LAS bf16*)(F.lds + UP_SEL);
    const bf16* VA = wsp<bf16>(F, WS_VA);
    LAS int* PAR = (LAS int*)(F.lds + UP_PAR); LAS float* ML = (LAS float*)(F.lds + UP_ML);
    const int t0 = qg * 8, nkeys = t0 + 8, ntile = (nkeys + 31) >> 5, L = ntile * 32;
    const size_t tb = (size_t)b * SEQ;
    {
        const int qq = 2 * ((m >> 2) & 1) + (m >> 4), head = (m & 3) + 4 * ((m >> 3) & 1);
        bf16x8 Af[2][4]; float wv[2][2][8];
#pragma unroll
        for (int mt = 0; mt < 2; ++mt) { const bf16* qp = QAI + (tb + t0 + 4 * mt + qq) * 1024 + 512 + head * 64 + 8 * hf;
#pragma unroll
            for (int kk = 0; kk < 4; ++kk) Af[mt][kk] = *(const bf16x8*)(qp + 16 * kk);
            Af[mt][0] = rope8(Af[mt][0], rope + (size_t)(t0 + 4 * mt + qq) * 8 + 4 * hf);
#pragma unroll
            for (int q2 = 0; q2 < 2; ++q2) { const float* wp = WI + (tb + t0 + 4 * mt + 2 * hf + q2) * 8; const f32x4 a = *(const f32x4*)wp, c = *(const f32x4*)(wp + 4);
                wv[mt][q2][0] = a[0]; wv[mt][q2][1] = a[1]; wv[mt][q2][2] = a[2]; wv[mt][q2][3] = a[3]; wv[mt][q2][4] = c[0]; wv[mt][q2][5] = c[1]; wv[mt][q2][6] = c[2]; wv[mt][q2][7] = c[3]; } }
#ifndef DSA_REP1
#define DSA_REP1 1
#define DSA_REP2 1
#define DSA_REP3 1
#endif
        for (int rep1 = 0; rep1 < DSA_REP1; ++rep1) {
        bf16x8 Bn[4];
        if (wave < ntile) { const bf16* kp = KI + (tb + 32 * wave + m) * 64 + 8 * hf;
#pragma unroll
            for (int kk = 0; kk < 4; ++kk) Bn[kk] = *(const bf16x8*)(kp + 16 * kk); }
        for (int tile = wave; tile < ntile; tile += NWAVES) {
            const int key = 32 * tile + m;
            bf16x8 Bf[4];
#pragma unroll
            for (int kk = 0; kk < 4; ++kk) Bf[kk] = Bn[kk];
            if (tile + NWAVES < ntile) { const bf16* kp = KI + (tb + 32 * (tile + NWAVES) + m) * 64 + 8 * hf;
#pragma unroll
                for (int kk = 0; kk < 4; ++kk) Bn[kk] = *(const bf16x8*)(kp + 16 * kk); }
#pragma unroll
            for (int mt = 0; mt < 2; ++mt) { f32x16 acc;
#pragma unroll
                for (int r = 0; r < 16; ++r) acc[r] = 0.f;
#pragma unroll
                for (int kk = 0; kk < 4; ++kk) acc = __builtin_amdgcn_mfma_f32_32x32x16_bf16(Af[mt][kk], Bf[kk], acc, 0, 0, 0);
#pragma unroll
                for (int q2 = 0; q2 < 2; ++q2) { float s = 0.f;
#pragma unroll
                    for (int h = 0; h < 8; ++h) s += wv[mt][q2][h] * fmaxf(acc[8 * q2 + h], 0.f);
                    const int ql = 4 * mt + 2 * hf + q2; const unsigned k16 = (key <= t0 + ql) ? f16key(s) : 0u;
                    SC[ql * SEQ + key] = (bf16)k16; } }
        }
        }
    }
    __syncthreads();
    const int ql = wave, t = t0 + ql, n = t + 1; int nsel;
    const LAS bf16* row = SC + ql * SEQ; LAS bf16* sel = SEL + ql * 256;
    if (n <= 256) { for (int i = lane; i < n; i += 64) sel[i] = (bf16)i; nsel = n; }
    else {
        int T = 0;
        for (int bit = 15; bit >= 0; --bit) { const int cand = T | (1 << bit); if (count_ge_pk(row, L, (unsigned)cand, lane) >= 256) T = cand; }
        const int cgt = count_ge_pk(row, L, (unsigned)T + 1u, lane), need = 256 - cgt;
        int bgt = 0, beq = 0; const unsigned long long lt = (1ull << lane) - 1ull;
        for (int i0 = 0; i0 < L; i0 += 64) { const int i = i0 + lane; const int k = (i < L) ? (int)row[i] : 0; const bool gt = k > T, eq = (k == T);
            const unsigned long long mg = __ballot(gt), me = __ballot(eq); const int pg = __popcll(mg & lt), pe = __popcll(me & lt);
            if (gt) sel[bgt + pg] = (bf16)i;
            if (eq && (beq + pe) < need) sel[cgt + beq + pe] = (bf16)i;
            bgt += __popcll(mg); beq += __popcll(me); }
        nsel = 256;
    }
    LDS_WAIT(); asm volatile("" ::: "memory");
    {
        LAS bf16* qs = (LAS bf16*)(F.lds + ql * (SEQ * 2));
        LAS float* P = (LAS float*)(F.lds + ql * (SEQ * 2) + 1024);
        { v4u w = *(const v4u*)(QAI + (tb + t) * 1024 + 8 * lane);
          if ((lane & 7) < 2) w = __builtin_bit_cast(v4u, rope8(__builtin_bit_cast(bf16x8, w), rope + (size_t)t * 8 + 4 * (lane & 7)));
          *(LAS v4u*)(qs + 8 * lane) = w; }
        LDS_WAIT(); asm volatile("" ::: "memory");
#pragma unroll 1
        for (int j = 0; j < 4; ++j) { const int slot = lane + 64 * j; const bool valid = slot < nsel; const int key = valid ? (int)sel[slot] : 0; const bf16* kp = KA + (tb + key) * 128; float lg[8];
#pragma unroll
            for (int g = 0; g < 2; ++g) { v4u kr[8];
#pragma unroll
                for (int c = 0; c < 8; ++c) kr[c] = *(const v4u*)(kp + 64 * g + 8 * c);
#pragma unroll
                for (int hh = 0; hh < 4; ++hh) { const int h = 4 * g + hh; float acc = 0.f;
#pragma unroll
                    for (int c = 0; c < 8; ++c) acc = dot8bf(kr[c], *(const LAS v4u*)(qs + h * 64 + 8 * c), acc);
                    lg[h] = valid ? acc : -INFINITY; }
                asm volatile("" ::: "memory"); }
            *(LAS f32x4*)(P + slot * 8) = (f32x4){lg[0], lg[1], lg[2], lg[3]}; *(LAS f32x4*)(P + slot * 8 + 4) = (f32x4){lg[4], lg[5], lg[6], lg[7]}; }
        LDS_WAIT(); asm volatile("" ::: "memory");
#pragma unroll
        for (int h = 0; h < 8; ++h) { float l4[4];
#pragma unroll
            for (int j = 0; j < 4; ++j) l4[j] = P[(lane + 64 * j) * 8 + h];
            const float mx = wave_max(fmaxf(fmaxf(l4[0], l4[1]), fmaxf(l4[2], l4[3])), lane); float s = 0.f;
#pragma unroll
            for (int j = 0; j < 4; ++j) { l4[j] = __expf(l4[j] - mx); s += l4[j]; }
            const float inv = 1.f / wave_sum(s, lane);
#pragma unroll
            for (int j = 0; j < 4; ++j) P[(lane + 64 * j) * 8 + h] = l4[j] * inv; }
        LDS_WAIT(); asm volatile("" ::: "memory");
        const int qd = lane >> 4, c16 = lane & 15, g = c16 >> 3; float o[4][8];
#pragma unroll
        for (int hh = 0; hh < 4; ++hh)
#pragma unroll
            for (int dd = 0; dd < 8; ++dd) o[hh][dd] = 0.f;
        const int nit = (nsel + 3) >> 2;
#pragma unroll 8
        for (int i = 0; i < nit; ++i) { const int slot = 4 * i + qd; const int key = (slot < nsel) ? (int)sel[slot] : 0; const v4u vv = *(const v4u*)(VA + (tb + key) * 128 + 8 * c16); const f32x4 p4 = *(const LAS f32x4*)(P + slot * 8 + 4 * g);
            const float v0 = bflo(vv.x), v1 = bfhi(vv.x), v2 = bflo(vv.y), v3 = bfhi(vv.y), v4 = bflo(vv.z), v5 = bfhi(vv.z), v6 = bflo(vv.w), v7 = bfhi(vv.w);
#pragma unroll
            for (int hh = 0; hh < 4; ++hh) { const float p = (slot < nsel) ? p4[hh] : 0.f; o[hh][0] += p * v0; o[hh][1] += p * v1; o[hh][2] += p * v2; o[hh][3] += p * v3; o[hh][4] += p * v4; o[hh][5] += p * v5; o[hh][6] += p * v6; o[hh][7] += p * v7; } }
#pragma unroll
        for (int hh = 0; hh < 4; ++hh)
#pragma unroll
            for (int dd = 0; dd < 8; ++dd) { float x = o[hh][dd]; x += shx(x, 16, lane); x += shx(x, 32, lane); o[hh][dd] = x; }
        if (qd == 0) {
#pragma unroll
            for (int hh = 0; hh < 4; ++hh) { v4u w; w.x = pk2(o[hh][0], o[hh][1]); w.y = pk2(o[hh][2], o[hh][3]); w.z = pk2(o[hh][4], o[hh][5]); w.w = pk2(o[hh][6], o[hh][7]);
                *(v4u*)(OAB + (tb + t) * 1024 + (4 * g + hh) * 64 + ((8 * c16) & 63)) = w; } }
    }
    __syncthreads();
}
__device__ __forceinline__ void dsa_phase(const Frame& F) {
    if (F.G == 256) { const int c = F.vcu, b = (c >> 5) & 3, j = (c & 31) + 32 * (c >> 7);
        for (int i = 0; i < 16; ++i) dsa_unit(F, b, 64 * i + ((i & 1) ? 63 - j : j)); }
    else { for (int u = F.vcu; u < NB * (SEQ / 8); u += F.G) dsa_unit(F, u & 3, u >> 2); }
}
__device__ __forceinline__ void sb_phase(const Frame& F) {
    const int gw = F.wave * F.G + F.vcu, NGW = F.G * NWAVES, lane = F.lane, m = lane & 31, hf = lane >> 5;
    const bf16* P1 = wsp<bf16>(F, WS_P1); const bf16* VBT = wsp<bf16>(F, WS_VBT); bf16* OAB = wsp<bf16>(F, WS_OAB);
    for (int task = gw; task < NB * 8 * (SEQ / 32); task += NGW) {
        const int qt = task & 255, h = (task >> 8) & 7, b = task >> 11, t0 = qt * 32, t = t0 + m; const size_t tb = (size_t)b * SEQ;
        bf16x8 qf[4], kf[4];
        { const bf16* qp = P1 + (tb + t0 + m) * EVW + C_QB + h * 64 + 8 * hf; const bf16* kp = P1 + (tb + t0 + m) * EVW + C_KB + h * 64 + 8 * hf;
#pragma unroll
          for (int kk = 0; kk < 4; ++kk) { qf[kk] = *(const bf16x8*)(qp + 16 * kk); kf[kk] = *(const bf16x8*)(kp + 16 * kk); } }
        f32x16 O[2];
#pragma unroll
        for (int r = 0; r < 16; ++r) { O[0][r] = 0.f; O[1][r] = 0.f; }
        float carry = 1.f;
#pragma unroll 1
        for (int kt = qt; kt >= 0; --kt) {
            f32x16 S;
#pragma unroll
            for (int r = 0; r < 16; ++r) S[r] = 0.f;
#pragma unroll
            for (int kk = 0; kk < 4; ++kk) S = __builtin_amdgcn_mfma_f32_32x32x16_bf16(kf[kk], qf[kk], S, 0, 0, 0);
            if (kt > 0) { const bf16* kp = P1 + (tb + 32 * (kt - 1) + m) * EVW + C_KB + h * 64 + 8 * hf;
#pragma unroll
                for (int kk = 0; kk < 4; ++kk) kf[kk] = *(const bf16x8*)(kp + 16 * kk); }
            v2u vlo[2][2], vhi[2][2];
#pragma unroll
            for (int dt = 0; dt < 2; ++dt) { const bf16* vp = VBT + ((size_t)(b * (SEQ / 32) + kt) * 768 + h * 64 + 32 * dt + m) * 32 + 4 * hf;
#pragma unroll
                for (int s = 0; s < 2; ++s) { vlo[dt][s] = *(const v2u*)(vp + 16 * s); vhi[dt][s] = *(const v2u*)(vp + 16 * s + 8); } }
            float rr[16], be[16];
#pragma unroll
            for (int r = 0; r < 16; ++r) { const int key = 32 * kt + crow(r, hf); const bool valid = key < t; const float z = S[r] * 0.125f;
                const float ez = __expf(fminf(z, 80.f)), rv = __builtin_amdgcn_rcpf(1.f + ez); rr[r] = valid ? rv : 1.f; be[r] = valid ? ez * rv : 0.f; }
            float g[4], og[4], T[5];
#pragma unroll
            for (int q = 0; q < 4; ++q) { g[q] = (rr[4 * q] * rr[4 * q + 1]) * (rr[4 * q + 2] * rr[4 * q + 3]); og[q] = shx(g[q], 32, lane); }
            T[4] = 1.f;
#pragma unroll
            for (int q = 3; q >= 0; --q) T[q] = g[q] * og[q] * T[q + 1];
#pragma unroll
            for (int q = 0; q < 4; ++q) { float aft = (hf == 0 ? og[q] : 1.f) * T[q + 1] * carry;
                S[4 * q + 3] = be[4 * q + 3] * aft; aft *= rr[4 * q + 3]; S[4 * q + 2] = be[4 * q + 2] * aft; aft *= rr[4 * q + 2];
                S[4 * q + 1] = be[4 * q + 1] * aft; aft *= rr[4 * q + 1]; S[4 * q] = be[4 * q] * aft; }
            carry *= T[0];
            bf16x8 pf[2];
#pragma unroll
            for (int s = 0; s < 2; ++s) { v4u w; w.x = pk2(S[8 * s + 0], S[8 * s + 1]); w.y = pk2(S[8 * s + 2], S[8 * s + 3]); w.z = pk2(S[8 * s + 4], S[8 * s + 5]); w.w = pk2(S[8 * s + 6], S[8 * s + 7]); pf[s] = __builtin_bit_cast(bf16x8, w); }
#pragma unroll
            for (int dt = 0; dt < 2; ++dt)
#pragma unroll
                for (int s = 0; s < 2; ++s) { v4u a; a.x = vlo[dt][s].x; a.y = vlo[dt][s].y; a.z = vhi[dt][s].x; a.w = vhi[dt][s].y;
                    O[dt] = __builtin_amdgcn_mfma_f32_32x32x16_bf16(__builtin_bit_cast(bf16x8, a), pf[s], O[dt], 0, 0, 0); }
            if (__all(carry < 1e-30f)) break;
        }
        bf16* op = OAB + (tb + t) * 1024 + 512 + h * 64 + 4 * hf;
#pragma unroll
        for (int dt = 0; dt < 2; ++dt)
#pragma unroll
            for (int rg = 0; rg < 4; ++rg) { v2u w; w.x = pk2(O[dt][4 * rg], O[dt][4 * rg + 1]); w.y = pk2(O[dt][4 * rg + 2], O[dt][4 * rg + 3]); *(v2u*)(op + 32 * dt + 8 * rg) = w; }
    }
}
__device__ __forceinline__ void xattn_phase(const Frame& F, int layer) {
    const int lane = F.lane, wave = F.wave, m = lane & 31, hf = lane >> 5, tid = F.tid;
    const bf16* QX = wsp<bf16>(F, WS_QX); const bf16* KX = wsp<bf16>(F, WS_KX) + layer * 1024; const bf16* VXT = wsp<bf16>(F, WS_VXT) + (size_t)layer * 1024 * 1024; bf16* AX = wsp<bf16>(F, WS_AX);
    constexpr int KP = 528, VP = 520;
    for (int task = F.vcu; task < NB * 4 * (SEQ / 256); task += F.G) {
        const int h = task & 3, qb = task >> 2, q0 = qb * 256 + wave * 32, b = (qb * 256) / SEQ;
        bf16x8 qf[16];
        { const bf16* qp = QX + (size_t)(q0 + m) * 1024 + h * 256 + 8 * hf;
#pragma unroll
          for (int kk = 0; kk < 16; ++kk) qf[kk] = *(const bf16x8*)(qp + 16 * kk); }
        float mx = -INFINITY, sum = 0.f;
        bf16x8 pf[8][2];
#pragma unroll
        for (int pass = 0; pass < 2; ++pass) {
            if (pass == 1) mx = fmaxf(mx, shx(mx, 32, lane));
#pragma unroll
            for (int kh = 0; kh < 2; ++kh) {
                __syncthreads();
#pragma unroll 2
                for (int i = 0; i < 8; ++i) { const int pc = i * NTHR + tid, row = pc >> 5, ch = pc & 31;
                    const v4u v = *(const v4u*)(KX + (size_t)(b * MEML + 128 * kh + row) * 2048 + h * 256 + 8 * ch);
                    *(LAS v4u*)(F.lds + row * KP + ch * 16) = v; }
                LDS_WAIT(); __syncthreads();
#pragma unroll
                for (int k4 = 0; k4 < 4; ++k4) { const int kt = 4 * kh + k4; f32x16 S;
#pragma unroll
                    for (int r = 0; r < 16; ++r) S[r] = 0.f;
                    const LAS unsigned char* kp = F.lds + (32 * k4 + m) * KP + 16 * hf;
#pragma unroll
                    for (int kk = 0; kk < 16; ++kk) { const bf16x8 kf = *(const LAS bf16x8*)(kp + 32 * kk); S = __builtin_amdgcn_mfma_f32_32x32x16_bf16(kf, qf[kk], S, 0, 0, 0); }
                    if (pass == 0) {
#pragma unroll
                        for (int r = 0; r < 16; ++r) mx = fmaxf(mx, S[r]);
                    } else {
#pragma unroll
                        for (int r = 0; r < 16; ++r) { S[r] = __expf(S[r] - mx); sum += S[r]; }
#pragma unroll
                        for (int s = 0; s < 2; ++s) { v4u w; w.x = pk2(S[8 * s + 0], S[8 * s + 1]); w.y = pk2(S[8 * s + 2], S[8 * s + 3]); w.z = pk2(S[8 * s + 4], S[8 * s + 5]); w.w = pk2(S[8 * s + 6], S[8 * s + 7]);
                            pf[kt][s] = __builtin_bit_cast(bf16x8, w); }
                    }
                }
            }
        }
        sum += shx(sum, 32, lane);
        const float inv = 1.f / sum;
#pragma unroll
        for (int half = 0; half < 2; ++half) {
            __syncthreads();
#pragma unroll 2
            for (int i = 0; i < 8; ++i) { const int pc = i * NTHR + tid, row = pc >> 5, c16 = pc & 31;
                const v4u v = *(const v4u*)(VXT + (size_t)(h * 256 + 128 * half + row) * 1024 + b * MEML + 8 * c16);
                LAS unsigned char* rp = F.lds + row * VP + c16 * 16; *(LAS v2u*)rp = (v2u){v.x, v.y}; *(LAS v2u*)(rp + 8) = (v2u){v.z, v.w}; }
            LDS_WAIT(); __syncthreads();
            f32x16 O[4];
#pragma unroll
            for (int d4 = 0; d4 < 4; ++d4) {
#pragma unroll
                for (int r = 0; r < 16; ++r) O[d4][r] = 0.f;
                const LAS unsigned char* vp = F.lds + (32 * d4 + m) * VP + 8 * hf;
#pragma unroll
                for (int kt = 0; kt < 8; ++kt)
#pragma unroll
                    for (int s = 0; s < 2; ++s) { const v2u lo = *(const LAS v2u*)(vp + 64 * kt + 32 * s), hi = *(const LAS v2u*)(vp + 64 * kt + 32 * s + 16);
                        v4u a; a.x = lo.x; a.y = lo.y; a.z = hi.x; a.w = hi.y;
                        O[d4] = __builtin_amdgcn_mfma_f32_32x32x16_bf16(__builtin_bit_cast(bf16x8, a), pf[kt][s], O[d4], 0, 0, 0);
                        if (s == 1 && (kt & 1)) asm volatile("" ::: "memory"); }
            }
            bf16* op = AX + (size_t)(q0 + m) * 1024 + h * 256 + 4 * hf;
#pragma unroll
            for (int d4 = 0; d4 < 4; ++d4)
#pragma unroll
                for (int rg = 0; rg < 4; ++rg) { v2u w; w.x = pk2(O[d4][4 * rg] * inv, O[d4][4 * rg + 1] * inv); w.y = pk2(O[d4][4 * rg + 2] * inv, O[d4][4 * rg + 3] * inv);
                    *(v2u*)(op + 32 * (4 * half + d4) + 8 * rg) = w; }
        }
    }
}

__device__ __forceinline__ void router_phase(const Frame& F, int layer) {
    const int gw = F.wave * F.G + F.vcu, NGW = F.G * NWAVES, lane = F.lane, m = lane & 31, hf = lane >> 5;
    const float* HF = wsp<float>(F, WS_HF); const float* Wr = inp(F, 26) + (size_t)layer * DM * NEXP; const float* br = inp(F, 27) + layer * NEXP;
    unsigned* cnt = wsp<unsigned>(F, WS_CTL) + CW_CNT + layer * 32 * 64;
    int* elist = wsp<int>(F, WS_ELIST); float* egate = wsp<float>(F, WS_EGATE); int* toke = wsp<int>(F, WS_TOKE); int* tokp = wsp<int>(F, WS_TOKP);
    LAS float* scr = (LAS float*)(F.lds + F.wave * 8192);
    for (int tile = gw; tile < NTOK / 32; tile += NGW) {
        const int tok0 = tile * 32;
        f32x16 acc;
#pragma unroll
        for (int r = 0; r < 16; ++r) acc[r] = 0.f;
        const float* ap = HF + (size_t)(tok0 + m) * DM + 4 * hf; const float* bp = Wr + (size_t)(4 * hf) * NEXP + m;
#pragma unroll 4
        for (int j = 0; j < 128; ++j) { const f32x4 a = *(const f32x4*)(ap + 8 * j);
#pragma unroll
            for (int s = 0; s < 4; ++s) acc = __builtin_amdgcn_mfma_f32_32x32x2f32(a[s], bp[(size_t)(8 * j + s) * NEXP], acc, 0, 0, 0); }
#pragma unroll
        for (int r = 0; r < 16; ++r) scr[crow(r, hf) * 33 + m] = acc[r];
        LDS_WAIT(); asm volatile("" ::: "memory");
        int e4[4]; float g4[4];
        { float lg[32];
#pragma unroll
          for (int e = 0; e < 32; ++e) lg[e] = scr[m * 33 + e] + br[e];
          unsigned taken = 0u; float v4[4];
#pragma unroll
          for (int k = 0; k < 4; ++k) { float best = -INFINITY; int bi = 0;
#pragma unroll
              for (int e = 0; e < 32; ++e) { const bool ok = !((taken >> e) & 1u) && (lg[e] > best); best = ok ? lg[e] : best; bi = ok ? e : bi; }
              taken |= 1u << bi; e4[k] = bi; v4[k] = best; }
          float s = 0.f;
#pragma unroll
          for (int k = 0; k < 4; ++k) { g4[k] = __expf(v4[k] - v4[0]); s += g4[k]; }
          const float inv = 1.f / s;
#pragma unroll
          for (int k = 0; k < 4; ++k) g4[k] *= inv; }
        LDS_WAIT(); asm volatile("" ::: "memory");
        int pos4[4];
        const bool act = lane < 32;
        for (int e = 0; e < 32; ++e) {
            unsigned long long mk[4]; int tot = 0;
#pragma unroll
            for (int k = 0; k < 4; ++k) { mk[k] = __ballot(act && e4[k] == e); tot += __popcll(mk[k]); }
            if (tot == 0) continue;
            unsigned base = 0u;
            if (lane == 0) base = __hip_atomic_fetch_add(cnt + e * 64, (unsigned)tot, __ATOMIC_RELAXED, __HIP_MEMORY_SCOPE_AGENT);
            base = (unsigned)__builtin_amdgcn_readfirstlane((int)base);
            const unsigned long long lt = (1ull << lane) - 1ull; int off = 0;
#pragma unroll
            for (int k = 0; k < 4; ++k) { if (act && e4[k] == e) pos4[k] = (int)base + off + __popcll(mk[k] & lt); off += __popcll(mk[k]); }
        }
        if (act) { const int tok = tok0 + lane;
#pragma unroll
            for (int k = 0; k < 4; ++k) { elist[(size_t)e4[k] * NTOK + pos4[k]] = tok; egate[(size_t)e4[k] * NTOK + pos4[k]] = g4[k]; }
            *(int4*)(toke + (size_t)tok * 4) = make_int4(e4[0], e4[1], e4[2], e4[3]); *(int4*)(tokp + (size_t)tok * 4) = make_int4(pos4[0], pos4[1], pos4[2], pos4[3]); }
    }
}
__device__ __forceinline__ void moe_tables(const Frame& F, int layer) {
    LAS int* tile_e = (LAS int*)(F.lds + UP_TILEE); LAS int* tstart = (LAS int*)(F.lds + UP_TSTART); LAS int* cntl = (LAS int*)(F.lds + UP_CNT);
    unsigned* cnt = wsp<unsigned>(F, WS_CTL) + CW_CNT + layer * 32 * 64;
    __syncthreads();
    if (F.tid < 32) cntl[F.tid] = (int)__hip_atomic_load(cnt + F.tid * 64, __ATOMIC_RELAXED, __HIP_MEMORY_SCOPE_AGENT);
    __syncthreads();
    if (F.tid == 0) { int s = 0; for (int e = 0; e < 32; ++e) { tstart[e] = s; s += (cntl[e] + 255) >> 8; } tstart[32] = s; }
    __syncthreads();
    for (int e = 0; e < 32; ++e) { const int a = tstart[e], b = tstart[e + 1]; for (int rt = a + F.tid; rt < b; rt += NTHR) tile_e[rt] = e; }
    __syncthreads();
}
__device__ __forceinline__ void gather_phase(const Frame& F, int layer) {
    moe_tables(F, layer);
    const LAS int* tile_e = (const LAS int*)(F.lds + UP_TILEE); const LAS int* tstart = (const LAS int*)(F.lds + UP_TSTART); const LAS int* cntl = (const LAS int*)(F.lds + UP_CNT);
    const int gw = F.vcu * NWAVES + F.wave, NGW = F.G * NWAVES, lane = F.lane; const int nrows = tstart[32] * 256;
    const int* elist = wsp<int>(F, WS_ELIST); const float* egate = wsp<float>(F, WS_EGATE); float* rgate = wsp<float>(F, WS_RGATE);
    const bf16* XB = wsp<bf16>(F, WS_XB); bf16* XG = wsp<bf16>(F, WS_XG);
    for (int row = gw; row < nrows; row += NGW) {
        const int rt = row >> 8, e = tile_e[rt], pos = (rt - tstart[e]) * 256 + (row & 255); const bool valid = pos < cntl[e];
        v4u a = (v4u){0u, 0u, 0u, 0u}, b = a; float gt = 0.f;
        if (valid) { const int tok = elist[(size_t)e * NTOK + pos]; gt = egate[(size_t)e * NTOK + pos]; const bf16* src = XB + (size_t)tok * DM + 16 * lane; a = *(const v4u*)src; b = *(const v4u*)(src + 8); }
        bf16* dst = XG + (size_t)row * DM + 16 * lane; *(v4u*)dst = a; *(v4u*)(dst + 8) = b;
        if (lane == 0) rgate[row] = gt;
    }
}
__device__ __forceinline__ void combine_phase(const Frame& F, int layer, float* dstF) {
    moe_tables(F, layer);
    const LAS int* tstart = (const LAS int*)(F.lds + UP_TSTART);
    const int gw = F.vcu * NWAVES + F.wave, NGW = F.G * NWAVES, lane = F.lane;
    const int* toke = wsp<int>(F, WS_TOKE); const int* tokp = wsp<int>(F, WS_TOKP); const bf16* Y = wsp<bf16>(F, WS_XG); const float* HF = wsp<float>(F, WS_HF); bf16* XB = wsp<bf16>(F, WS_XB);
    const float* g = inp(F, 32) + layer * DM; const float* b = inp(F, 33) + layer * DM;
    for (int tok = gw; tok < NTOK; tok += NGW) {
        const int4 e4 = *(const int4*)(toke + (size_t)tok * 4), p4 = *(const int4*)(tokp + (size_t)tok * 4);
        const int r0 = tstart[e4.x] * 256 + p4.x, r1 = tstart[e4.y] * 256 + p4.y, r2 = tstart[e4.z] * 256 + p4.z, r3 = tstart[e4.w] * 256 + p4.w;
        f32x4 v[4];
#pragma unroll
        for (int j = 0; j < 4; ++j) { const int c = 4 * lane + 256 * j; v[j] = *(const f32x4*)(HF + (size_t)tok * DM + c) * DN_ALPHA;
            const v2u y0 = *(const v2u*)(Y + (size_t)r0 * DM + c), y1 = *(const v2u*)(Y + (size_t)r1 * DM + c), y2 = *(const v2u*)(Y + (size_t)r2 * DM + c), y3 = *(const v2u*)(Y + (size_t)r3 * DM + c);
            v[j][0] += ((bflo(y0.x) + bflo(y1.x)) + bflo(y2.x)) + bflo(y3.x); v[j][1] += ((bfhi(y0.x) + bfhi(y1.x)) + bfhi(y2.x)) + bfhi(y3.x);
            v[j][2] += ((bflo(y0.y) + bflo(y1.y)) + bflo(y2.y)) + bflo(y3.y); v[j][3] += ((bfhi(y0.y) + bfhi(y1.y)) + bfhi(y2.y)) + bfhi(y3.y); }
        ln_row_store(F, v, g, b, dstF + (size_t)tok * DM, XB + (size_t)tok * DM);
    }
}

constexpr int S5_APITCH = 2064, S5_HPITCH = 272, S5_AOFF = 0, S5_HOFF = 32 * S5_APITCH  , S5_ROFF = 81920  ;
__device__ __forceinline__ void s5_stage_u(const Frame& F, int g, int mt) {
    const bf16* U = wsp<bf16>(F, WS_U); const int b = mt >> 2, ch0 = (mt & 3) * 32;
    for (int pc = F.tid; pc < 32 * 64; pc += NTHR) { const int i = pc >> 6, s = pc & 63; const bf16* src = U + ((size_t)b * SEQ + (size_t)(ch0 + i) * SCH + s) * DM + 16 * g;
        const v4u a = *(const v4u*)src, c = *(const v4u*)(src + 8); LAS unsigned char* d = F.lds + S5_AOFF + i * S5_APITCH + s * 32; *(LAS v4u*)d = a; *(LAS v4u*)(d + 16) = c; }
}
__device__ __forceinline__ void s5_local_phase(const Frame& F) {
    const int lane = F.lane, wave = F.wave, m = lane & 31, hf = lane >> 5;
    const bf16* W1 = wsp<bf16>(F, WS_W1); float* ELOC = wsp<float>(F, WS_ELOC);
    for (int unit = F.vcu; unit < 64 * 16; unit += F.G) {
        const int g = unit & 63, mt = unit >> 6, b = mt >> 2, ch0 = (mt & 3) * 32;
        __syncthreads();
        s5_stage_u(F, g, mt);
        LDS_WAIT(); __syncthreads();
        const int nt = wave & 3, kh = wave >> 2;
        f32x16 acc;
#pragma unroll
        for (int r = 0; r < 16; ++r) acc[r] = 0.f;
        const bf16* wp = W1 + ((size_t)g * 128 + 32 * nt + m) * 1024 + 8 * hf; const LAS unsigned char* ap = F.lds + S5_AOFF + m * S5_APITCH + 16 * hf;
#pragma unroll 8
        for (int kk = 32 * kh; kk < 32 * kh + 32; ++kk) { const bf16x8 af = *(const LAS bf16x8*)(ap + 32 * kk); const bf16x8 bf = *(const bf16x8*)(wp + 16 * kk);
            acc = __builtin_amdgcn_mfma_f32_32x32x16_bf16(af, bf, acc, 0, 0, 0); }
        LAS float* red = (LAS float*)(F.lds + S5_ROFF) + (nt * 64 + lane) * 16;
        if (kh == 1) {
#pragma unroll
            for (int r = 0; r < 16; r += 4) *(LAS f32x4*)(red + r) = (f32x4){acc[r], acc[r + 1], acc[r + 2], acc[r + 3]}; }
        LDS_WAIT(); __syncthreads();
        if (kh == 0) {
#pragma unroll
            for (int r = 0; r < 16; ++r) { const int i = crow(r, hf); ELOC[(((size_t)b * 64 + g) * NCHUNK + ch0 + i) * 128 + 32 * nt + m] = acc[r] + red[r]; } }
    }
}
__device__ __forceinline__ void s5_scan_phase(const Frame& F) {
    if (F.wave != 0) return;
    const f32x2* apow = wsp<f32x2>(F, WS_APOW); const float* ELOC = wsp<float>(F, WS_ELOC); bf16* HS = wsp<bf16>(F, WS_HS);
    for (int idx = F.vcu * 64 + F.lane; idx < NB * 64 * 64; idx += F.G * 64) {
        const int p = idx & 63, g = (idx >> 6) & 63, b = idx >> 12; const f32x2 a = apow[(g * 64 + p) * 65 + 64];
        const size_t base = ((size_t)b * 64 + g) * NCHUNK * 128; float hr = 0.f, hi = 0.f;
#pragma unroll 8
        for (int k = 0; k < NCHUNK; ++k) { HS[base + (size_t)k * 128 + p] = (bf16)f2bf(hr); HS[base + (size_t)k * 128 + 64 + p] = (bf16)f2bf(hi);
            const float er = ELOC[base + (size_t)k * 128 + p], ei = ELOC[base + (size_t)k * 128 + 64 + p];
            const float nr = a.x * hr - a.y * hi + er, ni = a.x * hi + a.y * hr + ei; hr = nr; hi = ni; }
    }
}
__device__ __forceinline__ void s5_out_phase(const Frame& F) {
    const int lane = F.lane, wave = F.wave, m = lane & 31, hf = lane >> 5;
    const bf16* KT = wsp<bf16>(F, WS_KT); const bf16* W3 = wsp<bf16>(F, WS_W3); const bf16* HS = wsp<bf16>(F, WS_HS); const bf16* U = wsp<bf16>(F, WS_U); bf16* YG = wsp<bf16>(F, WS_YG);
    const float* dvec = inp(F, 17);
    for (int unit = F.vcu; unit < 64 * 16; unit += F.G) {
        const int g = unit & 63, mt = unit >> 6, b = mt >> 2, ch0 = (mt & 3) * 32;
        __syncthreads();
        s5_stage_u(F, g, mt);
        for (int pc = F.tid; pc < 32 * 16; pc += NTHR) { const int i = pc >> 4, q = pc & 15;
            *(LAS v4u*)(F.lds + S5_HOFF + i * S5_HPITCH + q * 16) = *(const v4u*)(HS + (((size_t)b * 64 + g) * NCHUNK + ch0 + i) * 128 + 8 * q); }
        LDS_WAIT(); __syncthreads();
        const int tl = m >> 4, c = m & 15; const float dv = dvec[16 * g + c];
        const LAS unsigned char* ap = F.lds + S5_AOFF + m * S5_APITCH + 16 * hf; const LAS unsigned char* hp = F.lds + S5_HOFF + m * S5_HPITCH + 16 * hf;
#pragma unroll 1
        for (int q = 0; q < 4; ++q) {
            const int j = (q == 0) ? wave : (q == 1) ? 15 - wave : (q == 2) ? 16 + wave : 31 - wave; const int t = 2 * j + tl;
            f32x16 acc;
#pragma unroll
            for (int r = 0; r < 16; ++r) acc[r] = 0.f;
            const bf16* kt = KT + ((size_t)g * 64 * 16 + c) * 16 + 8 * hf;
#pragma unroll 2
            for (int s = 0; s <= 2 * j + 1; ++s) { const int tau = t - s; bf16x8 bf = (bf16x8){0, 0, 0, 0, 0, 0, 0, 0}; if (tau >= 0) bf = *(const bf16x8*)(kt + tau * 256);
                const bf16x8 af = *(const LAS bf16x8*)(ap + 32 * s); acc = __builtin_amdgcn_mfma_f32_32x32x16_bf16(af, bf, acc, 0, 0, 0); }
            const bf16* w3 = W3 + ((size_t)g * 1024 + 16 * t + c) * 128 + 8 * hf;
#pragma unroll
            for (int kk = 0; kk < 8; ++kk) { const bf16x8 af = *(const LAS bf16x8*)(hp + 32 * kk); const bf16x8 bf = *(const bf16x8*)(w3 + 16 * kk); acc = __builtin_amdgcn_mfma_f32_32x32x16_bf16(af, bf, acc, 0, 0, 0); }
#pragma unroll
            for (int r = 0; r < 16; ++r) { const int i = crow(r, hf); const size_t off = ((size_t)b * SEQ + (size_t)(ch0 + i) * SCH + t) * DM + 16 * g + c;
                const float y = acc[r] + dv * bf2f(U[off]); const float x = 0.7978845608028654f * (y + 0.044715f * y * y * y); const float th = 1.f - 2.f / (1.f + __expf(2.f * x));
                YG[off] = (bf16)f2bf(0.5f * y * (1.f + th)); }
        }
    }
}
#ifndef MK_PER_PHASE
#define MK_PER_PHASE 0
#endif
constexpr int NPH = 31;
__device__ __forceinline__ bool in_ph(int k, int lo, int hi) { asm volatile("" : "+s"(lo), "+s"(hi)); return lo <= k && k < hi; }
struct Args { const float* in[34]; float* out; unsigned char* ws; int ph_lo, ph_hi; };
__global__ void __launch_bounds__(NTHR, 2) fwd_kernel(Args args) {
    extern __shared__ __attribute__((aligned(16))) unsigned char lds_raw[];
    Frame F;
    F.lds = (LAS unsigned char*)lds_raw;
    F.tid = threadIdx.x; F.lane = F.tid & 63; F.wave = __builtin_amdgcn_readfirstlane(F.tid >> 6);
    F.G = gridDim.x; { const int bx = blockIdx.x; F.vcu = (F.G % 8 == 0) ? (bx % 8) * (F.G / 8) + bx / 8 : bx; }
    F.out = args.out; F.ws = args.ws;
    for (int u = F.tid; u < 64; u += NTHR) ((LAS unsigned*)(F.lds + UP_MISC))[u] = 0u;
    if (F.tid < 34) *(LAS unsigned long long*)(F.lds + UP_PTR + 8 * F.tid) = (unsigned long long)args.in[F.tid];
    const bool is_w0 = (F.wave == 0);
    F.tid = 0; F.lane = 0;
    __syncthreads();
    XcdBarrier bar; bar.w0 = is_w0; bar.bar = wsp<unsigned>(F, WS_CTL) + CW_BAR; bar.x = 0; bar.st = nullptr;
#if !MK_PER_PHASE
    bar = xcd_barrier_post(wsp<unsigned>(F, WS_CTL) + CW_BAR, (volatile LAS unsigned*)(F.lds + UP_MISC) + 8, is_w0);
#endif
    const int lo = args.ph_lo, hi = args.ph_hi;
#define IN(k) in_ph((k), lo, hi)
#ifndef REPMASK
#define REPMASK 0ull
#endif
#define REPS(n) ((((unsigned long long)(REPMASK)) >> (n)) & 1ull ? 2 : 1)
#ifndef ONLY_SITE
#define EN(n) true
#else
#define EN(n) ((n) == ONLY_SITE)
#endif
#if MK_PER_PHASE
#define SEAM(k) do { } while (0)
#else
#define SEAM(k) do { if (IN(k) && IN((k) + 1)) xcd_barrier(bar); } while (0)
#endif
    const int bx = (int)blockIdx.x;
    typedef pg8::EpiBf16<0> EpiB;
    if (IN(0) && EN(0)) _Pragma("unroll") for (int rep_ = 0; rep_ < REPS(0); ++rep_) { const Frame P = pframe(F); p0_prologue(P); }
    SEAM(0);

            if (IN(1) && EN(1)) _Pragma("unroll") for (int rep_ = 0; rep_ < REPS(1); ++rep_) { const Frame P = pframe(F);
                { pg8::Gemm g{wsp<bf16>(P, WS_XB), wsp<bf16>(P, WS_WTIN0), NTOK, EVW, DM, P.wave}; pg8::StaticOrder S; S.init(NTOK, EVW, P.G, bx);
                  EpiB E{wsp<bf16>(P, WS_P1), EVW, nullptr, 0, 0, 1.f}; pg8::gemm_phase<EpiB, pg8::StaticOrder, true, true>(P.lds, g, S, E); }
                { pg8::Gemm g{wsp<bf16>(P, WS_MEMB), wsp<bf16>(P, WS_WTXK), NMEM, 2048, DM, P.wave}; pg8::StaticOrder S; S.init(NMEM, 2048, P.G, (bx + P.G - P.G / 2) % P.G);
                  EpiB E{wsp<bf16>(P, WS_KX), 2048, nullptr, 0, 0, 1.f}; pg8::gemm_phase<EpiB, pg8::StaticOrder, true, true>(P.lds, g, S, E); }
                { pg8::Gemm g{wsp<bf16>(P, WS_WTXV), wsp<bf16>(P, WS_MEMB), 2048, NMEM, DM, P.wave}; pg8::StaticOrder S; S.init(2048, NMEM, P.G, (bx + P.G - P.G / 2 - 32) % P.G);
                  EpiB E{wsp<bf16>(P, WS_VXT), NMEM, nullptr, 0, 0, 1.f}; pg8::gemm_phase<EpiB, pg8::StaticOrder, true, true>(P.lds, g, S, E); }
                { pg8::Gemm g{wsp<bf16>(P, WS_WTVB), wsp<bf16>(P, WS_XB), 768, NTOK, DM, P.wave}; pg8::StaticOrder S; S.init(768, NTOK, P.G, (bx + P.G - P.G / 2 - 64) % P.G);
                  pg8::EpiVT E{wsp<bf16>(P, WS_VBT), 768}; pg8::gemm_phase<pg8::EpiVT, pg8::StaticOrder, true, true>(P.lds, g, S, E); }
            }
            SEAM(1);
            if (IN(2) && EN(2)) _Pragma("unroll") for (int rep_ = 0; rep_ < REPS(2); ++rep_) { const Frame P = pframe(F); p2_postproc(P); }
            SEAM(2);
            if (IN(3) && EN(3)) _Pragma("unroll") for (int rep_ = 0; rep_ < REPS(3); ++rep_) { const Frame P = pframe(F); const int kq = (lo < 0) ? 512 : 256;     pg8::Gemm g{wsp<bf16>(P, WS_CQ), wsp<bf16>(P, WS_WTQ), NTOK, 1024, kq, P.wave}; pg8::StaticOrder S; S.init(NTOK, 1024, P.G, bx);
                EpiB E{wsp<bf16>(P, WS_QAI), 1024, nullptr, 0, 0, 1.f}; pg8::gemm_phase<EpiB, pg8::StaticOrder, true, true>(P.lds, g, S, E); }
            SEAM(3);
            if (IN(4)) { if (EN(4)) _Pragma("unroll") for (int rep_ = 0; rep_ < REPS(4); ++rep_) { const Frame P = pframe(F); dsa_phase(P); } if (EN(22)) _Pragma("unroll") for (int rep_ = 0; rep_ < REPS(22); ++rep_) { const Frame P = pframe(F); sb_phase(P); } }
            SEAM(4);
            if (IN(5) && EN(5)) _Pragma("unroll") for (int rep_ = 0; rep_ < REPS(5); ++rep_) { const Frame P = pframe(F); pg8::Gemm g{wsp<bf16>(P, WS_OAB), wsp<bf16>(P, WS_WTOUT0), NTOK, DM, DM, P.wave}; pg8::StaticOrder S; S.init(NTOK, DM, P.G, bx);
                pg8::EpiResF32 E{inp(P, 0), wsp<float>(P, WS_T), DM, DN_ALPHA}; pg8::gemm_phase<pg8::EpiResF32, pg8::StaticOrder, true, true>(P.lds, g, S, E); }
            SEAM(5);
            if (IN(6) && EN(6)) _Pragma("unroll") for (int rep_ = 0; rep_ < REPS(6); ++rep_) { const Frame P = pframe(F); ln_phase(P, wsp<float>(P, WS_T), inp(P, 19), inp(P, 20), wsp<float>(P, WS_HF), wsp<bf16>(P, WS_XB)); }
            SEAM(6);
    {
        constexpr int cb = 7;
        if (IN(cb + 0) && EN(7)) _Pragma("unroll") for (int rep_ = 0; rep_ < REPS(7); ++rep_) { const Frame P = pframe(F); pg8::Gemm g{wsp<bf16>(P, WS_XB), wsp<bf16>(P, WS_WTXQ) + (size_t)0 * DM * DM, NTOK, DM, DM, P.wave}; pg8::StaticOrder S; S.init(NTOK, DM, P.G, bx);
            EpiB E{wsp<bf16>(P, WS_QX), DM, nullptr, 0, 0, 1.f}; pg8::gemm_phase<EpiB, pg8::StaticOrder, true, true>(P.lds, g, S, E); }
        SEAM(cb + 0);
        if (IN(cb + 1) && EN(8)) _Pragma("unroll") for (int rep_ = 0; rep_ < REPS(8); ++rep_) { const Frame P = pframe(F); xattn_phase(P, 0); }
        SEAM(cb + 1);
        if (IN(cb + 2) && EN(9)) _Pragma("unroll") for (int rep_ = 0; rep_ < REPS(9); ++rep_) { const Frame P = pframe(F); pg8::Gemm g{wsp<bf16>(P, WS_AX), wsp<bf16>(P, WS_WTXO) + (size_t)0 * DM * DM, NTOK, DM, DM, P.wave}; pg8::StaticOrder S; S.init(NTOK, DM, P.G, bx);
            pg8::EpiResF32 E{wsp<float>(P, WS_HF), wsp<float>(P, WS_T), DM, DN_ALPHA}; pg8::gemm_phase<pg8::EpiResF32, pg8::StaticOrder, true, true>(P.lds, g, S, E); }
        SEAM(cb + 2);
        if (IN(cb + 3) && EN(10)) _Pragma("unroll") for (int rep_ = 0; rep_ < REPS(10); ++rep_) { const Frame P = pframe(F); ln_phase(P, wsp<float>(P, WS_T), inp(P, 24) + 0 * DM, inp(P, 25) + 0 * DM, wsp<float>(P, WS_HF), wsp<bf16>(P, WS_XB)); }
        SEAM(cb + 3);
        if (IN(cb + 4) && EN(11)) _Pragma("unroll") for (int rep_ = 0; rep_ < REPS(11); ++rep_) { const Frame P = pframe(F); router_phase(P, 0); }
        do { if (IN(cb + 4) && IN(cb + 6)) xcd_barrier(bar); } while (0);
        if (IN(cb + 6) && EN(13)) _Pragma("unroll") for (int rep_ = 0; rep_ < REPS(13); ++rep_) { const Frame P0 = pframe(F); moe_tables(P0, 0); }
        if (IN(cb + 6) && EN(13)) _Pragma("unroll") for (int rep_ = 0; rep_ < REPS(13); ++rep_) { const Frame P = pframe(F); const int nrt = __builtin_amdgcn_readfirstlane(((const LAS int*)(P.lds + UP_TSTART))[32]);
            pg8::Gemm g{wsp<bf16>(P, WS_XB), wsp<bf16>(P, WS_WTGU) + (size_t)0 * NEXP * 2048 * DM, nrt * 256, NEXP * 2048, DM, P.wave};
            pg8::MoeRows<8> AM{wsp<int>(P, WS_ELIST), (const LAS int*)(P.lds + UP_TSTART), (const LAS int*)(P.lds + UP_CNT), (LAS int*)(P.lds + UP_TOK)};
            pg8::MoeOrder<8> S{(const LAS int*)(P.lds + UP_TILEE), nrt, P.G, P.vcu};
            pg8::EpiSwiGlu E{wsp<bf16>(P, WS_ACT), inp(P, 29) + (size_t)0 * NEXP * 2048}; pg8::gemm_phase_g<pg8::EpiSwiGlu, pg8::MoeOrder<8>, pg8::MoeRows<8>, true>(P.lds, g, S, E, AM); }
        SEAM(cb + 6);
        if (IN(cb + 7) && EN(14)) _Pragma("unroll") for (int rep_ = 0; rep_ < REPS(14); ++rep_) { const Frame P0 = pframe(F); moe_tables(P0, 0); }
        if (IN(cb + 7) && EN(14)) _Pragma("unroll") for (int rep_ = 0; rep_ < REPS(14); ++rep_) { const Frame P = pframe(F); const int nrt = __builtin_amdgcn_readfirstlane(((const LAS int*)(P.lds + UP_TSTART))[32]);
            pg8::Gemm g{wsp<bf16>(P, WS_ACT), wsp<bf16>(P, WS_WTDN) + (size_t)0 * NEXP * DM * DM, nrt * 256, NEXP * DM, DM, P.wave};
            pg8::MoeOrder<4> S{(const LAS int*)(P.lds + UP_TILEE), nrt, P.G, P.vcu};
            pg8::EpiDown E{wsp<bf16>(P, WS_XG), inp(P, 31) + (size_t)0 * NEXP * DM, wsp<float>(P, WS_EGATE), (const LAS int*)(P.lds + UP_TSTART), (const LAS int*)(P.lds + UP_CNT)}; pg8::gemm_phase<pg8::EpiDown, pg8::MoeOrder<4>, true, true>(P.lds, g, S, E); }
        SEAM(cb + 7);
        if (IN(cb + 8) && EN(15)) _Pragma("unroll") for (int rep_ = 0; rep_ < REPS(15); ++rep_) { const Frame P = pframe(F); combine_phase(P, 0, 0 == 0 ? wsp<float>(P, WS_HF) : P.out); }
        SEAM(cb + 8);
    }

            if (IN(16) && EN(16)) _Pragma("unroll") for (int rep_ = 0; rep_ < REPS(16); ++rep_) { const Frame P = pframe(F); pg8::Gemm g{wsp<bf16>(P, WS_XB), wsp<bf16>(P, WS_WTS5IN), NTOK, DM, DM, P.wave}; pg8::StaticOrder S; S.init(NTOK, DM, P.G, bx);
                EpiB E{wsp<bf16>(P, WS_U), DM, nullptr, 0, 0, 1.f}; pg8::gemm_phase<EpiB, pg8::StaticOrder, true, true>(P.lds, g, S, E); }
            SEAM(16);
            if (IN(17) && EN(17)) _Pragma("unroll") for (int rep_ = 0; rep_ < REPS(17); ++rep_) { const Frame P = pframe(F); s5_local_phase(P); }
            SEAM(17);
            if (IN(18) && EN(18)) _Pragma("unroll") for (int rep_ = 0; rep_ < REPS(18); ++rep_) { const Frame P = pframe(F); s5_scan_phase(P); }
            SEAM(18);
            if (IN(19) && EN(19)) _Pragma("unroll") for (int rep_ = 0; rep_ < REPS(19); ++rep_) { const Frame P = pframe(F); s5_out_phase(P); }
            SEAM(19);
            if (IN(20) && EN(20)) _Pragma("unroll") for (int rep_ = 0; rep_ < REPS(20); ++rep_) { const Frame P = pframe(F); pg8::Gemm g{wsp<bf16>(P, WS_YG), wsp<bf16>(P, WS_WTS5OUT), NTOK, 2048, DM, P.wave}; pg8::StaticOrder S; S.init(NTOK, 2048, P.G, bx);
                pg8::EpiGluRes E{wsp<float>(P, WS_HF), wsp<float>(P, WS_T), DM, DN_ALPHA}; pg8::gemm_phase<pg8::EpiGluRes, pg8::StaticOrder, true, true>(P.lds, g, S, E); }
            SEAM(20);
            if (IN(21) && EN(21)) _Pragma("unroll") for (int rep_ = 0; rep_ < REPS(21); ++rep_) { const Frame P = pframe(F); ln_phase(P, wsp<float>(P, WS_T), inp(P, 19) + DM, inp(P, 20) + DM, wsp<float>(P, WS_HF), wsp<bf16>(P, WS_XB)); }
            SEAM(21);
    {
        constexpr int cb = 22;
        if (IN(cb + 0) && EN(7)) _Pragma("unroll") for (int rep_ = 0; rep_ < REPS(7); ++rep_) { const Frame P = pframe(F); pg8::Gemm g{wsp<bf16>(P, WS_XB), wsp<bf16>(P, WS_WTXQ) + (size_t)1 * DM * DM, NTOK, DM, DM, P.wave}; pg8::StaticOrder S; S.init(NTOK, DM, P.G, bx);
            EpiB E{wsp<bf16>(P, WS_QX), DM, nullptr, 0, 0, 1.f}; pg8::gemm_phase<EpiB, pg8::StaticOrder, true, true>(P.lds, g, S, E); }
        SEAM(cb + 0);
        if (IN(cb + 1) && EN(8)) _Pragma("unroll") for (int rep_ = 0; rep_ < REPS(8); ++rep_) { const Frame P = pframe(F); xattn_phase(P, 1); }
        SEAM(cb + 1);
        if (IN(cb + 2) && EN(9)) _Pragma("unroll") for (int rep_ = 0; rep_ < REPS(9); ++rep_) { const Frame P = pframe(F); pg8::Gemm g{wsp<bf16>(P, WS_AX), wsp<bf16>(P, WS_WTXO) + (size_t)1 * DM * DM, NTOK, DM, DM, P.wave}; pg8::StaticOrder S; S.init(NTOK, DM, P.G, bx);
            pg8::EpiResF32 E{wsp<float>(P, WS_HF), wsp<float>(P, WS_T), DM, DN_ALPHA}; pg8::gemm_phase<pg8::EpiResF32, pg8::StaticOrder, true, true>(P.lds, g, S, E); }
        SEAM(cb + 2);
        if (IN(cb + 3) && EN(10)) _Pragma("unroll") for (int rep_ = 0; rep_ < REPS(10); ++rep_) { const Frame P = pframe(F); ln_phase(P, wsp<float>(P, WS_T), inp(P, 24) + 1 * DM, inp(P, 25) + 1 * DM, wsp<float>(P, WS_HF), wsp<bf16>(P, WS_XB)); }
        SEAM(cb + 3);
        if (IN(cb + 4) && EN(11)) _Pragma("unroll") for (int rep_ = 0; rep_ < REPS(11); ++rep_) { const Frame P = pframe(F); router_phase(P, 1); }
        do { if (IN(cb + 4) && IN(cb + 6)) xcd_barrier(bar); } while (0);
        if (IN(cb + 6) && EN(13)) _Pragma("unroll") for (int rep_ = 0; rep_ < REPS(13); ++rep_) { const Frame P0 = pframe(F); moe_tables(P0, 1); }
        if (IN(cb + 6) && EN(13)) _Pragma("unroll") for (int rep_ = 0; rep_ < REPS(13); ++rep_) { const Frame P = pframe(F); const int nrt = __builtin_amdgcn_readfirstlane(((const LAS int*)(P.lds + UP_TSTART))[32]);
            pg8::Gemm g{wsp<bf16>(P, WS_XB), wsp<bf16>(P, WS_WTGU) + (size_t)1 * NEXP * 2048 * DM, nrt * 256, NEXP * 2048, DM, P.wave};
            pg8::MoeRows<8> AM{wsp<int>(P, WS_ELIST), (const LAS int*)(P.lds + UP_TSTART), (const LAS int*)(P.lds + UP_CNT), (LAS int*)(P.lds + UP_TOK)};
            pg8::MoeOrder<8> S{(const LAS int*)(P.lds + UP_TILEE), nrt, P.G, P.vcu};
            pg8::EpiSwiGlu E{wsp<bf16>(P, WS_ACT), inp(P, 29) + (size_t)1 * NEXP * 2048}; pg8::gemm_phase_g<pg8::EpiSwiGlu, pg8::MoeOrder<8>, pg8::MoeRows<8>, true>(P.lds, g, S, E, AM); }
        SEAM(cb + 6);
        if (IN(cb + 7) && EN(14)) _Pragma("unroll") for (int rep_ = 0; rep_ < REPS(14); ++rep_) { const Frame P0 = pframe(F); moe_tables(P0, 1); }
        if (IN(cb + 7) && EN(14)) _Pragma("unroll") for (int rep_ = 0; rep_ < REPS(14); ++rep_) { const Frame P = pframe(F); const int nrt = __builtin_amdgcn_readfirstlane(((const LAS int*)(P.lds + UP_TSTART))[32]);
            pg8::Gemm g{wsp<bf16>(P, WS_ACT), wsp<bf16>(P, WS_WTDN) + (size_t)1 * NEXP * DM * DM, nrt * 256, NEXP * DM, DM, P.wave};
            pg8::MoeOrder<4> S{(const LAS int*)(P.lds + UP_TILEE), nrt, P.G, P.vcu};
            pg8::EpiDown E{wsp<bf16>(P, WS_XG), inp(P, 31) + (size_t)1 * NEXP * DM, wsp<float>(P, WS_EGATE), (const LAS int*)(P.lds + UP_TSTART), (const LAS int*)(P.lds + UP_CNT)}; pg8::gemm_phase<pg8::EpiDown, pg8::MoeOrder<4>, true, true>(P.lds, g, S, E); }
        SEAM(cb + 7);
        if (IN(cb + 8) && EN(15)) _Pragma("unroll") for (int rep_ = 0; rep_ < REPS(15); ++rep_) { const Frame P = pframe(F); combine_phase(P, 1, 1 == 0 ? wsp<float>(P, WS_HF) : P.out); }

    }
#undef IN
#undef SEAM
}

extern "C" void kernel_launch(void* const* d_in, const int* in_sizes, int n_in, void* d_out, int out_size, void* d_ws, size_t ws_size, hipStream_t stream) {
    static int grid = 0;
    if (grid == 0) {
        if (n_in != 34 || in_sizes[0] != NTOK * DM || out_size != NTOK * DM || ws_size < WS_WTVB + 2 * MiB) {
            fprintf(stderr, "kernel_launch: built for 34 inputs, x/out of %d floats, >= %zu bytes of workspace; got n_in %d, in0 %d, out %d, ws %zu; nothing launched\n", NTOK * DM, (size_t)WS_END, n_in, n_in > 0 ? in_sizes[0] : -1, out_size, ws_size);
            grid = -1; return; }
        int dev = 0, cus = 0, per_cu = 0;
        if (hipGetDevice(&dev) != hipSuccess || hipDeviceGetAttribute(&cus, hipDeviceAttributeMultiprocessorCount, dev) != hipSuccess) { fprintf(stderr, "kernel_launch: device query failed\n"); grid = -1; return; }
        if (hipFuncSetAttribute((const void*)fwd_kernel, hipFuncAttributeMaxDynamicSharedMemorySize, LDS_BYTES) != hipSuccess) { fprintf(stderr, "kernel_launch: hipFuncSetAttribute failed\n"); grid = -1; return; }
        if (hipOccupancyMaxActiveBlocksPerMultiprocessor(&per_cu, (const void*)fwd_kernel, NTHR, LDS_BYTES) != hipSuccess || per_cu < 1)
            fprintf(stderr, "kernel_launch: note: occupancy query reports %d workgroups per CU\n", per_cu);
        (void)hipGetLastError();
        grid = cus;
    }
    if (grid < 0) return;
    if (hipMemsetAsync((char*)d_ws + WS_CTL, 0, CTL_ZERO_BYTES, stream) != hipSuccess) { fprintf(stderr, "kernel_launch: memset failed\n"); return; }
    Args a{};
    for (int i = 0; i < 34; ++i) a.in[i] = (const float*)d_in[i];
    a.out = (float*)d_out; a.ws = (unsigned char*)d_ws;
#if MK_PER_PHASE
    for (int p = 0; p < NPH; ++p) { a.ph_lo = p; a.ph_hi = p + 1; hipLaunchKernelGGL(fwd_kernel, dim3(grid), dim3(NTHR), LDS_BYTES, stream, a); }
#else
    a.ph_lo = 0; a.ph_hi = NPH;
    hipLaunchKernelGGL(fwd_kernel, dim3(grid), dim3(NTHR), LDS_BYTES, stream, a);
#endif
    const hipError_t le = hipPeekAtLastError();
    if (le != hipSuccess) fprintf(stderr, "kernel_launch: launch failed: %s\n", hipGetErrorName(le));
}
```

```cpp
#include <hip/hip_runtime.h>
#include <cstdio>
#include <cstdint>
namespace pg8 {
#define PG8_LAS __attribute__((address_space(3)))
typedef unsigned short bf16_t;
typedef short bf16x8 __attribute__((ext_vector_type(8)));
typedef float f32x4 __attribute__((ext_vector_type(4)));
typedef unsigned u32x4 __attribute__((ext_vector_type(4)));
constexpr int BM = 256, BK = 64, HALF = 128, HTB = HALF * BK * 2  , STAGE_BYTES = 8 * HTB, NXCD = 8, WGM = 8;

__host__ __device__ __forceinline__ int lds_byte(int r, int c) { const int st = (r >> 4) * 2 + (c >> 5), rr = r & 15, cc = c & 31, ob = rr * 64 + cc * 2; return st * 1024 + (ob ^ (((ob >> 9) & 1) << 5)); }
__host__ __device__ __forceinline__ void stage_rc(int b, int& R, int& C) { const int st = b / 1024, sb = b % 1024, swz = sb ^ (((sb >> 9) & 1) << 5); R = (st >> 1) * 16 + swz / 64; C = (st & 1) * 32 + (swz % 64) / 2; }
__host__ __device__ __forceinline__ int perm32(int rho) { const int n = rho >> 4, i = rho & 15; return 8 * (i >> 2) + 4 * n + (i & 3); }

struct Unit { int pm, pn; };
struct Gemm { const bf16_t* A; const bf16_t* Bt; int M, N, K; int wid; };

struct StaticOrder {
    int nM, nN, nwg, G, c;
    __host__ __device__ void init(int M, int N, int G_, int c_) { nM = M / BM; nN = N / BM; nwg = nM * nN; G = G_; c = c_; }
    __host__ __device__ bool next(int i, Unit& u) const {
        const long L = (long)i * G + c; if (L >= nwg) return false;
        int wgid = (int)L; { const int q = nwg / NXCD, r = nwg % NXCD, xcd = wgid % NXCD, off = wgid / NXCD; wgid = (xcd < r ? xcd * (q + 1) : r * (q + 1) + (xcd - r) * q) + off; }
        const int nig = WGM * nN, gid = wgid / nig, fm = gid * WGM, gsz = (nM - fm) < WGM ? (nM - fm) : WGM;
        u.pm = fm + ((wgid % nig) % gsz); u.pn = (wgid % nig) / gsz; return true;
    }
    __device__ __forceinline__ void a_ready(const Unit&) const {}
    __device__ __forceinline__ void done(const Unit&) const {}
};

__device__ __forceinline__ unsigned cvt_pk_bf16(float lo, float hi) { unsigned r; asm volatile("v_cvt_pk_bf16_f32 %0, %1, %2" : "=v"(r) : "v"(lo), "v"(hi)); return r; }
typedef float f32x2 __attribute__((ext_vector_type(2)));
__device__ __forceinline__ f32x2 gelu_pk(f32x2 v) {
    const f32x2 av = __builtin_elementwise_abs(v), d = av * 0.2316418882f + 1.0f;
    f32x2 t; t.x = __builtin_amdgcn_rcpf(d.x); t.y = __builtin_amdgcn_rcpf(d.y);
    f32x2 q = t * 0.5307027145f + (-0.7265760135f); q = q * t + 0.7107068705f; q = q * t + (-0.142248368f); q = q * t + 0.127414796f; q = q * t;
    const f32x2 s = (v * v) * (-0.72134752044f);
    f32x2 e; e.x = __builtin_amdgcn_exp2f(s.x); e.y = __builtin_amdgcn_exp2f(s.y);
    const f32x2 m = v * (q * e), r = v - m;
    f32x2 o; o.x = v.x < 0.f ? m.x : r.x; o.y = v.y < 0.f ? m.y : r.y; return o;
}

template <int ACT  > struct EpiBf16 {
    static constexpr bool PERM = true, AFTER_DRAIN = false; static_assert(ACT == 0 || ACT == 1, "EpiBf16: ACT is 0 (none) or 1 (gelu_pk)");
    bf16_t* O; int ldc; const float* bias; int split_cols; size_t split_stride; float scale0;
    __device__ __forceinline__ void operator()(const f32x4 (&acc)[2][2][4][2], const Unit& u, int wr, int wc, int fr, int fq) const {
        const int row0 = u.pm * BM + wr * 64 + fr; int colt = u.pn * BM; bf16_t* base = O;
        float sc = 1.f; if (split_cols) { const int t = colt / split_cols; base += (size_t)t * split_stride; colt -= t * split_cols; if (t == 0) sc = scale0; }
        const int col0 = colt + wc * 32 + 8 * fq, bcol0 = u.pn * BM + wc * 32 + 8 * fq;
        f32x4 bv[2][2];
#pragma unroll
        for (int bj = 0; bj < 2; ++bj)
#pragma unroll
            for (int n = 0; n < 2; ++n) bv[bj][n] = bias ? *(const f32x4*)(bias + bcol0 + bj * HALF + 4 * n) : (f32x4){0.f, 0.f, 0.f, 0.f};
#pragma unroll
        for (int ai = 0; ai < 2; ++ai)
#pragma unroll
            for (int m = 0; m < 4; ++m) { bf16_t* rowp = base + (size_t)(row0 + ai * HALF + m * 16) * ldc + col0;
#pragma unroll
                for (int bj = 0; bj < 2; ++bj) { f32x4 v0 = acc[ai][bj][m][0] + bv[bj][0], v1 = acc[ai][bj][m][1] + bv[bj][1];
                    if (ACT == 1) { f32x2 a = gelu_pk((f32x2){v0[0], v0[1]}), b = gelu_pk((f32x2){v0[2], v0[3]}), c = gelu_pk((f32x2){v1[0], v1[1]}), d = gelu_pk((f32x2){v1[2], v1[3]});
                        v0 = (f32x4){a.x, a.y, b.x, b.y}; v1 = (f32x4){c.x, c.y, d.x, d.y}; }
                    v0 = v0 * sc; v1 = v1 * sc; u32x4 w; w.x = cvt_pk_bf16(v0[0], v0[1]); w.y = cvt_pk_bf16(v0[2], v0[3]); w.z = cvt_pk_bf16(v1[0], v1[1]); w.w = cvt_pk_bf16(v1[2], v1[3]);
                    *(u32x4*)(rowp + bj * HALF) = w; } }
    }
};
template <class Epi, class Sched, bool ALIGN_EPI = false, bool SP2 = false>
__device__ __forceinline__ void gemm_phase(PG8_LAS unsigned char* lds, const Gemm g, const Sched& S, const Epi& E) {
    int tid_; asm volatile("v_mbcnt_lo_u32_b32 %0, -1, 0\n\tv_mbcnt_hi_u32_b32 %0, -1, %0" : "=v"(tid_)); tid_ += g.wid * 64;
    const int tid = tid_, wid = __builtin_amdgcn_readfirstlane(tid >> 6), lane = tid & 63, wr = wid >> 2, wc = wid & 3, fr = lane & 15, fq = lane >> 4;
    const int K = g.K, nt = K / BK;
    unsigned voffA[2], voffB[2];
#pragma unroll
    for (int i = 0; i < 2; ++i) { int R, C; stage_rc(tid * 16 + i * 8192, R, C); const int Rb = Epi::PERM ? ((R & ~31) + perm32(R & 31)) : R;
        voffA[i] = (unsigned)(R * K + C) * 2u; voffB[i] = (unsigned)(Rb * K + C) * 2u; }
    const size_t kstep = (size_t)(BK * 2);
    const size_t hstep = (size_t)HALF * K * 2;
    const size_t tstep = 2 * hstep;
    const unsigned ldsw = (unsigned)wid * 1024u;
    const int aoff = lds_byte(wr * 64 + fr, fq * 8), boff = lds_byte(wc * 32 + fr, fq * 8);
#define PG8_SA(b, h) (((b) * 2 + (h)) * HTB)
#define PG8_SB(b, h) ((4 + (b) * 2 + (h)) * HTB)
#define PG8_STAGE(bufoff, gbase, voff) do { _Pragma("unroll") for (int _i = 0; _i < 2; ++_i) \
        __builtin_amdgcn_global_load_lds((const unsigned*)((const char*)(gbase) + (voff)[_i]), (PG8_LAS unsigned*)(lds + (bufoff) + ldsw + _i * 8192), 16, 0, 0); } while (0)
#define PG8_LDA(dst, b, h) do { _Pragma("unroll") for (int m = 0; m < 4; ++m) _Pragma("unroll") for (int k = 0; k < 2; ++k) dst[m][k] = *(const PG8_LAS bf16x8*)(lds + PG8_SA(b, h) + aoff + m * 2048 + k * 1024); } while (0)
#define PG8_LDB(dst, b, h) do { _Pragma("unroll") for (int n = 0; n < 2; ++n) _Pragma("unroll") for (int k = 0; k < 2; ++k) dst[n][k] = *(const PG8_LAS bf16x8*)(lds + PG8_SB(b, h) + boff + n * 2048 + k * 1024); } while (0)
#define PG8_MMA(ai, bj, At, Bt) do { __builtin_amdgcn_s_setprio(1); _Pragma("unroll") for (int m = 0; m < 4; ++m) _Pragma("unroll") for (int n = 0; n < 2; ++n) _Pragma("unroll") for (int k = 0; k < 2; ++k) \
        acc[ai][bj][m][n] = __builtin_amdgcn_mfma_f32_16x16x32_bf16(Bt[n][k], At[m][k], acc[ai][bj][m][n], 0, 0, 0); __builtin_amdgcn_s_setprio(0); } while (0)
#define PG8_WAIT_V(n) asm volatile("s_waitcnt vmcnt(" #n ")" ::: "memory")
#define PG8_WAIT_L(n) asm volatile("s_waitcnt lgkmcnt(" #n ")" ::: "memory")
#define PG8_BAR __builtin_amdgcn_s_barrier()
#define PG8_SCHED __builtin_amdgcn_sched_barrier(0)
    Unit cur, nxt; int ui = 0;
    if (!S.next(0, cur)) return;
    f32x4 acc[2][2][4][2];
#pragma unroll
    for (int a = 0; a < 2; ++a)
#pragma unroll
        for (int b = 0; b < 2; ++b)
#pragma unroll
            for (int m = 0; m < 4; ++m)
#pragma unroll
                for (int n = 0; n < 2; ++n) acc[a][b][m][n] = (f32x4){0.f, 0.f, 0.f, 0.f};
    bf16x8 At[4][2], B0[2][2], B1[2][2];
    const char* cA = (const char*)g.A + (size_t)cur.pm * tstep; const char* cB = (const char*)g.Bt + (size_t)cur.pn * tstep;
    S.a_ready(cur);
    if constexpr (SP2) {
        PG8_STAGE(PG8_SB(0, 0), cB, voffB); PG8_STAGE(PG8_SB(0, 1), cB + hstep, voffB); PG8_STAGE(PG8_SA(0, 0), cA, voffA); PG8_STAGE(PG8_SA(0, 1), cA + hstep, voffA);
        if (wr == 1) PG8_BAR;
        PG8_WAIT_V(2); PG8_BAR;
        PG8_STAGE(PG8_SB(1, 0), cB + kstep, voffB); PG8_STAGE(PG8_SA(1, 0), cA + kstep, voffA); PG8_STAGE(PG8_SB(1, 1), cB + hstep + kstep, voffB);
        PG8_WAIT_V(6); PG8_BAR;
    } else {
        PG8_STAGE(PG8_SB(0, 0), cB, voffB); PG8_STAGE(PG8_SA(0, 0), cA, voffA); PG8_STAGE(PG8_SB(0, 1), cB + hstep, voffB); PG8_STAGE(PG8_SA(0, 1), cA + hstep, voffA);
        if (wr == 1) PG8_BAR;
        PG8_WAIT_V(4); PG8_BAR;
        PG8_STAGE(PG8_SB(1, 0), cB + kstep, voffB); PG8_STAGE(PG8_SA(1, 0), cA + kstep, voffA); PG8_STAGE(PG8_SB(1, 1), cB + hstep + kstep, voffB);
        PG8_WAIT_V(6); PG8_BAR;
    }
    for (;;) {
        const bool has_next = S.next(ui + 1, nxt);
        const char* nA = has_next ? (const char*)g.A + (size_t)nxt.pm * tstep : cA; const char* nB = has_next ? (const char*)g.Bt + (size_t)nxt.pn * tstep : cB;
        for (int t = 0; t < nt; t += 2) {
            const bool last = (t == nt - 2);
            const char* a1 = cA + (size_t)(t + 1) * kstep;
            const char* a2 = last ? nA : cA + (size_t)(t + 2) * kstep; const char* b2 = last ? nB : cB + (size_t)(t + 2) * kstep;
            const char* a3 = a2 + kstep; const char* b3 = b2 + kstep;
            if (last && has_next) S.a_ready(nxt);
            if constexpr (SP2) {
            PG8_LDB(B0, 0, 0); PG8_LDB(B1, 0, 1); PG8_SCHED; PG8_LDA(At, 0, 0); PG8_STAGE(PG8_SA(1, 1), a1 + hstep, voffA);
            PG8_WAIT_V(8); PG8_WAIT_L(0); PG8_BAR; PG8_MMA(0, 0, At, B0); PG8_MMA(0, 1, At, B1); PG8_BAR; PG8_SCHED;
            PG8_LDA(At, 0, 1); PG8_STAGE(PG8_SB(0, 0), b2, voffB); PG8_STAGE(PG8_SB(0, 1), b2 + hstep, voffB); PG8_STAGE(PG8_SA(0, 0), a2, voffA);
            PG8_WAIT_V(8); PG8_WAIT_L(0); PG8_BAR; PG8_MMA(1, 0, At, B0); PG8_MMA(1, 1, At, B1); PG8_BAR; PG8_SCHED;
            PG8_LDB(B0, 1, 0); PG8_LDB(B1, 1, 1); PG8_SCHED; PG8_LDA(At, 1, 0); PG8_STAGE(PG8_SA(0, 1), a2 + hstep, voffA);
            PG8_WAIT_V(8); PG8_WAIT_L(0); PG8_BAR; PG8_MMA(0, 0, At, B0); PG8_MMA(0, 1, At, B1); PG8_BAR; PG8_SCHED;
            PG8_LDA(At, 1, 1); PG8_STAGE(PG8_SB(1, 0), b3, voffB); PG8_STAGE(PG8_SB(1, 1), b3 + hstep, voffB); PG8_STAGE(PG8_SA(1, 0), a3, voffA);
            PG8_WAIT_V(8); PG8_WAIT_L(0); PG8_BAR; PG8_MMA(1, 0, At, B0); PG8_MMA(1, 1, At, B1); PG8_BAR; PG8_SCHED;
            } else {
            PG8_LDB(B0, 0, 0); PG8_SCHED; PG8_LDA(At, 0, 0); PG8_STAGE(PG8_SA(1, 1), a1 + hstep, voffA);
            PG8_WAIT_L(8); PG8_BAR; PG8_WAIT_L(0); PG8_MMA(0, 0, At, B0); PG8_BAR; PG8_SCHED;
            PG8_LDB(B1, 0, 1); PG8_STAGE(PG8_SB(0, 0), b2, voffB);
            PG8_BAR; PG8_WAIT_L(0); PG8_MMA(0, 1, At, B1); PG8_BAR;
            PG8_LDA(At, 0, 1); PG8_STAGE(PG8_SA(0, 0), a2, voffA);
            PG8_BAR; PG8_WAIT_L(0); PG8_MMA(1, 0, At, B0); PG8_BAR; PG8_SCHED;
            PG8_STAGE(PG8_SB(0, 1), b2 + hstep, voffB);
            PG8_WAIT_V(6); PG8_BAR; PG8_MMA(1, 1, At, B1); PG8_BAR;
            PG8_LDB(B0, 1, 0); PG8_SCHED; PG8_LDA(At, 1, 0); PG8_STAGE(PG8_SA(0, 1), a2 + hstep, voffA);
            PG8_WAIT_L(8); PG8_BAR; PG8_WAIT_L(0); PG8_MMA(0, 0, At, B0); PG8_BAR; PG8_SCHED;
            PG8_LDB(B1, 1, 1); PG8_STAGE(PG8_SB(1, 0), b3, voffB);
            PG8_BAR; PG8_WAIT_L(0); PG8_MMA(0, 1, At, B1); PG8_BAR;
            PG8_LDA(At, 1, 1); PG8_STAGE(PG8_SA(1, 0), a3, voffA);
            PG8_BAR; PG8_WAIT_L(0); PG8_MMA(1, 0, At, B0); PG8_BAR; PG8_SCHED;
            PG8_STAGE(PG8_SB(1, 1), b3 + hstep, voffB);
            PG8_WAIT_V(6); PG8_BAR; PG8_MMA(1, 1, At, B1); PG8_BAR;
            }
        }
        if constexpr (ALIGN_EPI) { if (wr == 0) PG8_BAR; }
        if constexpr (!Epi::AFTER_DRAIN) { E(acc, cur, wr, wc, fr, fq); S.done(cur); }
        if (!has_next) break;
#pragma unroll
        for (int a = 0; a < 2; ++a)
#pragma unroll
            for (int b = 0; b < 2; ++b)
#pragma unroll
                for (int m = 0; m < 4; ++m)
#pragma unroll
                    for (int n = 0; n < 2; ++n) acc[a][b][m][n] = (f32x4){0.f, 0.f, 0.f, 0.f};
        cur = nxt; cA = nA; cB = nB; ++ui;
        if constexpr (ALIGN_EPI) { if (wr == 1) PG8_BAR; }
    }
    PG8_WAIT_V(0);
    if constexpr (!ALIGN_EPI) { if (wr == 0) PG8_BAR; }
    PG8_BAR;
    if constexpr (Epi::AFTER_DRAIN) { E.fused(acc, cur, wr, wc, fr, fq, lds, wid, lane); S.done(cur); }
#undef PG8_SA
#undef PG8_SB
#undef PG8_STAGE
#undef PG8_LDA
#undef PG8_LDB
#undef PG8_MMA
#undef PG8_WAIT_V
#undef PG8_WAIT_L
#undef PG8_BAR
#undef PG8_SCHED
}
template <class Epi, class Sched, class AMap, bool ALIGN_EPI = false>
__device__ __forceinline__ void gemm_phase_g(PG8_LAS unsigned char* lds, const Gemm g, const Sched& S, const Epi& E, const AMap& AM) {
    constexpr bool SP2 = true;
    int tid_; asm volatile("v_mbcnt_lo_u32_b32 %0, -1, 0\n\tv_mbcnt_hi_u32_b32 %0, -1, %0" : "=v"(tid_)); tid_ += g.wid * 64;
    const int tid = tid_, wid = __builtin_amdgcn_readfirstlane(tid >> 6), lane = tid & 63, wr = wid >> 2, wc = wid & 3, fr = lane & 15, fq = lane >> 4;
    const int K = g.K, nt = K / BK;
    unsigned voffB[2]; int pR[2], pC[2]; unsigned gc[2][2], gn[2][2];
#pragma unroll
    for (int i = 0; i < 2; ++i) { int R, C; stage_rc(tid * 16 + i * 8192, R, C); const int Rb = Epi::PERM ? ((R & ~31) + perm32(R & 31)) : R;
        pR[i] = R; pC[i] = C; voffB[i] = (unsigned)(Rb * K + C) * 2u; }
    const size_t kstep = (size_t)(BK * 2);
    const size_t kstepA = AM.kstep();
    const size_t hstep = (size_t)HALF * K * 2;
    const size_t tstep = 2 * hstep;
    const unsigned ldsw = (unsigned)wid * 1024u;
    const int aoff = lds_byte(wr * 64 + fr, fq * 8), boff = lds_byte(wc * 32 + fr, fq * 8);
#define PG8_SA(b, h) (((b) * 2 + (h)) * HTB)
#define PG8_SB(b, h) ((4 + (b) * 2 + (h)) * HTB)
#define PG8_STAGE(bufoff, gbase, voff) do { _Pragma("unroll") for (int _i = 0; _i < 2; ++_i) \
        __builtin_amdgcn_global_load_lds((const unsigned*)((const char*)(gbase) + (voff)[_i]), (PG8_LAS unsigned*)(lds + (bufoff) + ldsw + _i * 8192), 16, 0, 0); } while (0)
#define PG8_LDA(dst, b, h) do { _Pragma("unroll") for (int m = 0; m < 4; ++m) _Pragma("unroll") for (int k = 0; k < 2; ++k) dst[m][k] = *(const PG8_LAS bf16x8*)(lds + PG8_SA(b, h) + aoff + m * 2048 + k * 1024); } while (0)
#define PG8_LDB(dst, b, h) do { _Pragma("unroll") for (int n = 0; n < 2; ++n) _Pragma("unroll") for (int k = 0; k < 2; ++k) dst[n][k] = *(const PG8_LAS bf16x8*)(lds + PG8_SB(b, h) + boff + n * 2048 + k * 1024); } while (0)
#define PG8_MMA(ai, bj, At, Bt) do { __builtin_amdgcn_s_setprio(1); _Pragma("unroll") for (int m = 0; m < 4; ++m) _Pragma("unroll") for (int n = 0; n < 2; ++n) _Pragma("unroll") for (int k = 0; k < 2; ++k) \
        acc[ai][bj][m][n] = __builtin_amdgcn_mfma_f32_16x16x32_bf16(Bt[n][k], At[m][k], acc[ai][bj][m][n], 0, 0, 0); __builtin_amdgcn_s_setprio(0); } while (0)
#define PG8_WAIT_V(n) asm volatile("s_waitcnt vmcnt(" #n ")" ::: "memory")
#define PG8_WAIT_L(n) asm volatile("s_waitcnt lgkmcnt(" #n ")" ::: "memory")
#define PG8_BAR __builtin_amdgcn_s_barrier()
#define PG8_SCHED __builtin_amdgcn_sched_barrier(0)
    Unit cur, nxt; int ui = 0;
    if (!S.next(0, cur)) return;
    f32x4 acc[2][2][4][2];
#pragma unroll
    for (int a = 0; a < 2; ++a)
#pragma unroll
        for (int b = 0; b < 2; ++b)
#pragma unroll
            for (int m = 0; m < 4; ++m)
#pragma unroll
                for (int n = 0; n < 2; ++n) acc[a][b][m][n] = (f32x4){0.f, 0.f, 0.f, 0.f};
    bf16x8 At[4][2], B0[2][2], B1[2][2];
    const char* const cA = (const char*)g.A; const char* cB = (const char*)g.Bt + (size_t)cur.pn * tstep;
    AM.prefetch(cur, 0, wid, lane);
    asm volatile("s_waitcnt vmcnt(0)" ::: "memory"); __builtin_amdgcn_s_barrier(); asm volatile("" ::: "memory");
#pragma unroll
    for (int h = 0; h < 2; ++h)
#pragma unroll
        for (int i = 0; i < 2; ++i) gc[h][i] = AM.off(cur, 0, h * HALF + pR[i], pC[i], K);
    S.a_ready(cur);
    if constexpr (SP2) {
        PG8_STAGE(PG8_SB(0, 0), cB, voffB); PG8_STAGE(PG8_SB(0, 1), cB + hstep, voffB); PG8_STAGE(PG8_SA(0, 0), cA, gc[0]); PG8_STAGE(PG8_SA(0, 1), cA, gc[1]);
        if (wr == 1) PG8_BAR;
        PG8_WAIT_V(2); PG8_BAR;
        PG8_STAGE(PG8_SB(1, 0), cB + kstep, voffB); PG8_STAGE(PG8_SA(1, 0), cA + kstepA, gc[0]); PG8_STAGE(PG8_SB(1, 1), cB + hstep + kstep, voffB);
        PG8_WAIT_V(6); PG8_BAR;
    } else {
        PG8_STAGE(PG8_SB(0, 0), cB, voffB); PG8_STAGE(PG8_SA(0, 0), cA, gc[0]); PG8_STAGE(PG8_SB(0, 1), cB + hstep, voffB); PG8_STAGE(PG8_SA(0, 1), cA, gc[1]);
        if (wr == 1) PG8_BAR;
        PG8_WAIT_V(4); PG8_BAR;
        PG8_STAGE(PG8_SB(1, 0), cB + kstep, voffB); PG8_STAGE(PG8_SA(1, 0), cA + kstepA, gc[0]); PG8_STAGE(PG8_SB(1, 1), cB + hstep + kstep, voffB);
        PG8_WAIT_V(6); PG8_BAR;
    }
    for (;;) {
        const bool has_next = S.next(ui + 1, nxt);
        const char* nB = has_next ? (const char*)g.Bt + (size_t)nxt.pn * tstep : cB;
        if (has_next) AM.prefetch(nxt, (ui + 1) & 1, wid, lane);
        for (int t = 0; t < nt; t += 2) {
            const bool last = (t == nt - 2);
            const char* a1 = cA + (size_t)(t + 1) * kstepA;
            const char* a2 = last ? cA : cA + (size_t)(t + 2) * kstepA; const char* b2 = last ? nB : cB + (size_t)(t + 2) * kstep;
            if (last) {
#pragma unroll
                for (int h = 0; h < 2; ++h)
#pragma unroll
                    for (int i = 0; i < 2; ++i) gn[h][i] = has_next ? AM.off(nxt, (ui + 1) & 1, h * HALF + pR[i], pC[i], K) : gc[h][i]; }
            unsigned o2[2][2];
#pragma unroll
            for (int h = 0; h < 2; ++h)
#pragma unroll
                for (int i = 0; i < 2; ++i) o2[h][i] = last ? gn[h][i] : gc[h][i];
            const char* a3 = a2 + kstepA; const char* b3 = b2 + kstep;
            if (last && has_next) S.a_ready(nxt);
            if constexpr (SP2) {
            PG8_LDB(B0, 0, 0); PG8_LDB(B1, 0, 1); PG8_SCHED; PG8_LDA(At, 0, 0); PG8_STAGE(PG8_SA(1, 1), a1, gc[1]);
            PG8_WAIT_V(8); PG8_WAIT_L(0); PG8_BAR; PG8_MMA(0, 0, At, B0); PG8_MMA(0, 1, At, B1); PG8_BAR; PG8_SCHED;
            PG8_LDA(At, 0, 1); PG8_STAGE(PG8_SB(0, 0), b2, voffB); PG8_STAGE(PG8_SB(0, 1), b2 + hstep, voffB); PG8_STAGE(PG8_SA(0, 0), a2, o2[0]);
            PG8_WAIT_V(8); PG8_WAIT_L(0); PG8_BAR; PG8_MMA(1, 0, At, B0); PG8_MMA(1, 1, At, B1); PG8_BAR; PG8_SCHED;
            PG8_LDB(B0, 1, 0); PG8_LDB(B1, 1, 1); PG8_SCHED; PG8_LDA(At, 1, 0); PG8_STAGE(PG8_SA(0, 1), a2, o2[1]);
            PG8_WAIT_V(8); PG8_WAIT_L(0); PG8_BAR; PG8_MMA(0, 0, At, B0); PG8_MMA(0, 1, At, B1); PG8_BAR; PG8_SCHED;
            PG8_LDA(At, 1, 1); PG8_STAGE(PG8_SB(1, 0), b3, voffB); PG8_STAGE(PG8_SB(1, 1), b3 + hstep, voffB); PG8_STAGE(PG8_SA(1, 0), a3, o2[0]);
            PG8_WAIT_V(8); PG8_WAIT_L(0); PG8_BAR; PG8_MMA(1, 0, At, B0); PG8_MMA(1, 1, At, B1); PG8_BAR; PG8_SCHED;
            } else {
            PG8_LDB(B0, 0, 0); PG8_SCHED; PG8_LDA(At, 0, 0); PG8_STAGE(PG8_SA(1, 1), a1, gc[1]);
            PG8_WAIT_L(8); PG8_BAR; PG8_WAIT_L(0); PG8_MMA(0, 0, At, B0); PG8_BAR; PG8_SCHED;
            PG8_LDB(B1, 0, 1); PG8_STAGE(PG8_SB(0, 0), b2, voffB);
            PG8_BAR; PG8_WAIT_L(0); PG8_MMA(0, 1, At, B1); PG8_BAR;
            PG8_LDA(At, 0, 1); PG8_STAGE(PG8_SA(0, 0), a2, o2[0]);
            PG8_BAR; PG8_WAIT_L(0); PG8_MMA(1, 0, At, B0); PG8_BAR; PG8_SCHED;
            PG8_STAGE(PG8_SB(0, 1), b2 + hstep, voffB);
            PG8_WAIT_V(6); PG8_BAR; PG8_MMA(1, 1, At, B1); PG8_BAR;
            PG8_LDB(B0, 1, 0); PG8_SCHED; PG8_LDA(At, 1, 0); PG8_STAGE(PG8_SA(0, 1), a2, o2[1]);
            PG8_WAIT_L(8); PG8_BAR; PG8_WAIT_L(0); PG8_MMA(0, 0, At, B0); PG8_BAR; PG8_SCHED;
            PG8_LDB(B1, 1, 1); PG8_STAGE(PG8_SB(1, 0), b3, voffB);
            PG8_BAR; PG8_WAIT_L(0); PG8_MMA(0, 1, At, B1); PG8_BAR;
            PG8_LDA(At, 1, 1); PG8_STAGE(PG8_SA(1, 0), a3, o2[0]);
            PG8_BAR; PG8_WAIT_L(0); PG8_MMA(1, 0, At, B0); PG8_BAR; PG8_SCHED;
            PG8_STAGE(PG8_SB(1, 1), b3 + hstep, voffB);
            PG8_WAIT_V(6); PG8_BAR; PG8_MMA(1, 1, At, B1); PG8_BAR;
            }
        }
        if constexpr (ALIGN_EPI) { if (wr == 0) PG8_BAR; }
        if constexpr (!Epi::AFTER_DRAIN) { E(acc, cur, wr, wc, fr, fq); S.done(cur); }
        if (!has_next) break;
#pragma unroll
        for (int a = 0; a < 2; ++a)
#pragma unroll
            for (int b = 0; b < 2; ++b)
#pragma unroll
                for (int m = 0; m < 4; ++m)
#pragma unroll
                    for (int n = 0; n < 2; ++n) acc[a][b][m][n] = (f32x4){0.f, 0.f, 0.f, 0.f};
        cur = nxt; cB = nB; ++ui;
#pragma unroll
        for (int h = 0; h < 2; ++h)
#pragma unroll
            for (int i = 0; i < 2; ++i) gc[h][i] = gn[h][i];
        if constexpr (ALIGN_EPI) { if (wr == 1) PG8_BAR; }
    }
    PG8_WAIT_V(0);
    if constexpr (!ALIGN_EPI) { if (wr == 0) PG8_BAR; }
    PG8_BAR;
    if constexpr (Epi::AFTER_DRAIN) { E.fused(acc, cur, wr, wc, fr, fq, lds, wid, lane); S.done(cur); }
#undef PG8_SA
#undef PG8_SB
#undef PG8_STAGE
#undef PG8_LDA
#undef PG8_LDB
#undef PG8_MMA
#undef PG8_WAIT_V
#undef PG8_WAIT_L
#undef PG8_BAR
#undef PG8_SCHED
}
}
#define LAS __attribute__((address_space(3)))
#define XB_TMO      128
#define XB_XCNT(j)  (256  + 64 * (j))
#define XB_XSUB(j)  (1280 + 64 * (j))
#define XB_XGEN(j)  (2304 + 64 * (j))
#define XB_TOP      3328
#define XB_TOPGEN   3392
#define XCD_BAR_WORDS 3456
#define XB_SPIN_CAP (1u << 18)

__device__ __forceinline__ unsigned xb_ld(unsigned* p)              { return __hip_atomic_load(p, __ATOMIC_RELAXED, __HIP_MEMORY_SCOPE_AGENT); }
__device__ __forceinline__ unsigned xb_add(unsigned* p, unsigned v) { return __hip_atomic_fetch_add(p, v, __ATOMIC_RELAXED, __HIP_MEMORY_SCOPE_AGENT); }
__device__ __forceinline__ unsigned xb_xcc_id() { return (unsigned)__builtin_amdgcn_s_getreg((3 << 11) | 20) & 0xFu; }
#define XB_SPIN(cond, bar) do { unsigned _sp = 0; while (cond) { __builtin_amdgcn_s_sleep(1); \
    if ((++_sp & 255u) == 0u) { if (xb_ld(&(bar)[XB_TMO])) break; if (_sp > XB_SPIN_CAP) { atomicAdd(&(bar)[XB_TMO], 1u); break; } } } } while (0)

__device__ __forceinline__ int xb_lane() { int l; asm volatile("v_mbcnt_lo_u32_b32 %0, -1, 0\n\tv_mbcnt_hi_u32_b32 %0, -1, %0" : "=v"(l)); return l; }
struct XcdBarrier {
    bool w0;
    unsigned* bar; unsigned x;
    volatile LAS unsigned* st;
};

__device__ __forceinline__ XcdBarrier xcd_barrier_post(unsigned* bar, volatile LAS unsigned* st, bool w0) {
    XcdBarrier b; b.w0 = w0; b.bar = bar; b.x = xb_xcc_id(); b.st = st;
    if (b.w0 && xb_lane() == 0) (void)xb_add(&bar[XB_XCNT(b.x)], 1u);
    return b;
}
__device__ __forceinline__ void xcd_barrier_complete(unsigned* bar, unsigned x, unsigned& nloc, unsigned& nx) {
    const unsigned G = gridDim.x * gridDim.y * gridDim.z;
    unsigned sum, cnt, mine, sp = 0u;
    for (;;) {
        sum = 0u; cnt = 0u; mine = 0u;
#pragma unroll
        for (unsigned j = 0; j < 16; ++j) { const unsigned c = xb_ld(&bar[XB_XCNT(j)]); sum += c; cnt += (c > 0u) ? 1u : 0u; mine = (j == x) ? c : mine; }
        if (sum == G) break;
        __builtin_amdgcn_s_sleep(1);
        if ((++sp & 255u) == 0u) { if (xb_ld(&bar[XB_TMO])) break; if (sp > XB_SPIN_CAP) { atomicAdd(&bar[XB_TMO], 1u); break; } }
    }
    nloc = mine > 0u ? mine : 1u; nx = cnt > 0u ? cnt : 1u;
}

__device__ __forceinline__ void xcd_barrier(const XcdBarrier& b) {
    asm volatile("s_waitcnt vmcnt(0)" ::: "memory");
    __syncthreads();
    if (b.w0 && xb_lane() == 0) {
        unsigned* bar = b.bar;
        __builtin_amdgcn_s_waitcnt(0);
        unsigned nloc = b.st[0], nx = b.st[1];
        if (nloc == 0u) { xcd_barrier_complete(bar, b.x, nloc, nx); b.st[0] = nloc; b.st[1] = nx; }
        const unsigned old = xb_add(&bar[XB_XSUB(b.x)], 1u);
        const unsigned gen = old / nloc;
        if (old + 1u == (gen + 1u) * nloc) {
            __builtin_amdgcn_fence(__ATOMIC_RELEASE, "agent");
            asm volatile("s_waitcnt vmcnt(0)" ::: "memory");
            const unsigned og = xb_add(&bar[XB_TOP], 1u);
            const unsigned tg = og / nx;
            if (og + 1u == (tg + 1u) * nx) xb_add(&bar[XB_TOPGEN], 1u);
            else XB_SPIN(xb_ld(&bar[XB_TOPGEN]) == tg, bar);
            __builtin_amdgcn_fence(__ATOMIC_ACQUIRE, "agent");
            xb_add(&bar[XB_XGEN(b.x)], 1u);
            asm volatile("s_waitcnt vmcnt(0)" ::: "memory");
        } else {
            XB_SPIN(xb_ld(&bar[XB_XGEN(b.x)]) == gen, bar);
            __builtin_amdgcn_fence(__ATOMIC_ACQUIRE, "agent");
            asm volatile("s_waitcnt vmcnt(0)" ::: "memory");
        }
    }
    __syncthreads();
}
#define GAS __attribute__((address_space(1)))
#ifndef LAS
#define LAS __attribute__((address_space(3)))
#endif
typedef unsigned short bf16;
typedef unsigned v4u __attribute__((ext_vector_type(4))) __attribute__((may_alias));
typedef unsigned v2u __attribute__((ext_vector_type(2))) __attribute__((may_alias));
typedef float f32x4 __attribute__((ext_vector_type(4))) __attribute__((may_alias));
typedef float f32x2 __attribute__((ext_vector_type(2))) __attribute__((may_alias));
typedef float f32x16 __attribute__((ext_vector_type(16)));
typedef short bf16x8 __attribute__((ext_vector_type(8))) __attribute__((may_alias));
typedef __bf16 bf2_t __attribute__((ext_vector_type(2)));

constexpr int NWAVES = 8, NTHR = 512;
constexpr int NB = 4, SEQ = 8192, NTOK = NB * SEQ, DM = 1024, MEML = 256, NMEM = NB * MEML;
constexpr int EVW = 1792;
constexpr int C_CQ = 0, C_KA = 256, C_VA = 384, C_KI = 512, C_QB = 576, C_KB = 1088, C_WI = 1600;
constexpr int NEXP = 32, TOPK = 4;
constexpr int NROWS_MAX = NTOK * TOPK + NEXP * 256;
constexpr int NRT_MAX = NROWS_MAX / 256;
constexpr float LN_EPS = 1e-5f;
constexpr float DN_ALPHA = 1.4142135623730951f;
constexpr int SCH = 64, NCHUNK = SEQ / SCH;

constexpr size_t MiB = 1u << 20;
constexpr size_t WS_CTL = 0, CTL_ZERO_BYTES = 1 * MiB;
constexpr size_t WS_ROPE = 1 * MiB;
constexpr size_t WS_APOW = 2 * MiB;
constexpr size_t WS_BB = 5 * MiB;
constexpr size_t WS_WTQ = 6 * MiB;
constexpr size_t WS_WTVB = 1536 * MiB;
constexpr size_t WS_WTIN0 = 8 * MiB;
constexpr size_t WS_WTOUT0 = 13 * MiB;
constexpr size_t WS_WTS5IN = 15 * MiB;
constexpr size_t WS_WTS5OUT = 17 * MiB;
constexpr size_t WS_WTXQ = 21 * MiB;
constexpr size_t WS_WTXK = 25 * MiB;
constexpr size_t WS_WTXV = 29 * MiB;
constexpr size_t WS_WTXO = 33 * MiB;
constexpr size_t WS_MEMB = 37 * MiB;
constexpr size_t WS_KX = 39 * MiB;
constexpr size_t WS_VXT = 43 * MiB;
constexpr size_t WS_W1 = 47 * MiB;
constexpr size_t WS_W3 = 63 * MiB;
constexpr size_t WS_KT = 79 * MiB;
constexpr size_t WS_ELOC = 81 * MiB;
constexpr size_t WS_HS = 97 * MiB;
constexpr size_t WS_KI = 105 * MiB;
constexpr size_t WS_KA = 109 * MiB;
constexpr size_t WS_VA = 117 * MiB;
constexpr size_t WS_WI = 125 * MiB;
constexpr size_t WS_TOKE = 126 * MiB;
constexpr size_t WS_TOKP = 127 * MiB;
constexpr size_t WS_WTGU = 128 * MiB;
constexpr size_t WS_WTDN = 384 * MiB;
constexpr size_t WS_XB = 512 * MiB;
constexpr size_t WS_HF = 576 * MiB;
constexpr size_t WS_T = 704 * MiB;
constexpr size_t WS_SCR = 832 * MiB;
constexpr size_t WS_P1 = WS_SCR;
constexpr size_t WS_CQ = WS_SCR + 144 * MiB;
constexpr size_t WS_QAI = WS_SCR + 160 * MiB;
constexpr size_t WS_OAB = WS_SCR + 224 * MiB;
constexpr size_t WS_VBT = WS_SCR + 288 * MiB;
constexpr size_t WS_QX = WS_SCR;
constexpr size_t WS_AX = WS_SCR + 64 * MiB;
constexpr size_t WS_ELIST = WS_SCR + 128 * MiB;
constexpr size_t WS_EGATE = WS_SCR + 132 * MiB;
constexpr size_t WS_RGATE = WS_SCR + 136 * MiB;
constexpr size_t WS_XG = WS_SCR + 144 * MiB;
constexpr size_t WS_ACT = WS_SCR + 416 * MiB;
constexpr size_t WS_U = WS_SCR;
constexpr size_t WS_YG = WS_SCR + 64 * MiB;
constexpr size_t WS_END = WS_SCR + 688 * MiB;
static_assert(WS_END <= (size_t)1536 * MiB && WS_WTVB + 2 * MiB <= (size_t)2047 * MiB, "workspace map");

constexpr int CW_BAR = 4096;
constexpr int CW_CNT = 16384;

constexpr int RING_BYTES = 131072;
constexpr int UP_OFF = RING_BYTES;
constexpr int UP_MISC = UP_OFF;
constexpr int UP_PTR = UP_OFF + 256;
constexpr int UP_SEL = UP_OFF + 1024;
constexpr int UP_TILEE = UP_OFF + 6144;
constexpr int UP_TSTART = UP_TILEE + 576 * 4;
constexpr int UP_CNT = UP_TSTART + 64 * 4;
constexpr int UP_TOK = UP_OFF + 12288;
constexpr int UP_RSCR = UP_OFF + 16384;
constexpr int LDS_BYTES = 163840;
static_assert(UP_CNT + 32 * 4 <= LDS_BYTES && UP_RSCR + 16384 <= LDS_BYTES, "LDS map");

#define LDS_WAIT() asm volatile("s_waitcnt lgkmcnt(0)" ::: "memory")
#define VM_WAIT() asm volatile("s_waitcnt vmcnt(0)" ::: "memory")
__device__ __forceinline__ unsigned f2bf(float f) { unsigned u = __builtin_bit_cast(unsigned, f); return (u + 0x7fffu + ((u >> 16) & 1u)) >> 16; }
typedef __bf16 bf2cv_t __attribute__((ext_vector_type(2)));
__device__ __forceinline__ unsigned pk2(float lo, float hi) { typedef float f2_t __attribute__((ext_vector_type(2))); const f2_t v = {lo, hi}; return __builtin_bit_cast(unsigned, __builtin_convertvector(v, bf2cv_t)); }
__device__ __forceinline__ float bflo(unsigned w) { return __builtin_bit_cast(float, w << 16); }
__device__ __forceinline__ float bfhi(unsigned w) { return __builtin_bit_cast(float, w & 0xffff0000u); }
__device__ __forceinline__ float bf2f(bf16 h) { return __builtin_bit_cast(float, (unsigned)h << 16); }
__device__ __forceinline__ float dot2bf(unsigned a, unsigned b, float c) { return __builtin_amdgcn_fdot2_f32_bf16(__builtin_bit_cast(bf2_t, a), __builtin_bit_cast(bf2_t, b), c, false); }
__device__ __forceinline__ float dot8bf(v4u a, v4u b, float c) { c = dot2bf(a.x, b.x, c); c = dot2bf(a.y, b.y, c); c = dot2bf(a.z, b.z, c); return dot2bf(a.w, b.w, c); }
__device__ __forceinline__ float shx(float v, int o, int lane) { return __builtin_bit_cast(float, __builtin_amdgcn_ds_bpermute((lane ^ o) << 2, __builtin_bit_cast(int, v))); }
__device__ __forceinline__ int shxi(int v, int o, int lane) { return __builtin_amdgcn_ds_bpermute((lane ^ o) << 2, v); }
__device__ __forceinline__ float wave_sum(float v, int lane) {
#pragma unroll
    for (int o = 1; o < 64; o <<= 1) v += shx(v, o, lane);
    return v;
}
__device__ __forceinline__ float wave_max(float v, int lane) {
#pragma unroll
    for (int o = 1; o < 64; o <<= 1) v = fmaxf(v, shx(v, o, lane));
    return v;
}
__device__ __forceinline__ int wave_sum_i(int v, int lane) {
#pragma unroll
    for (int o = 1; o < 64; o <<= 1) v += shxi(v, o, lane);
    return v;
}
__device__ __forceinline__ int crow(int r, int hf) { return (r & 3) + 8 * (r >> 2) + 4 * hf; }
__device__ __forceinline__ int rperm(int j) { return j < 16 ? ((j & 1) ? 8 + (j >> 1) : (j >> 1)) : j; }

struct Frame {
    LAS unsigned char* lds;
    int tid, lane, wave, vcu, G;
    float* out;
    unsigned char* ws;
};
__device__ __forceinline__ Frame pframe(const Frame& F) {
    Frame P = F;
    { int l; asm volatile("v_mbcnt_lo_u32_b32 %0, -1, 0\n\tv_mbcnt_hi_u32_b32 %0, -1, %0" : "=v"(l)); P.tid = P.wave * 64 + l; }
    asm volatile("" : "+s"(P.ws), "+s"(P.out), "+v"(P.tid), "+s"(P.vcu), "+s"(P.G));
    P.lane = P.tid & 63;
    return P;
}
__device__ __forceinline__ const float* inp(const Frame& F, int i) {
    const unsigned long long p = *(const LAS unsigned long long*)(F.lds + UP_PTR + 8 * i);
    const unsigned lo = (unsigned)__builtin_amdgcn_readfirstlane((int)(unsigned)p), hi = (unsigned)__builtin_amdgcn_readfirstlane((int)(unsigned)(p >> 32));
    return (const float*)(((unsigned long long)hi << 32) | lo);
}
template <class T> __device__ __forceinline__ T* wsp(const Frame& F, size_t off) { return (T*)(F.ws + off); }

namespace pg8 {
struct EpiRope {
    static constexpr bool PERM = true, AFTER_DRAIN = false;
    bf16_t* O; int ldc; const f32x2* rope;
    __device__ __forceinline__ void operator()(const f32x4 (&acc)[2][2][4][2], const Unit& u, int wr, int wc, int fr, int fq) const {
        const int row0 = u.pm * BM + wr * 64 + fr; const int col0 = u.pn * BM + wc * 32 + 8 * fq;
#pragma unroll
        for (int ai = 0; ai < 2; ++ai)
#pragma unroll
            for (int m = 0; m < 4; ++m) { const int row = row0 + ai * HALF + m * 16; const int pos = row & (SEQ - 1); bf16_t* rowp = O + (size_t)row * ldc + col0;
#pragma unroll
                for (int bj = 0; bj < 2; ++bj) { f32x4 v0 = acc[ai][bj][m][0], v1 = acc[ai][bj][m][1];
                    const int c64 = (col0 + bj * HALF) & 63;
                    if (c64 < 16) { const f32x2* rp = rope + pos * 8 + (c64 >> 1);
                        const f32x2 r0 = rp[0], r1 = rp[1], r2 = rp[2], r3 = rp[3];
                        f32x4 w0, w1;
                        w0[0] = v0[0] * r0.x - v0[1] * r0.y; w0[1] = v0[1] * r0.x + v0[0] * r0.y;
                        w0[2] = v0[2] * r1.x - v0[3] * r1.y; w0[3] = v0[3] * r1.x + v0[2] * r1.y;
                        w1[0] = v1[0] * r2.x - v1[1] * r2.y; w1[1] = v1[1] * r2.x + v1[0] * r2.y;
                        w1[2] = v1[2] * r3.x - v1[3] * r3.y; w1[3] = v1[3] * r3.x + v1[2] * r3.y;
                        v0 = w0; v1 = w1; }
                    u32x4 w; w.x = cvt_pk_bf16(v0[0], v0[1]); w.y = cvt_pk_bf16(v0[2], v0[3]); w.z = cvt_pk_bf16(v1[0], v1[1]); w.w = cvt_pk_bf16(v1[2], v1[3]);
                    *(u32x4*)(rowp + bj * HALF) = w; } }
    }
};
struct EpiVT {
    static constexpr bool PERM = true, AFTER_DRAIN = false;
    bf16_t* O; int nrows;
    __device__ __forceinline__ void operator()(const f32x4 (&acc)[2][2][4][2], const Unit& u, int wr, int wc, int fr, int fq) const {
        const int row0 = u.pm * BM + wr * 64 + fr; const int col0 = u.pn * BM + wc * 32 + 8 * fq;
#pragma unroll
        for (int ai = 0; ai < 2; ++ai)
#pragma unroll
            for (int m = 0; m < 4; ++m) { const int row = row0 + ai * HALF + m * 16;
#pragma unroll
                for (int bj = 0; bj < 2; ++bj) { const int col = col0 + bj * HALF; const f32x4 v0 = acc[ai][bj][m][0], v1 = acc[ai][bj][m][1];
                    u32x4 w; w.x = cvt_pk_bf16(v0[0], v0[1]); w.y = cvt_pk_bf16(v0[2], v0[3]); w.z = cvt_pk_bf16(v1[0], v1[1]); w.w = cvt_pk_bf16(v1[2], v1[3]);
                    *(u32x4*)(O + ((size_t)(col >> 5) * nrows + row) * 32 + (col & 31)) = w; } }
    }
};
struct EpiResF32 {
    static constexpr bool PERM = false, AFTER_DRAIN = false;
    const float* R; float* T; int ldc; float alpha;
    __device__ __forceinline__ void operator()(const f32x4 (&acc)[2][2][4][2], const Unit& u, int wr, int wc, int fr, int fq) const {
        const int row0 = u.pm * BM + wr * 64 + fr; const int col0 = u.pn * BM + wc * 32 + 4 * fq;
#pragma unroll
        for (int ai = 0; ai < 2; ++ai)
#pragma unroll
            for (int m = 0; m < 4; ++m) { const size_t off = (size_t)(row0 + ai * HALF + m * 16) * ldc + col0;
#pragma unroll
                for (int bj = 0; bj < 2; ++bj)
#pragma unroll
                    for (int n = 0; n < 2; ++n) { const f32x4 r = *(const f32x4*)(R + off + bj * HALF + n * 16); *(f32x4*)(T + off + bj * HALF + n * 16) = r * alpha + acc[ai][bj][m][n]; } }
    }
};
struct EpiGluRes {
    static constexpr bool PERM = false, AFTER_DRAIN = false;
    const float* R; float* T; int ldc; float alpha;
    __device__ __forceinline__ void operator()(const f32x4 (&acc)[2][2][4][2], const Unit& u, int wr, int wc, int fr, int fq) const {
        const int row0 = u.pm * BM + wr * 64 + fr; const int col0 = u.pn * HALF + wc * 32 + 4 * fq;
#pragma unroll
        for (int ai = 0; ai < 2; ++ai)
#pragma unroll
            for (int m = 0; m < 4; ++m) { const size_t off = (size_t)(row0 + ai * HALF + m * 16) * ldc + col0;
#pragma unroll
                for (int n = 0; n < 2; ++n) { const f32x4 r = *(const f32x4*)(R + off + n * 16); const f32x4 v = acc[ai][0][m][n], g = acc[ai][1][m][n]; f32x4 o;
#pragma unroll
                    for (int i = 0; i < 4; ++i) o[i] = r[i] * alpha + v[i] * __builtin_amdgcn_rcpf(1.0f + __expf(-g[i]));
                    *(f32x4*)(T + off + n * 16) = o; } }
    }
};
struct EpiSwiGlu {
    static constexpr bool PERM = true, AFTER_DRAIN = false;
    bf16_t* O; const float* bgu;
    __device__ __forceinline__ void operator()(const f32x4 (&acc)[2][2][4][2], const Unit& u, int wr, int wc, int fr, int fq) const {
        const int e = u.pn >> 3, ct = u.pn & 7; const int row0 = u.pm * BM + wr * 64 + fr; const int col0 = ct * HALF + wc * 32 + 8 * fq;
        const float* bg = bgu + (size_t)e * 2048 + col0; const float* bu = bg + 1024;
        f32x4 g0 = *(const f32x4*)bg, g1 = *(const f32x4*)(bg + 4), u0 = *(const f32x4*)bu, u1 = *(const f32x4*)(bu + 4);
#pragma unroll
        for (int ai = 0; ai < 2; ++ai)
#pragma unroll
            for (int m = 0; m < 4; ++m) { bf16_t* rowp = O + (size_t)(row0 + ai * HALF + m * 16) * 1024 + col0;
                f32x4 a0 = acc[ai][0][m][0] + g0, a1 = acc[ai][0][m][1] + g1, b0 = acc[ai][1][m][0] + u0, b1 = acc[ai][1][m][1] + u1; float o[8];
#pragma unroll
                for (int i = 0; i < 4; ++i) { float g = fminf(a0[i], 7.0f), up = fminf(fmaxf(b0[i], -7.0f), 7.0f); o[i] = g * __builtin_amdgcn_rcpf(1.0f + __expf(-1.702f * g)) * (up + 1.0f);
                    g = fminf(a1[i], 7.0f); up = fminf(fmaxf(b1[i], -7.0f), 7.0f); o[4 + i] = g * __builtin_amdgcn_rcpf(1.0f + __expf(-1.702f * g)) * (up + 1.0f); }
                u32x4 w; w.x = cvt_pk_bf16(o[0], o[1]); w.y = cvt_pk_bf16(o[2], o[3]); w.z = cvt_pk_bf16(o[4], o[5]); w.w = cvt_pk_bf16(o[6], o[7]);
                *(u32x4*)rowp = w; }
    }
};
struct EpiDown {
    static constexpr bool PERM = true, AFTER_DRAIN = false;
    bf16_t* O; const float* bdn; const float* egate; const PG8_LAS int* tstart; const PG8_LAS int* cnt;
    __device__ __forceinline__ void operator()(const f32x4 (&acc)[2][2][4][2], const Unit& u, int wr, int wc, int fr, int fq) const {
        const int e = u.pn >> 2, ct = u.pn & 3; const int row0 = u.pm * BM + wr * 64 + fr; const int col0 = ct * BM + wc * 32 + 8 * fq;
        const int pos0 = (u.pm - tstart[e]) * BM + wr * 64 + fr, ne = cnt[e]; const float* gp = egate + (size_t)e * NTOK;
        const float* bp = bdn + (size_t)e * 1024 + col0;
        f32x4 bv[2][2];
#pragma unroll
        for (int bj = 0; bj < 2; ++bj)
#pragma unroll
            for (int n = 0; n < 2; ++n) bv[bj][n] = *(const f32x4*)(bp + bj * HALF + 4 * n);
#pragma unroll
        for (int ai = 0; ai < 2; ++ai)
#pragma unroll
            for (int m = 0; m < 4; ++m) { const int row = row0 + ai * HALF + m * 16; const int pos = pos0 + ai * HALF + m * 16; const float gt = (pos < ne) ? gp[pos] : 0.f; bf16_t* rowp = O + (size_t)row * 1024 + col0;
#pragma unroll
                for (int bj = 0; bj < 2; ++bj) { const f32x4 v0 = (acc[ai][bj][m][0] + bv[bj][0]) * gt, v1 = (acc[ai][bj][m][1] + bv[bj][1]) * gt;
                    u32x4 w; w.x = cvt_pk_bf16(v0[0], v0[1]); w.y = cvt_pk_bf16(v0[2], v0[3]); w.z = cvt_pk_bf16(v1[0], v1[1]); w.w = cvt_pk_bf16(v1[2], v1[3]);
                    *(u32x4*)(rowp + bj * HALF) = w; } }
    }
};
template <int NCT> struct MoeRows {
    const int* elist; const PG8_LAS int* tstart; const PG8_LAS int* cnt; PG8_LAS int* tab;
    __device__ __forceinline__ void prefetch(const Unit& u, int slot, int wid, int lane) const {
        if (wid == 0) { const int e = u.pn / NCT, pos0 = (u.pm - tstart[e]) * BM;
            __builtin_amdgcn_global_load_lds((const unsigned*)(elist + (size_t)e * NTOK + pos0 + 4 * lane), (PG8_LAS unsigned*)(tab + slot * BM), 16, 0, 0); } }
    __device__ __forceinline__ size_t kstep() const { return (size_t)(BK * 2); }
    __device__ __forceinline__ unsigned off(const Unit& u, int slot, int row, int C, int K) const {
        const int e = u.pn / NCT, pos = (u.pm - tstart[e]) * BM + row; const int t = tab[slot * BM + row]; const int tok = (pos < cnt[e]) ? t : 0;
        return (unsigned)(tok * K + C) * 2u; }
};
struct BlkRows {
    __device__ __forceinline__ void prefetch(const Unit&, int, int, int) const {}
    __device__ __forceinline__ size_t kstep() const { return (size_t)4 * NTOK * 32; }
    __device__ __forceinline__ unsigned off(const Unit& u, int, int row, int C, int) const { return (unsigned)((((C >> 4) * NTOK + u.pm * BM + row) * 16 + (C & 15)) * 2); }
};
struct EpiBlk {
    static constexpr bool PERM = true, AFTER_DRAIN = false;
    bf16_t* O;
    __device__ __forceinline__ void operator()(const f32x4 (&acc)[2][2][4][2], const Unit& u, int wr, int wc, int fr, int fq) const {
        const int row0 = u.pm * BM + wr * 64 + fr; const int col0 = u.pn * BM + wc * 32 + 8 * fq;
#pragma unroll
        for (int ai = 0; ai < 2; ++ai)
#pragma unroll
            for (int m = 0; m < 4; ++m) { const int row = row0 + ai * HALF + m * 16;
#pragma unroll
                for (int bj = 0; bj < 2; ++bj) { const int col = col0 + bj * HALF; const f32x4 v0 = acc[ai][bj][m][0], v1 = acc[ai][bj][m][1];
                    u32x4 w; w.x = cvt_pk_bf16(v0[0], v0[1]); w.y = cvt_pk_bf16(v0[2], v0[3]); w.z = cvt_pk_bf16(v1[0], v1[1]); w.w = cvt_pk_bf16(v1[2], v1[3]);
                    *(u32x4*)(O + ((size_t)(col >> 4) * NTOK + row) * 16 + (col & 15)) = w; } }
    }
};
template <int NCT> struct MoeOrder {
    const PG8_LAS int* tile_e; int nrt, G, vc;
    __device__ __forceinline__ bool next(int i, Unit& u) const {
        const int L = i * G + vc; const int rt = L / NCT, ct = L % NCT; if (rt >= nrt) return false;
        u.pm = rt; u.pn = __builtin_amdgcn_readfirstlane(tile_e[rt]) * NCT + ct; return true;
    }
    __device__ __forceinline__ void a_ready(const Unit&) const {}
    __device__ __forceinline__ void done(const Unit&) const {}
};
}
__device__ __forceinline__ int map_col(int id, int r) {
    switch (id) {
    default: return r;
    case 1: {
        if (r < 256) return r;
        if (r < 384) { const int q = r - 256; return 256 + (q & ~63) + rperm(q & 63); }
        if (r < 576) return r;
        if (r < 1088) return 584 + (r - 576);
        if (r < 1600) return 1096 + (r - 1088);
        if (r < 1608) return 576 + (r - 1600);
        return -1; }
    case 2: return (r & ~63) + rperm(r & 63);
    case 3: { const int t = r >> 8, w = r & 255; return w < 128 ? 128 * t + w : 1024 + 128 * t + (w - 128); }
    case 4: return 1024 + r;
    case 5: return r < 512 ? 1608 + r : (r < 640 ? 384 + (r - 512) : -1);
    }
}
__device__ __forceinline__ void tr_item(const float* W, int K, int Nsrc, bf16* WT, LAS float* scr, int kb, int nb, int lane, int mapid, float scale) {
    const int k0 = 64 * kb, n0 = 32 * nb;
    const int sc = map_col(mapid, n0 + (lane & 31));
#pragma unroll 8
    for (int i = 0; i < 32; ++i) { const int kk = 2 * i + (lane >> 5); scr[kk * 33 + (lane & 31)] = (sc >= 0) ? W[(size_t)(k0 + kk) * Nsrc + sc] * scale : 0.f; }
    LDS_WAIT(); asm volatile("" ::: "memory");
    const int c = lane & 7;
#pragma unroll
    for (int j = 0; j < 4; ++j) { const int n = (lane >> 3) + 8 * j; const LAS float* s = scr + (8 * c) * 33 + n;
        v4u o; o.x = pk2(s[0 * 33], s[1 * 33]); o.y = pk2(s[2 * 33], s[3 * 33]); o.z = pk2(s[4 * 33], s[5 * 33]); o.w = pk2(s[6 * 33], s[7 * 33]);
        *(v4u*)(WT + (size_t)(n0 + n) * K + k0 + 8 * c) = o; }
    LDS_WAIT(); asm volatile("" ::: "memory");
}
__device__ __forceinline__ void tr_load_v4(f32x4 (&v)[8], const float* W, int Nsrc, int kb, int nb, int lane, int mapid) {
    const int k0 = 64 * kb, n0 = 32 * nb, n4 = 4 * (lane & 7); const int sc = map_col(mapid, n0 + n4);
#pragma unroll
    for (int i = 0; i < 8; ++i) v[i] = (sc >= 0) ? *(const f32x4*)(W + (size_t)(k0 + 8 * i + (lane >> 3)) * Nsrc + sc) : (f32x4){0.f, 0.f, 0.f, 0.f};
}
__device__ __forceinline__ void tr_item_v4(const f32x4 (&v)[8], int K, bf16* WT, LAS float* scr, int kb, int nb, int lane, float scale) {
    const int k0 = 64 * kb, n0 = 32 * nb, n4 = 4 * (lane & 7);
#pragma unroll
    for (int i = 0; i < 8; ++i) { LAS float* d = scr + (8 * i + (lane >> 3)) * 33 + n4; d[0] = v[i][0] * scale; d[1] = v[i][1] * scale; d[2] = v[i][2] * scale; d[3] = v[i][3] * scale; }
    LDS_WAIT(); asm volatile("" ::: "memory");
    const int c = lane & 7;
#pragma unroll
    for (int j = 0; j < 4; ++j) { const int n = (lane >> 3) + 8 * j; const LAS float* s = scr + (8 * c) * 33 + n;
        v4u o; o.x = pk2(s[0 * 33], s[1 * 33]); o.y = pk2(s[2 * 33], s[3 * 33]); o.z = pk2(s[4 * 33], s[5 * 33]); o.w = pk2(s[6 * 33], s[7 * 33]);
        *(v4u*)(WT + (size_t)(n0 + n) * K + k0 + 8 * c) = o; }
    LDS_WAIT(); asm volatile("" ::: "memory");
}
struct TrJob { const float* src; bf16* dst; int K, Nsrc, Ndst, batch, mapid; float scale; };
__device__ __forceinline__ TrJob tr_job(const Frame& F, int j) {
    TrJob t; t.batch = 1; t.mapid = 0; t.scale = 1.f; t.K = 1024; t.Nsrc = 1024; t.Ndst = 1024;
    switch (j) {
    case 0: t.src = inp(F, 2); t.dst = wsp<bf16>(F, WS_WTIN0); t.Nsrc = 2120; t.Ndst = EVW; t.mapid = 1; break;
    case 1: t.src = inp(F, 4); t.dst = wsp<bf16>(F, WS_WTQ); t.K = 256; t.Nsrc = 512; t.Ndst = 512; t.mapid = 2; t.scale = 0.125f; break;
    case 2: t.src = inp(F, 5); t.dst = wsp<bf16>(F, WS_WTQ) + 512 * 256; t.K = 256; t.Nsrc = 512; t.Ndst = 512; t.mapid = 2; t.scale = 0.125f; break;
    case 3: t.src = inp(F, 8); t.dst = wsp<bf16>(F, WS_WTOUT0); break;
    case 4: t.src = inp(F, 9); t.dst = wsp<bf16>(F, WS_WTS5IN); break;
    case 5: t.src = inp(F, 18); t.dst = wsp<bf16>(F, WS_WTS5OUT); t.Nsrc = 2048; t.Ndst = 2048; t.mapid = 3; break;
    case 6: t.src = inp(F, 21); t.dst = wsp<bf16>(F, WS_WTXQ); t.batch = 2; t.scale = 0.0625f; break;
    case 7: t.src = inp(F, 22); t.dst = wsp<bf16>(F, WS_WTXK); t.Nsrc = 2048; t.batch = 2; break;
    case 8: t.src = inp(F, 22); t.dst = wsp<bf16>(F, WS_WTXV); t.Nsrc = 2048; t.batch = 2; t.mapid = 4; break;
    case 9: t.src = inp(F, 23); t.dst = wsp<bf16>(F, WS_WTXO); t.batch = 2; break;
    case 10: t.src = inp(F, 28); t.dst = wsp<bf16>(F, WS_WTGU); t.Nsrc = 2048; t.Ndst = 2048; t.mapid = 3; t.batch = 64; break;
    case 11: t.src = inp(F, 30); t.dst = wsp<bf16>(F, WS_WTDN); t.batch = 64; break;
    default: t.src = inp(F, 2); t.dst = wsp<bf16>(F, WS_WTVB); t.Nsrc = 2120; t.Ndst = 512; t.mapid = 5; break;
    }
    return t;
}
__device__ __forceinline__ void p0_prologue(const Frame& F) {
    LAS float* scr = (LAS float*)(F.lds + F.wave * 16384);
    const int gw = F.vcu * NWAVES + F.wave, NGW = F.G * NWAVES;
    for (int j = 12; j >= 0; --j) {
        const TrJob t = tr_job(F, j);
        const int nkb = t.K / 64, nnb = t.Ndst / 32, per = nkb * nnb, total = per * t.batch;
        if (t.mapid == 1 || t.mapid == 2) for (int it = gw; it < total; it += NGW) {
            const int bi = it / per, r = it - bi * per, kb = r / nnb, nb = r - kb * nnb;
            if (t.mapid == 1 || t.mapid == 2) tr_item(t.src + (size_t)bi * t.K * t.Nsrc, t.K, t.Nsrc, t.dst + (size_t)bi * t.Ndst * t.K, scr, kb, nb, F.lane, t.mapid, t.scale);
        }
        if (!(t.mapid == 1 || t.mapid == 2)) {
            f32x4 vc[8], vn[8]; int it = gw;
            if (it < total) { const int bi = it / per, r = it - bi * per, kb = r / nnb, nb = r - kb * nnb; tr_load_v4(vc, t.src + (size_t)bi * t.K * t.Nsrc, t.Nsrc, kb, nb, F.lane, t.mapid); }
            for (; it < total; it += NGW) {
                const int bi = it / per, r = it - bi * per, kb = r / nnb, nb = r - kb * nnb; const int itn = it + NGW;
                if (itn < total) { const int bi2 = itn / per, r2 = itn - bi2 * per, kb2 = r2 / nnb, nb2 = r2 - kb2 * nnb; tr_load_v4(vn, t.src + (size_t)bi2 * t.K * t.Nsrc, t.Nsrc, kb2, nb2, F.lane, t.mapid); }
                tr_item_v4(vc, t.K, t.dst + (size_t)bi * t.Ndst * t.K, scr, kb, nb, F.lane, t.scale);
#pragma unroll
                for (int i = 0; i < 8; ++i) vc[i] = vn[i];
            }
        }
    }
    const int gt = F.vcu * NTHR + F.tid, NGT = F.G * NTHR;
    { const float* x = inp(F, 0); bf16* xb = wsp<bf16>(F, WS_XB);
      for (int i = gt; i < NTOK * DM / 8; i += NGT) { const f32x4 a = *(const f32x4*)(x + (size_t)i * 8), b = *(const f32x4*)(x + (size_t)i * 8 + 4);
          v4u o; o.x = pk2(a[0], a[1]); o.y = pk2(a[2], a[3]); o.z = pk2(b[0], b[1]); o.w = pk2(b[2], b[3]); *(v4u*)(xb + (size_t)i * 8) = o; }
      const float* mm = inp(F, 1); bf16* mb = wsp<bf16>(F, WS_MEMB);
      for (int i = gt; i < NMEM * DM / 8; i += NGT) { const f32x4 a = *(const f32x4*)(mm + (size_t)i * 8), b = *(const f32x4*)(mm + (size_t)i * 8 + 4);
          v4u o; o.x = pk2(a[0], a[1]); o.y = pk2(a[2], a[3]); o.z = pk2(b[0], b[1]); o.w = pk2(b[2], b[3]); *(v4u*)(mb + (size_t)i * 8) = o; } }
    { f32x2* rope = wsp<f32x2>(F, WS_ROPE);
      for (int i = gt; i < SEQ * 8; i += NGT) { const int pos = i >> 3, k = i & 7; const float inv = (float)pow(500000.0, -(double)k / 8.0); const float ang = (float)pos * inv;
          rope[i] = (f32x2){(float)cos((double)ang), (float)sin((double)ang)}; } }
    { const float* log_dt = inp(F, 10); const float* lre = inp(F, 11); const float* lim = inp(F, 12); const float* bre = inp(F, 13); const float* bim = inp(F, 14);
      f32x2* apow = wsp<f32x2>(F, WS_APOW); f32x2* bb = wsp<f32x2>(F, WS_BB);
      for (int i = gt; i < 64 * 64 * 65; i += NGT) { const int gp = i / 65, k = i - gp * 65, g = gp >> 6;
          const double dt = exp((double)log_dt[g]), lr = lre[gp], li = lim[gp]; const double mag = exp(lr * dt * k), ang = li * dt * k;
          apow[i] = (f32x2){(float)(mag * cos(ang)), (float)(mag * sin(ang))}; }
      for (int i = gt; i < 64 * 64 * 16; i += NGT) { const int gp = i >> 4, g = gp >> 6;
          const double dt = exp((double)log_dt[g]), lr = lre[gp], li = lim[gp]; const double mag = exp(lr * dt), ar = mag * cos(li * dt), ai = mag * sin(li * dt);
          const double den = lr * lr + li * li, cr = ((ar - 1.0) * lr + ai * li) / den, ci = (ai * lr - (ar - 1.0) * li) / den; const double br = bre[i], bi = bim[i];
          bb[i] = (f32x2){(float)(cr * br - ci * bi), (float)(cr * bi + ci * br)}; } }
}

__device__ __forceinline__ void ln_row_store(const Frame& F, f32x4 (&v)[4], const float* g, const float* b, float* dstF, bf16* dstB) {
    float s = 0.f;
#pragma unroll
    for (int j = 0; j < 4; ++j) s += (v[j][0] + v[j][1]) + (v[j][2] + v[j][3]);
    const float mean = wave_sum(s, F.lane) * (1.f / DM); float s2 = 0.f;
#pragma unroll
    for (int j = 0; j < 4; ++j) { v[j] = v[j] - mean; s2 += (v[j][0] * v[j][0] + v[j][1] * v[j][1]) + (v[j][2] * v[j][2] + v[j][3] * v[j][3]); }
    const float rstd = 1.f / sqrtf(wave_sum(s2, F.lane) * (1.f / DM) + LN_EPS);
#pragma unroll
    for (int j = 0; j < 4; ++j) { const int c = 4 * F.lane + 256 * j; const f32x4 gg = *(const f32x4*)(g + c), bv = *(const f32x4*)(b + c);
        const f32x4 o = v[j] * rstd * gg + bv; *(f32x4*)(dstF + c) = o;
        v2u w; w.x = pk2(o[0], o[1]); w.y = pk2(o[2], o[3]); *(v2u*)(dstB + c) = w; }
}
__device__ __forceinline__ void ln_phase(const Frame& F, const float* T, const float* g, const float* b, float* dstF, bf16* dstB) {
    const int gw = F.vcu * NWAVES + F.wave, NGW = F.G * NWAVES;
    for (int m0 = gw; m0 < NTOK; m0 += 4 * NGW) { f32x4 v[4][4];
#pragma unroll
        for (int q = 0; q < 4; ++q) { const int m = m0 + q * NGW;
#pragma unroll
            for (int j = 0; j < 4; ++j) v[q][j] = (m < NTOK) ? *(const f32x4*)(T + (size_t)m * DM + 4 * F.lane + 256 * j) : (f32x4){0.f, 0.f, 0.f, 0.f}; }
#pragma unroll
        for (int q = 0; q < 4; ++q) { const int m = m0 + q * NGW; if (m < NTOK) ln_row_store(F, v[q], g, b, dstF + (size_t)m * DM, dstB + (size_t)m * DM); } }
}

__device__ __forceinline__ void p2_postproc(const Frame& F) {
    const int gw = F.vcu * NWAVES + F.wave, NGW = F.G * NWAVES, lane = F.lane;
    const bf16* P1 = wsp<bf16>(F, WS_P1); bf16* CQ = wsp<bf16>(F, WS_CQ); bf16* KI = wsp<bf16>(F, WS_KI); bf16* KA = wsp<bf16>(F, WS_KA); bf16* VA = wsp<bf16>(F, WS_VA);
    float* WI = wsp<float>(F, WS_WI); const f32x2* rope = wsp<f32x2>(F, WS_ROPE);
    const float* qg = inp(F, 3); const float* kg = inp(F, 6); const float* kb = inp(F, 7);
    const f32x4 qg4 = *(const f32x4*)(qg + 4 * lane); const float kgl = kg[lane], kbl = kb[lane];
    for (int tok = gw; tok < NTOK; tok += NGW) {
        const bf16* row = P1 + (size_t)tok * EVW; const int pos = tok & (SEQ - 1);
        { const v2u w = *(const v2u*)(row + C_CQ + 4 * lane); float v0 = bflo(w.x), v1 = bfhi(w.x), v2 = bflo(w.y), v3 = bfhi(w.y);
          const float ss = wave_sum(v0 * v0 + v1 * v1 + v2 * v2 + v3 * v3, lane); const float rs = 1.f / sqrtf(ss * (1.f / 256.f) + LN_EPS);
          v2u o; o.x = pk2(v0 * rs * qg4[0], v1 * rs * qg4[1]); o.y = pk2(v2 * rs * qg4[2], v3 * rs * qg4[3]); *(v2u*)(CQ + (size_t)tok * 256 + 4 * lane) = o; }
        { const float v = bf2f(row[C_KI + lane]); const float mean = wave_sum(v, lane) * (1.f / 64.f); const float d = v - mean; const float var = wave_sum(d * d, lane) * (1.f / 64.f);
          const float y = d * (1.f / sqrtf(var + LN_EPS)) * kgl + kbl; const float partner = shx(y, 8, lane);
          float o = y; int dst = lane;
          if (lane < 16) { const int i = lane & 7; const f32x2 cs = rope[pos * 8 + i];
              if (lane < 8) { o = y * cs.x - partner * cs.y; dst = 2 * lane; } else { o = y * cs.x + partner * cs.y; dst = 2 * (lane - 8) + 1; } }
          KI[(size_t)tok * 64 + dst] = (bf16)f2bf(o); }
        { const unsigned w = *(const unsigned*)(row + C_KA + 2 * lane); float t1 = bflo(w), t2 = bfhi(w); const int j = (2 * lane) & 63;
          if (j < 16) { const f32x2 cs = rope[pos * 8 + (j >> 1)]; const float a = t1 * cs.x - t2 * cs.y, b = t2 * cs.x + t1 * cs.y; t1 = a; t2 = b; }
          *(unsigned*)(KA + (size_t)tok * 128 + 2 * lane) = pk2(t1, t2);
          *(unsigned*)(VA + (size_t)tok * 128 + 2 * lane) = *(const unsigned*)(row + C_VA + 2 * lane); }
        if (lane < 8) WI[(size_t)tok * 8 + lane] = bf2f(row[C_WI + lane]) * 0.35355339059327373f;
    }
    const int gt = F.vcu * NTHR + F.tid, NGT = F.G * NTHR;
    const f32x2* apow = wsp<f32x2>(F, WS_APOW); const f32x2* bb = wsp<f32x2>(F, WS_BB);
    const float* cre = inp(F, 15); const float* cim = inp(F, 16);
    bf16* W1 = wsp<bf16>(F, WS_W1); bf16* W3 = wsp<bf16>(F, WS_W3); bf16* KT = wsp<bf16>(F, WS_KT);
    for (int i = gt; i < 64 * 128 * 1024 / 8; i += NGT) { const int e0 = i * 8, g = e0 >> 17, rem = e0 & 131071, rp = rem >> 10, k = rem & 1023, ri = rp >> 6, p = rp & 63, s = k >> 4, c0 = k & 15;
        const f32x2 a = apow[(g * 64 + p) * 65 + (63 - s)]; float o[8];
#pragma unroll
        for (int q = 0; q < 8; ++q) { const f32x2 b = bb[(g * 64 + p) * 16 + c0 + q]; o[q] = ri == 0 ? a.x * b.x - a.y * b.y : a.x * b.y + a.y * b.x; }
        v4u w; w.x = pk2(o[0], o[1]); w.y = pk2(o[2], o[3]); w.z = pk2(o[4], o[5]); w.w = pk2(o[6], o[7]); *(v4u*)(W1 + (size_t)e0) = w; }
    for (int i = gt; i < 64 * 1024 * 128 / 8; i += NGT) { const int e0 = i * 8, g = e0 >> 17, rem = e0 & 131071, tc = rem >> 7, k = rem & 127, t = tc >> 4, c = tc & 15, ri = k >> 6, p0 = k & 63; float o[8];
#pragma unroll
        for (int q = 0; q < 8; ++q) { const int p = p0 + q; const f32x2 a = apow[(g * 64 + p) * 65 + (t + 1)]; const float cr = cre[(g * 16 + c) * 64 + p], ci = cim[(g * 16 + c) * 64 + p];
            o[q] = ri == 0 ? cr * a.x - ci * a.y : -(cr * a.y + ci * a.x); }
        v4u w; w.x = pk2(o[0], o[1]); w.y = pk2(o[2], o[3]); w.z = pk2(o[4], o[5]); w.w = pk2(o[6], o[7]); *(v4u*)(W3 + (size_t)e0) = w; }
    for (int i = gt; i < 64 * 64 * 256; i += NGT) { const int g = i >> 14, tau = (i >> 8) & 63, c = (i >> 4) & 15, c2 = i & 15; float acc = 0.f;
        for (int p = 0; p < 64; ++p) { const f32x2 a = apow[(g * 64 + p) * 65 + tau]; const float cr = cre[(g * 16 + c) * 64 + p], ci = cim[(g * 16 + c) * 64 + p]; const f32x2 b = bb[(g * 64 + p) * 16 + c2];
            const float xr = cr * a.x - ci * a.y, xi = cr * a.y + ci * a.x; acc += xr * b.x - xi * b.y; }
        KT[i] = (bf16)f2bf(acc); }
}

__device__ __forceinline__ unsigned rope1(unsigned w, f32x2 cs) { const float t1 = bflo(w), t2 = bfhi(w); return pk2(t1 * cs.x - t2 * cs.y, t2 * cs.x + t1 * cs.y); }
__device__ __forceinline__ bf16x8 rope8(bf16x8 f, const f32x2* cs) { v4u w = __builtin_bit_cast(v4u, f); w.x = rope1(w.x, cs[0]); w.y = rope1(w.y, cs[1]); w.z = rope1(w.z, cs[2]); w.w = rope1(w.w, cs[3]); return __builtin_bit_cast(bf16x8, w); }
__device__ __forceinline__ unsigned f16key(float s) {
    const _Float16 h = (_Float16)s; unsigned u = (unsigned)__builtin_bit_cast(unsigned short, h);
    return (u & 0x8000u) ? (~u & 0xffffu) : (u | 0x8000u);
}
constexpr int UP_H1 = UP_OFF + 1024;
constexpr int UP_H2 = UP_H1 + 4096;
constexpr int UP_PAR = UP_H2 + 4096;
constexpr int UP_ML = UP_PAR + 256;
static_assert(UP_ML + 8 * 32 * 2 * 4 <= LDS_BYTES, "DSA LDS map");
__device__ __forceinline__ void pk_count(unsigned& acc, unsigned w, unsigned xm2, unsigned one2) {
    unsigned tmp; asm("v_pk_sub_u16 %1, %2, %3 clamp\n\tv_pk_min_u16 %1, %1, %4\n\tv_pk_add_u16 %0, %0, %1" : "+v"(acc), "=&v"(tmp) : "v"(w), "v"(xm2), "v"(one2)); }
__device__ __forceinline__ int wave_sum_dpp(int x, int lane) {
    x += __builtin_amdgcn_update_dpp(0, x, 0xB1, 0xF, 0xF, false);
    x += __builtin_amdgcn_update_dpp(0, x, 0x4E, 0xF, 0xF, false);
    x += __builtin_amdgcn_update_dpp(0, x, 0x124, 0xF, 0xF, false);
    x += __builtin_amdgcn_update_dpp(0, x, 0x128, 0xF, 0xF, false);
    x += shxi(x, 16, lane); x += shxi(x, 32, lane);
    return x;
}
__device__ __forceinline__ int count_ge_pk(const LAS bf16* row, int L, unsigned X, int lane) {
    const unsigned xm = (X - 1u) & 0xffffu, xm2 = xm | (xm << 16), one2 = 0x00010001u; unsigned a0 = 0u, a1 = 0u, a2 = 0u, a3 = 0u;
    const int nch = L >> 3; int c = lane;
    for (; c + 192 < nch; c += 256) {
        const v4u w0 = *(const LAS v4u*)(row + 8 * c), w1 = *(const LAS v4u*)(row + 8 * (c + 64)), w2 = *(const LAS v4u*)(row + 8 * (c + 128)), w3 = *(const LAS v4u*)(row + 8 * (c + 192));
        pk_count(a0, w0.x, xm2, one2); pk_count(a1, w0.y, xm2, one2); pk_count(a2, w0.z, xm2, one2); pk_count(a3, w0.w, xm2, one2);
        pk_count(a0, w1.x, xm2, one2); pk_count(a1, w1.y, xm2, one2); pk_count(a2, w1.z, xm2, one2); pk_count(a3, w1.w, xm2, one2);
        pk_count(a0, w2.x, xm2, one2); pk_count(a1, w2.y, xm2, one2); pk_count(a2, w2.z, xm2, one2); pk_count(a3, w2.w, xm2, one2);
        pk_count(a0, w3.x, xm2, one2); pk_count(a1, w3.y, xm2, one2); pk_count(a2, w3.z, xm2, one2); pk_count(a3, w3.w, xm2, one2); }
    for (; c < nch; c += 64) { const v4u w = *(const LAS v4u*)(row + 8 * c); pk_count(a0, w.x, xm2, one2); pk_count(a1, w.y, xm2, one2); pk_count(a2, w.z, xm2, one2); pk_count(a3, w.w, xm2, one2); }
    const unsigned acc = (a0 + a1) + (a2 + a3);
    return wave_sum_dpp((int)(acc & 0xffffu) + (int)(acc >> 16), lane);
}
__device__ __forceinline__ void dsa_unit(const Frame& F, int b, int qg) {
    const int lane = F.lane, wave = F.wave, m = lane & 31, hf = lane >> 5, tid = F.tid;
    const bf16* QAI = wsp<bf16>(F, WS_QAI); const bf16* KI = wsp<bf16>(F, WS_KI); const bf16* KA = wsp<bf16>(F, WS_KA); const bf16* VAT = wsp<bf16>(F, WS_VBT) + 512 * 32;
    const float* WI = wsp<float>(F, WS_WI); bf16* OAB = wsp<bf16>(F, WS_OAB); const f32x2* rope = wsp<f32x2>(F, WS_ROPE);
    LAS bf16* SC = (LAS bf16*)F.lds;
    LAS bf16* SEL = (LAS bf16*)(F.lds + UP_SEL);
    const bf16* VA = wsp<bf16>(F, WS_VA);
    LAS int* PAR = (LAS int*)(F.lds + UP_PAR); LAS float* ML = (LAS float*)(F.lds + UP_ML);
    const int t0 = qg * 8, nkeys = t0 + 8, ntile = (nkeys + 31) >> 5, L = ntile * 32;
    const size_t tb = (size_t)b * SEQ;
    {
        const int qq = 2 * ((m >> 2) & 1) + (m >> 4), head = (m & 3) + 4 * ((m >> 3) & 1);
        bf16x8 Af[2][4]; float wv[2][2][8];
#pragma unroll
        for (int mt = 0; mt < 2; ++mt) { const bf16* qp = QAI + (tb + t0 + 4 * mt + qq) * 1024 + 512 + head * 64 + 8 * hf;
#pragma unroll
            for (int kk = 0; kk < 4; ++kk) Af[mt][kk] = *(const bf16x8*)(qp + 16 * kk);
            Af[mt][0] = rope8(Af[mt][0], rope + (size_t)(t0 + 4 * mt + qq) * 8 + 4 * hf);
#pragma unroll
            for (int q2 = 0; q2 < 2; ++q2) { const float* wp = WI + (tb + t0 + 4 * mt + 2 * hf + q2) * 8; const f32x4 a = *(const f32x4*)wp, c = *(const f32x4*)(wp + 4);
                wv[mt][q2][0] = a[0]; wv[mt][q2][1] = a[1]; wv[mt][q2][2] = a[2]; wv[mt][q2][3] = a[3]; wv[mt][q2][4] = c[0]; wv[mt][q2][5] = c[1]; wv[mt][q2][6] = c[2]; wv[mt][q2][7] = c[3]; } }
#ifndef DSA_REP1
#define DSA_REP1 1
#define DSA_REP2 1
#define DSA_REP3 1
#endif
        for (int rep1 = 0; rep1 < DSA_REP1; ++rep1) {
        bf16x8 Bn[4];
        if (wave < ntile) { const bf16* kp = KI + (tb + 32 * wave + m) * 64 + 8 * hf;
#pragma unroll
            for (int kk = 0; kk < 4; ++kk) Bn[kk] = *(const bf16x8*)(kp + 16 * kk); }
        for (int tile = wave; tile < ntile; tile += NWAVES) {
            const int key = 32 * tile + m;
            bf16x8 Bf[4];
#pragma unroll
            for (int kk = 0; kk < 4; ++kk) Bf[kk] = Bn[kk];
            if (tile + NWAVES < ntile) { const bf16* kp = KI + (tb + 32 * (tile + NWAVES) + m) * 64 + 8 * hf;
#pragma unroll
                for (int kk = 0; kk < 4; ++kk) Bn[kk] = *(const bf16x8*)(kp + 16 * kk); }
#pragma unroll
            for (int mt = 0; mt < 2; ++mt) { f32x16 acc;
#pragma unroll
                for (int r = 0; r < 16; ++r) acc[r] = 0.f;
#pragma unroll
                for (int kk = 0; kk < 4; ++kk) acc = __builtin_amdgcn_mfma_f32_32x32x16_bf16(Af[mt][kk], Bf[kk], acc, 0, 0, 0);
#pragma unroll
                for (int q2 = 0; q2 < 2; ++q2) { float s = 0.f;
#pragma unroll
                    for (int h = 0; h < 8; ++h) s += wv[mt][q2][h] * fmaxf(acc[8 * q2 + h], 0.f);
                    const int ql = 4 * mt + 2 * hf + q2; const unsigned k16 = (key <= t0 + ql) ? f16key(s) : 0u;
                    SC[ql * SEQ + key] = (bf16)k16; } }
        }
        }
    }
    __syncthreads();
    const int ql = wave, t = t0 + ql, n = t + 1; int nsel;
    const LAS bf16* row = SC + ql * SEQ; LAS bf16* sel = SEL + ql * 256;
    if (n <= 256) { for (int i = lane; i < 256; i += 64) sel[i] = (bf16)(i < n ? i : 0); nsel = n; }
    else for (int rep2 = 0; rep2 < DSA_REP2; ++rep2) {
        const int nch = L >> 3, nj = (nch + 63) >> 6;
        v4u kr[16];
#pragma unroll
        for (int j = 0; j < 16; ++j) { kr[j] = (v4u){0u, 0u, 0u, 0u}; if (j < nj) { const int c = lane + 64 * j; if (c < nch) kr[j] = *(const LAS v4u*)(row + 8 * c); } }
        const unsigned one2 = 0x00010001u;
#define DSA_COUNT_GE(X, OUT) do { const unsigned xm_ = ((X) - 1u) & 0xffffu, xm2_ = xm_ | (xm_ << 16); unsigned ac_[16]; \
            _Pragma("unroll") for (int q = 0; q < 16; ++q) ac_[q] = 0u; \
            _Pragma("unroll") for (int j = 0; j < 16; ++j) if (j < nj) { pk_count(ac_[(4 * j) & 15], kr[j].x, xm2_, one2); pk_count(ac_[(4 * j + 1) & 15], kr[j].y, xm2_, one2); pk_count(ac_[(4 * j + 2) & 15], kr[j].z, xm2_, one2); pk_count(ac_[(4 * j + 3) & 15], kr[j].w, xm2_, one2); } \
            unsigned s_ = 0u; _Pragma("unroll") for (int q = 0; q < 16; ++q) s_ += ac_[q];     \
            (OUT) = (int)(s_ & 0xffffu) + (int)(s_ >> 16); } while (0)
        int T = 0;
        for (int bit = 15; bit >= 0; --bit) { const int cand = T | (1 << bit); int cl; DSA_COUNT_GE((unsigned)cand, cl); if (wave_sum_dpp(cl, lane) >= 256) T = cand; }
        int cgl; DSA_COUNT_GE((unsigned)T + 1u, cgl);
        int incl = cgl;
#pragma unroll
        for (int o = 1; o < 64; o <<= 1) { const int v = __builtin_amdgcn_ds_bpermute(((lane - o) & 63) << 2, incl); incl += (lane >= o) ? v : 0; }
        const int cgt = __builtin_amdgcn_readlane(incl, 63), need = 256 - cgt; int wp = incl - cgl;
        unsigned em[4] = {0u, 0u, 0u, 0u};
#pragma unroll
        for (int j = 0; j < 16; ++j) if (j < nj) {
#pragma unroll
            for (int e = 0; e < 8; ++e) { const unsigned w = (e < 2) ? kr[j].x : (e < 4) ? kr[j].y : (e < 6) ? kr[j].z : kr[j].w; const int k = (int)((e & 1) ? (w >> 16) : (w & 0xffffu));
                if (k > T) { sel[wp] = (bf16)(8 * (lane + 64 * j) + e); ++wp; }
                em[j >> 2] |= (k == T) ? (1u << ((j & 3) * 8 + e)) : 0u; } }
        for (int it = 0; it < need; ++it) {
            const int w = em[0] ? 0 : em[1] ? 1 : em[2] ? 2 : 3; const unsigned mw = em[0] ? em[0] : em[1] ? em[1] : em[2] ? em[2] : em[3];
            const int bitp = mw ? __builtin_ctz(mw) : 0; const int mine = mw ? (512 * (4 * w + (bitp >> 3)) + 8 * lane + (bitp & 7)) : 0x7fffffff;
            int mn = mine;
#pragma unroll
            for (int o = 1; o < 64; o <<= 1) { const int v = shxi(mn, o, lane); mn = v < mn ? v : mn; }
            if (mine == mn) { const unsigned clr = ~(1u << bitp); if (w == 0) em[0] &= clr; else if (w == 1) em[1] &= clr; else if (w == 2) em[2] &= clr; else em[3] &= clr; }
            if (lane == 0) sel[cgt + it] = (bf16)mn;
        }
#undef DSA_COUNT_GE
        nsel = 256;
    }
    LDS_WAIT(); asm volatile("" ::: "memory");
    for (int rep3 = 0; rep3 < DSA_REP3; ++rep3) {
        typedef float f32x4r __attribute__((ext_vector_type(4)));
        LAS unsigned char* buf = F.lds + ql * (SEQ * 2);
        const int t = t0 + ql, c16 = lane & 15, quad = lane >> 4;
        bf16x8 Bq[2][2];
        { const bf16* qp = QAI + (tb + t) * 1024 + (c16 & 7) * 64 + 8 * quad; bf16x8 q0 = *(const bf16x8*)qp, q1 = *(const bf16x8*)(qp + 32);
          if (quad < 2) q0 = rope8(q0, rope + (size_t)t * 8 + 4 * quad);
          const v4u z = {0u, 0u, 0u, 0u}, u0 = __builtin_bit_cast(v4u, q0), u1 = __builtin_bit_cast(v4u, q1); const bool g0 = c16 < 4, g1 = (c16 >= 4) && (c16 < 8);
          v4u a0, a1, b0, b1;
#pragma unroll
          for (int i = 0; i < 4; ++i) { a0[i] = g0 ? u0[i] : z[i]; a1[i] = g0 ? u1[i] : z[i]; b0[i] = g1 ? u0[i] : z[i]; b1[i] = g1 ? u1[i] : z[i]; }
          Bq[0][0] = __builtin_bit_cast(bf16x8, a0); Bq[0][1] = __builtin_bit_cast(bf16x8, a1); Bq[1][0] = __builtin_bit_cast(bf16x8, b0); Bq[1][1] = __builtin_bit_cast(bf16x8, b1); }
        f32x4r S[16];
#pragma unroll
        for (int rd = 0; rd < 4; ++rd) {
#pragma unroll
            for (int i = 0; i < 16; ++i) { const int rl = 4 * i + quad, slot = 64 * rd + rl; const int key = (int)sel[slot]; const int c = c16 ^ (rl & 15);
                __builtin_amdgcn_global_load_lds((const unsigned*)(KA + (tb + key) * 128 + 8 * c), (LAS unsigned*)(buf + i * 1024), 16, 0, 0); }
            asm volatile("s_waitcnt vmcnt(0)" ::: "memory");
#pragma unroll
            for (int k4 = 0; k4 < 4; ++k4) { const int rl = 16 * k4 + c16; f32x4r acc = {0.f, 0.f, 0.f, 0.f};
                const LAS unsigned char* rp = buf + rl * 256;
#pragma unroll
                for (int g = 0; g < 2; ++g)
#pragma unroll
                    for (int ks = 0; ks < 2; ++ks) { const bf16x8 kf = *(const LAS bf16x8*)(rp + (((8 * g + 4 * ks + quad) ^ c16) << 4)); acc = __builtin_amdgcn_mfma_f32_16x16x32_bf16(kf, Bq[g][ks], acc, 0, 0, 0); }
                S[4 * rd + k4] = acc; }
            asm volatile("s_waitcnt lgkmcnt(0)" ::: "memory");
        }
        float mx = -INFINITY;
#pragma unroll
        for (int kt = 0; kt < 16; ++kt)
#pragma unroll
            for (int r = 0; r < 4; ++r) { const bool ok = (16 * kt + 4 * quad + r) < nsel; S[kt][r] = ok ? S[kt][r] : -INFINITY; mx = fmaxf(mx, S[kt][r]); }
        mx = fmaxf(mx, shx(mx, 16, lane)); mx = fmaxf(mx, shx(mx, 32, lane));
        float sum = 0.f;
#pragma unroll
        for (int kt = 0; kt < 16; ++kt)
#pragma unroll
            for (int r = 0; r < 4; ++r) { const float p = __expf(S[kt][r] - mx); S[kt][r] = p; sum += p; }
        sum += shx(sum, 16, lane); sum += shx(sum, 32, lane);
        const float inv = 1.f / sum;
        bf16x8 pf[8];
#pragma unroll
        for (int s = 0; s < 8; ++s) { v4u w; w.x = pk2(S[2 * s][0], S[2 * s][1]); w.y = pk2(S[2 * s][2], S[2 * s][3]); w.z = pk2(S[2 * s + 1][0], S[2 * s + 1][1]); w.w = pk2(S[2 * s + 1][2], S[2 * s + 1][3]); pf[s] = __builtin_bit_cast(bf16x8, w); }
        f32x4r O[8];
#pragma unroll
        for (int dt = 0; dt < 8; ++dt) O[dt] = (f32x4r){0.f, 0.f, 0.f, 0.f};
#pragma unroll
        for (int rd = 0; rd < 4; ++rd) {
#pragma unroll
            for (int i = 0; i < 16; ++i) { const int rl = 4 * i + quad, slot = 64 * rd + rl; const int key = (int)sel[slot];
                __builtin_amdgcn_global_load_lds((const unsigned*)(VA + (tb + key) * 128 + 8 * c16), (LAS unsigned*)(buf + i * 1024), 16, 0, 0); }
            asm volatile("s_waitcnt vmcnt(0)" ::: "memory");
#pragma unroll
            for (int s2 = 0; s2 < 2; ++s2) {
#pragma unroll
                for (int dt = 0; dt < 8; ++dt) { const int d = 16 * dt + c16; unsigned e[8];
#pragma unroll
                    for (int j = 0; j < 8; ++j) { const int rl = 32 * s2 + 16 * (j >> 2) + 4 * quad + (j & 3); e[j] = *(const LAS bf16*)(buf + rl * 256 + d * 2); }
                    v4u a; a.x = e[0] | (e[1] << 16); a.y = e[2] | (e[3] << 16); a.z = e[4] | (e[5] << 16); a.w = e[6] | (e[7] << 16);
                    O[dt] = __builtin_amdgcn_mfma_f32_16x16x32_bf16(__builtin_bit_cast(bf16x8, a), pf[2 * rd + s2], O[dt], 0, 0, 0);
                    if (dt & 1) asm volatile("" ::: "memory"); } }
            asm volatile("s_waitcnt lgkmcnt(0)" ::: "memory");
        }
        if (c16 < 8) { bf16* op = OAB + (tb + t) * 1024 + c16 * 64 + 4 * quad;
#pragma unroll
            for (int d4 = 0; d4 < 4; ++d4) { const f32x4r Oa = O[d4], Ob = O[4 + d4]; f32x4r Ox; const bool lo4 = c16 < 4;
#pragma unroll
                for (int i = 0; i < 4; ++i) Ox[i] = lo4 ? Oa[i] : Ob[i];
                v2u w; w.x = pk2(Ox[0] * inv, Ox[1] * inv); w.y = pk2(Ox[2] * inv, Ox[3] * inv); *(v2u*)(op + 16 * d4) = w; } }
    }
    __syncthreads();
}
__device__ __forceinline__ void dsa_phase(const Frame& F) {
    const bool bal = (F.G == 256); const int c = F.vcu, bb = (c >> 5) & 3, j = (c & 31) + 32 * (c >> 7);
    const int nit = bal ? 16 : (NB * (SEQ / 8) + F.G - 1) / F.G;
    for (int i = 0; i < nit; ++i) {
        int b, qg;
        if (bal) { b = bb; qg = 64 * i + ((i & 1) ? 63 - j : j); } else { const int u = i * F.G + F.vcu; if (u >= NB * (SEQ / 8)) break; b = u & 3; qg = u >> 2; }
        dsa_unit(F, b, qg);
    }
}
__device__ __forceinline__ void sb_phase(const Frame& F) {
    const int gw = F.wave * F.G + F.vcu, NGW = F.G * NWAVES, lane = F.lane, m = lane & 31, hf = lane >> 5;
    const bf16* P1 = wsp<bf16>(F, WS_P1); const bf16* VBT = wsp<bf16>(F, WS_VBT); bf16* OAB = wsp<bf16>(F, WS_OAB);
    for (int task = gw; task < NB * 8 * (SEQ / 32); task += NGW) {
        const int qt = task & 255, h = (task >> 8) & 7, b = task >> 11, t0 = qt * 32, t = t0 + m; const size_t tb = (size_t)b * SEQ;
        bf16x8 qf[4], kf[4];
        { const bf16* qp = P1 + (tb + t0 + m) * EVW + C_QB + h * 64 + 8 * hf; const bf16* kp = P1 + (tb + t0 + m) * EVW + C_KB + h * 64 + 8 * hf;
#pragma unroll
          for (int kk = 0; kk < 4; ++kk) { qf[kk] = *(const bf16x8*)(qp + 16 * kk); kf[kk] = *(const bf16x8*)(kp + 16 * kk); } }
        f32x16 O[2];
#pragma unroll
        for (int r = 0; r < 16; ++r) { O[0][r] = 0.f; O[1][r] = 0.f; }
        float carry = 1.f;
#pragma unroll 1
        for (int kt = qt; kt >= 0; --kt) {
            f32x16 S;
#pragma unroll
            for (int r = 0; r < 16; ++r) S[r] = 0.f;
#pragma unroll
            for (int kk = 0; kk < 4; ++kk) S = __builtin_amdgcn_mfma_f32_32x32x16_bf16(kf[kk], qf[kk], S, 0, 0, 0);
            if (kt > 0) { const bf16* kp = P1 + (tb + 32 * (kt - 1) + m) * EVW + C_KB + h * 64 + 8 * hf;
#pragma unroll
                for (int kk = 0; kk < 4; ++kk) kf[kk] = *(const bf16x8*)(kp + 16 * kk); }
            v2u vlo[2][2], vhi[2][2];
#pragma unroll
            for (int dt = 0; dt < 2; ++dt) { const bf16* vp = VBT + ((size_t)(b * (SEQ / 32) + kt) * 512 + h * 64 + 32 * dt + m) * 32 + 4 * hf;
#pragma unroll
                for (int s = 0; s < 2; ++s) { vlo[dt][s] = *(const v2u*)(vp + 16 * s); vhi[dt][s] = *(const v2u*)(vp + 16 * s + 8); } }
            float rr[16], be[16];
#pragma unroll
            for (int r = 0; r < 16; ++r) { const int key = 32 * kt + crow(r, hf); const bool valid = key < t; const float z = S[r] * 0.125f;
                const float ez = __expf(fminf(z, 80.f)), rv = __builtin_amdgcn_rcpf(1.f + ez); rr[r] = valid ? rv : 1.f; be[r] = valid ? ez * rv : 0.f; }
            float g[4], og[4], T[5];
#pragma unroll
            for (int q = 0; q < 4; ++q) { g[q] = (rr[4 * q] * rr[4 * q + 1]) * (rr[4 * q + 2] * rr[4 * q + 3]); og[q] = shx(g[q], 32, lane); }
            T[4] = 1.f;
#pragma unroll
            for (int q = 3; q >= 0; --q) T[q] = g[q] * og[q] * T[q + 1];
#pragma unroll
            for (int q = 0; q < 4; ++q) { float aft = (hf == 0 ? og[q] : 1.f) * T[q + 1] * carry;
                S[4 * q + 3] = be[4 * q + 3] * aft; aft *= rr[4 * q + 3]; S[4 * q + 2] = be[4 * q + 2] * aft; aft *= rr[4 * q + 2];
                S[4 * q + 1] = be[4 * q + 1] * aft; aft *= rr[4 * q + 1]; S[4 * q] = be[4 * q] * aft; }
            carry *= T[0];
            bf16x8 pf[2];
#pragma unroll
            for (int s = 0; s < 2; ++s) { v4u w; w.x = pk2(S[8 * s + 0], S[8 * s + 1]); w.y = pk2(S[8 * s + 2], S[8 * s + 3]); w.z = pk2(S[8 * s + 4], S[8 * s + 5]); w.w = pk2(S[8 * s + 6], S[8 * s + 7]); pf[s] = __builtin_bit_cast(bf16x8, w); }
#pragma unroll
            for (int dt = 0; dt < 2; ++dt)
#pragma unroll
                for (int s = 0; s < 2; ++s) { v4u a; a.x = vlo[dt][s].x; a.y = vlo[dt][s].y; a.z = vhi[dt][s].x; a.w = vhi[dt][s].y;
                    O[dt] = __builtin_amdgcn_mfma_f32_32x32x16_bf16(__builtin_bit_cast(bf16x8, a), pf[s], O[dt], 0, 0, 0); }
            if (__all(carry < 1e-30f)) break;
        }
        bf16* op = OAB + (tb + t) * 1024 + 512 + h * 64 + 4 * hf;
#pragma unroll
        for (int dt = 0; dt < 2; ++dt)
#pragma unroll
            for (int rg = 0; rg < 4; ++rg) { v2u w; w.x = pk2(O[dt][4 * rg], O[dt][4 * rg + 1]); w.y = pk2(O[dt][4 * rg + 2], O[dt][4 * rg + 3]); *(v2u*)(op + 32 * dt + 8 * rg) = w; }
    }
}
__device__ __forceinline__ void xattn_phase(const Frame& F, int layer) {
    const int lane = F.lane, wave = F.wave, m = lane & 31, hf = lane >> 5, tid = F.tid;
    const bf16* QX = wsp<bf16>(F, WS_QX); const bf16* KX = wsp<bf16>(F, WS_KX) + layer * 1024; const bf16* VXT = wsp<bf16>(F, WS_VXT) + (size_t)layer * 1024 * 1024; bf16* AX = wsp<bf16>(F, WS_AX);
    constexpr int KP = 528, VP = 520;
    for (int task = F.vcu; task < NB * 4 * (SEQ / 256); task += F.G) {
        const int h = task & 3, qb = task >> 2, q0 = qb * 256 + wave * 32, b = (qb * 256) / SEQ;
        bf16x8 qf[16];
        { const bf16* qp = QX + (size_t)(q0 + m) * 1024 + h * 256 + 8 * hf;
#pragma unroll
          for (int kk = 0; kk < 16; ++kk) qf[kk] = *(const bf16x8*)(qp + 16 * kk); }
        float mx = -INFINITY, sum = 0.f;
        bf16x8 pf[8][2];
#pragma unroll
        for (int pass = 0; pass < 2; ++pass) {
            if (pass == 1) mx = fmaxf(mx, shx(mx, 32, lane));
#pragma unroll
            for (int kh = 0; kh < 2; ++kh) {
                __syncthreads();
#pragma unroll 2
                for (int i = 0; i < 8; ++i) { const int pc = i * NTHR + tid, row = pc >> 5, ch = pc & 31;
                    const v4u v = *(const v4u*)(KX + (size_t)(b * MEML + 128 * kh + row) * 2048 + h * 256 + 8 * ch);
                    *(LAS v4u*)(F.lds + row * KP + ch * 16) = v; }
                LDS_WAIT(); __syncthreads();
#pragma unroll
                for (int k4 = 0; k4 < 4; ++k4) { const int kt = 4 * kh + k4; f32x16 S;
#pragma unroll
                    for (int r = 0; r < 16; ++r) S[r] = 0.f;
                    const LAS unsigned char* kp = F.lds + (32 * k4 + m) * KP + 16 * hf;
#pragma unroll
                    for (int kk = 0; kk < 16; ++kk) { const bf16x8 kf = *(const LAS bf16x8*)(kp + 32 * kk); S = __builtin_amdgcn_mfma_f32_32x32x16_bf16(kf, qf[kk], S, 0, 0, 0); }
                    if (pass == 0) {
#pragma unroll
                        for (int r = 0; r < 16; ++r) mx = fmaxf(mx, S[r]);
                    } else {
#pragma unroll
                        for (int r = 0; r < 16; ++r) { S[r] = __expf(S[r] - mx); sum += S[r]; }
#pragma unroll
                        for (int s = 0; s < 2; ++s) { v4u w; w.x = pk2(S[8 * s + 0], S[8 * s + 1]); w.y = pk2(S[8 * s + 2], S[8 * s + 3]); w.z = pk2(S[8 * s + 4], S[8 * s + 5]); w.w = pk2(S[8 * s + 6], S[8 * s + 7]);
                            pf[kt][s] = __builtin_bit_cast(bf16x8, w); }
                    }
                }
            }
        }
        sum += shx(sum, 32, lane);
        const float inv = 1.f / sum;
#pragma unroll
        for (int half = 0; half < 2; ++half) {
            __syncthreads();
#pragma unroll 2
            for (int i = 0; i < 8; ++i) { const int pc = i * NTHR + tid, row = pc >> 5, c16 = pc & 31;
                const v4u v = *(const v4u*)(VXT + (size_t)(h * 256 + 128 * half + row) * 1024 + b * MEML + 8 * c16);
                LAS unsigned char* rp = F.lds + row * VP + c16 * 16; *(LAS v2u*)rp = (v2u){v.x, v.y}; *(LAS v2u*)(rp + 8) = (v2u){v.z, v.w}; }
            LDS_WAIT(); __syncthreads();
            f32x16 O[4];
#pragma unroll
            for (int d4 = 0; d4 < 4; ++d4) {
#pragma unroll
                for (int r = 0; r < 16; ++r) O[d4][r] = 0.f;
                const LAS unsigned char* vp = F.lds + (32 * d4 + m) * VP + 8 * hf;
#pragma unroll
                for (int kt = 0; kt < 8; ++kt)
#pragma unroll
                    for (int s = 0; s < 2; ++s) { const v2u lo = *(const LAS v2u*)(vp + 64 * kt + 32 * s), hi = *(const LAS v2u*)(vp + 64 * kt + 32 * s + 16);
                        v4u a; a.x = lo.x; a.y = lo.y; a.z = hi.x; a.w = hi.y;
                        O[d4] = __builtin_amdgcn_mfma_f32_32x32x16_bf16(__builtin_bit_cast(bf16x8, a), pf[kt][s], O[d4], 0, 0, 0);
                        if (s == 1 && (kt & 1)) asm volatile("" ::: "memory"); }
            }
            bf16* op = AX + (size_t)(q0 + m) * 1024 + h * 256 + 4 * hf;
#pragma unroll
            for (int d4 = 0; d4 < 4; ++d4)
#pragma unroll
                for (int rg = 0; rg < 4; ++rg) { v2u w; w.x = pk2(O[d4][4 * rg] * inv, O[d4][4 * rg + 1] * inv); w.y = pk2(O[d4][4 * rg + 2] * inv, O[d4][4 * rg + 3] * inv);
                    *(v2u*)(op + 32 * (4 * half + d4) + 8 * rg) = w; }
        }
    }
}

__device__ __forceinline__ void router_phase(const Frame& F, int layer) {
    const int lane = F.lane, wave = F.wave, m = lane & 31, hf = lane >> 5, tid = F.tid;
    const float* HF = wsp<float>(F, WS_HF); const float* Wr = inp(F, 26) + (size_t)layer * DM * NEXP; const float* br = inp(F, 27) + layer * NEXP;
    unsigned* cnt = wsp<unsigned>(F, WS_CTL) + CW_CNT + layer * 32 * 64;
    int* elist = wsp<int>(F, WS_ELIST); float* egate = wsp<float>(F, WS_EGATE); int* toke = wsp<int>(F, WS_TOKE); int* tokp = wsp<int>(F, WS_TOKP);
    __syncthreads();
    for (int i = tid; i < DM * NEXP / 4; i += NTHR) *(LAS f32x4*)(F.lds + 16 * i) = *(const f32x4*)(Wr + 4 * i);
    LDS_WAIT(); __syncthreads();
    const LAS float* W = (const LAS float*)F.lds;
    const int slot = wave & 3, kh = wave >> 2;
    LAS float* scr = (LAS float*)(F.lds + UP_RSCR) + slot * 1024;
    for (int t4 = F.vcu; t4 < NTOK / 128; t4 += F.G) {
        const int tok0 = (t4 * 4 + slot) * 32;
        f32x16 acc;
#pragma unroll
        for (int r = 0; r < 16; ++r) acc[r] = 0.f;
        const float* ap = HF + (size_t)(tok0 + m) * DM + 512 * kh + 4 * hf; const LAS float* bp = W + (512 * kh + 4 * hf) * NEXP + m;
#pragma unroll 8
        for (int j = 0; j < 64; ++j) { const f32x4 a = *(const f32x4*)(ap + 8 * j);
#pragma unroll
            for (int s = 0; s < 4; ++s) acc = __builtin_amdgcn_mfma_f32_32x32x2f32(a[s], bp[(8 * j + s) * NEXP], acc, 0, 0, 0); }
        if (kh == 1) {
#pragma unroll
            for (int r = 0; r < 16; ++r) { const int i = crow(r, hf); scr[i * 32 + (m ^ i)] = acc[r]; } }
        LDS_WAIT(); __syncthreads();
        if (kh == 0) {
#pragma unroll
            for (int r = 0; r < 16; ++r) { const int i = crow(r, hf); scr[i * 32 + (m ^ i)] += acc[r]; }
            LDS_WAIT(); asm volatile("" ::: "memory");
            int e4[4]; float g4[4];
            { float lg[32];
#pragma unroll
              for (int e = 0; e < 32; ++e) lg[e] = scr[m * 32 + (e ^ m)] + br[e];
              unsigned taken = 0u; float v4[4];
#pragma unroll
              for (int k = 0; k < 4; ++k) { float best = -INFINITY; int bi = 0;
#pragma unroll
                  for (int e = 0; e < 32; ++e) { const bool ok = !((taken >> e) & 1u) && (lg[e] > best); best = ok ? lg[e] : best; bi = ok ? e : bi; }
                  taken |= 1u << bi; e4[k] = bi; v4[k] = best; }
              float s = 0.f;
#pragma unroll
              for (int k = 0; k < 4; ++k) { g4[k] = __expf(v4[k] - v4[0]); s += g4[k]; }
              const float inv = 1.f / s;
#pragma unroll
              for (int k = 0; k < 4; ++k) g4[k] *= inv; }
            int pos4[4];
            const bool act = lane < 32;
            for (int e = 0; e < 32; ++e) {
                unsigned long long mk[4]; int tot = 0;
#pragma unroll
                for (int k = 0; k < 4; ++k) { mk[k] = __ballot(act && e4[k] == e); tot += __popcll(mk[k]); }
                if (tot == 0) continue;
                unsigned base = 0u;
                if (lane == 0) base = __hip_atomic_fetch_add(cnt + e * 64, (unsigned)tot, __ATOMIC_RELAXED, __HIP_MEMORY_SCOPE_AGENT);
                base = (unsigned)__builtin_amdgcn_readfirstlane((int)base);
                const unsigned long long lt = (1ull << lane) - 1ull; int off = 0;
#pragma unroll
                for (int k = 0; k < 4; ++k) { if (act && e4[k] == e) pos4[k] = (int)base + off + __popcll(mk[k] & lt); off += __popcll(mk[k]); }
            }
            if (act) { const int tok = tok0 + lane;
#pragma unroll
                for (int k = 0; k < 4; ++k) { elist[(size_t)e4[k] * NTOK + pos4[k]] = tok; egate[(size_t)e4[k] * NTOK + pos4[k]] = g4[k]; }
                *(int4*)(toke + (size_t)tok * 4) = make_int4(e4[0], e4[1], e4[2], e4[3]); *(int4*)(tokp + (size_t)tok * 4) = make_int4(pos4[0], pos4[1], pos4[2], pos4[3]); }
        }
        __syncthreads();
    }
}
__device__ __forceinline__ void moe_tables(const Frame& F, int layer) {
    LAS int* tile_e = (LAS int*)(F.lds + UP_TILEE); LAS int* tstart = (LAS int*)(F.lds + UP_TSTART); LAS int* cntl = (LAS int*)(F.lds + UP_CNT);
    unsigned* cnt = wsp<unsigned>(F, WS_CTL) + CW_CNT + layer * 32 * 64;
    __syncthreads();
    if (F.tid < 32) cntl[F.tid] = (int)__hip_atomic_load(cnt + F.tid * 64, __ATOMIC_RELAXED, __HIP_MEMORY_SCOPE_AGENT);
    __syncthreads();
    if (F.tid == 0) { int s = 0; for (int e = 0; e < 32; ++e) { tstart[e] = s; s += (cntl[e] + 255) >> 8; } tstart[32] = s; }
    __syncthreads();
    for (int e = 0; e < 32; ++e) { const int a = tstart[e], b = tstart[e + 1]; for (int rt = a + F.tid; rt < b; rt += NTHR) tile_e[rt] = e; }
    __syncthreads();
}
__device__ __forceinline__ void gather_phase(const Frame& F, int layer) {
    moe_tables(F, layer);
    const LAS int* tile_e = (const LAS int*)(F.lds + UP_TILEE); const LAS int* tstart = (const LAS int*)(F.lds + UP_TSTART); const LAS int* cntl = (const LAS int*)(F.lds + UP_CNT);
    const int gw = F.vcu * NWAVES + F.wave, NGW = F.G * NWAVES, lane = F.lane; const int nrows = tstart[32] * 256;
    const int* elist = wsp<int>(F, WS_ELIST); const float* egate = wsp<float>(F, WS_EGATE); float* rgate = wsp<float>(F, WS_RGATE);
    const bf16* XB = wsp<bf16>(F, WS_XB); bf16* XG = wsp<bf16>(F, WS_XG);
    for (int row = gw; row < nrows; row += NGW) {
        const int rt = row >> 8, e = tile_e[rt], pos = (rt - tstart[e]) * 256 + (row & 255); const bool valid = pos < cntl[e];
        v4u a = (v4u){0u, 0u, 0u, 0u}, b = a; float gt = 0.f;
        if (valid) { const int tok = elist[(size_t)e * NTOK + pos]; gt = egate[(size_t)e * NTOK + pos]; const bf16* src = XB + (size_t)tok * DM + 16 * lane; a = *(const v4u*)src; b = *(const v4u*)(src + 8); }
        bf16* dst = XG + (size_t)row * DM + 16 * lane; *(v4u*)dst = a; *(v4u*)(dst + 8) = b;
        if (lane == 0) rgate[row] = gt;
    }
}
__device__ __forceinline__ void combine_phase(const Frame& F, int layer, float* dstF, int nrep = 1) {
    moe_tables(F, layer);
    const LAS int* tstart = (const LAS int*)(F.lds + UP_TSTART);
    const int gw = F.vcu * NWAVES + F.wave, NGW = F.G * NWAVES, lane = F.lane;
    const int* toke = wsp<int>(F, WS_TOKE); const int* tokp = wsp<int>(F, WS_TOKP); const bf16* Y = wsp<bf16>(F, WS_XG); const float* HF = wsp<float>(F, WS_HF); bf16* XB = wsp<bf16>(F, WS_XB);
    const float* g = inp(F, 32) + layer * DM; const float* b = inp(F, 33) + layer * DM;
    for (int rep = 0; rep < nrep; ++rep)
    for (int tok0 = gw; tok0 < NTOK; tok0 += 2 * NGW) {
        f32x4 v[2][4]; v2u y[2][4][4];
#pragma unroll
        for (int q = 0; q < 2; ++q) { const int tok = (tok0 + q * NGW < NTOK) ? tok0 + q * NGW : tok0;
            const int4 e4 = *(const int4*)(toke + (size_t)tok * 4), p4 = *(const int4*)(tokp + (size_t)tok * 4);
            const int r0 = tstart[e4.x] * 256 + p4.x, r1 = tstart[e4.y] * 256 + p4.y, r2 = tstart[e4.z] * 256 + p4.z, r3 = tstart[e4.w] * 256 + p4.w;
#pragma unroll
            for (int j = 0; j < 4; ++j) { const int c = 4 * lane + 256 * j; v[q][j] = *(const f32x4*)(HF + (size_t)tok * DM + c);
                y[q][j][0] = *(const v2u*)(Y + (size_t)r0 * DM + c); y[q][j][1] = *(const v2u*)(Y + (size_t)r1 * DM + c); y[q][j][2] = *(const v2u*)(Y + (size_t)r2 * DM + c); y[q][j][3] = *(const v2u*)(Y + (size_t)r3 * DM + c); } }
#pragma unroll
        for (int q = 0; q < 2; ++q) { const int tok = tok0 + q * NGW; if (tok >= NTOK) continue;
#pragma unroll
            for (int j = 0; j < 4; ++j) { const v2u y0 = y[q][j][0], y1 = y[q][j][1], y2 = y[q][j][2], y3 = y[q][j][3]; v[q][j] = v[q][j] * DN_ALPHA;
                v[q][j][0] += ((bflo(y0.x) + bflo(y1.x)) + bflo(y2.x)) + bflo(y3.x); v[q][j][1] += ((bfhi(y0.x) + bfhi(y1.x)) + bfhi(y2.x)) + bfhi(y3.x);
                v[q][j][2] += ((bflo(y0.y) + bflo(y1.y)) + bflo(y2.y)) + bflo(y3.y); v[q][j][3] += ((bfhi(y0.y) + bfhi(y1.y)) + bfhi(y2.y)) + bfhi(y3.y); }
            if (rep == nrep - 1 || F.G < 0) ln_row_store(F, v[q], g, b, dstF + (size_t)tok * DM, XB + (size_t)tok * DM);
            else { float s = 0.f;
#pragma unroll
                for (int j = 0; j < 4; ++j) s += v[q][j][0] + v[q][j][1] + v[q][j][2] + v[q][j][3]; if (s == 1.2345e38f) dstF[tok] = s; } }
    }
}

constexpr int S5_APITCH = 2064, S5_HPITCH = 272, S5_AOFF = 0, S5_HOFF = 32 * S5_APITCH  , S5_ROFF = 81920  ;
__device__ __forceinline__ void s5_stage_u(const Frame& F, int g, int mt) {
    const bf16* U = wsp<bf16>(F, WS_U); const int b = mt >> 2, ch0 = (mt & 3) * 32;
    for (int pc = F.tid; pc < 32 * 128; pc += NTHR) { const int i = pc >> 7, q = pc & 127;
        *(LAS v4u*)(F.lds + S5_AOFF + i * S5_APITCH + q * 16) = *(const v4u*)(U + (((size_t)g * NTOK + (size_t)b * SEQ + (size_t)(ch0 + i) * SCH) * 16 + 8 * q)); }
}
__device__ __forceinline__ void s5_local_phase(const Frame& F) {
    const int lane = F.lane, wave = F.wave, m = lane & 31, hf = lane >> 5;
    const bf16* W1 = wsp<bf16>(F, WS_W1); float* ELOC = wsp<float>(F, WS_ELOC);
    for (int unit = F.vcu; unit < 64 * 16; unit += F.G) {
        const int g = unit & 63, mt = unit >> 6, b = mt >> 2, ch0 = (mt & 3) * 32;
        __syncthreads();
        s5_stage_u(F, g, mt);
        LDS_WAIT(); __syncthreads();
        const int nt = wave & 3, kh = wave >> 2;
        f32x16 acc;
#pragma unroll
        for (int r = 0; r < 16; ++r) acc[r] = 0.f;
        const bf16* wp = W1 + ((size_t)g * 128 + 32 * nt + m) * 1024 + 8 * hf; const LAS unsigned char* ap = F.lds + S5_AOFF + m * S5_APITCH + 16 * hf;
#pragma unroll 8
        for (int kk = 32 * kh; kk < 32 * kh + 32; ++kk) { const bf16x8 af = *(const LAS bf16x8*)(ap + 32 * kk); const bf16x8 bf = *(const bf16x8*)(wp + 16 * kk);
            acc = __builtin_amdgcn_mfma_f32_32x32x16_bf16(af, bf, acc, 0, 0, 0); }
        LAS float* red = (LAS float*)(F.lds + S5_ROFF) + (nt * 64 + lane) * 16;
        if (kh == 1) {
#pragma unroll
            for (int r = 0; r < 16; r += 4) *(LAS f32x4*)(red + r) = (f32x4){acc[r], acc[r + 1], acc[r + 2], acc[r + 3]}; }
        LDS_WAIT(); __syncthreads();
        if (kh == 0) {
#pragma unroll
            for (int r = 0; r < 16; ++r) { const int i = crow(r, hf); ELOC[(((size_t)b * 64 + g) * NCHUNK + ch0 + i) * 128 + 32 * nt + m] = acc[r] + red[r]; } }
    }
}
__device__ __forceinline__ void s5_scan_phase(const Frame& F) {
    if (F.wave != 0) return;
    const f32x2* apow = wsp<f32x2>(F, WS_APOW); const float* ELOC = wsp<float>(F, WS_ELOC); bf16* HS = wsp<bf16>(F, WS_HS);
    for (int idx = F.vcu * 64 + F.lane; idx < NB * 64 * 64; idx += F.G * 64) {
        const int p = idx & 63, g = (idx >> 6) & 63, b = idx >> 12; const f32x2 a = apow[(g * 64 + p) * 65 + 64];
        const size_t base = ((size_t)b * 64 + g) * NCHUNK * 128; float hr = 0.f, hi = 0.f;
#pragma unroll 8
        for (int k = 0; k < NCHUNK; ++k) { HS[base + (size_t)k * 128 + p] = (bf16)f2bf(hr); HS[base + (size_t)k * 128 + 64 + p] = (bf16)f2bf(hi);
            const float er = ELOC[base + (size_t)k * 128 + p], ei = ELOC[base + (size_t)k * 128 + 64 + p];
            const float nr = a.x * hr - a.y * hi + er, ni = a.x * hi + a.y * hr + ei; hr = nr; hi = ni; }
    }
}
__device__ __forceinline__ void s5_out_phase(const Frame& F) {
    const int lane = F.lane, wave = F.wave, m = lane & 31, hf = lane >> 5;
    const bf16* KT = wsp<bf16>(F, WS_KT); const bf16* W3 = wsp<bf16>(F, WS_W3); const bf16* HS = wsp<bf16>(F, WS_HS); const bf16* U = wsp<bf16>(F, WS_U); bf16* YG = wsp<bf16>(F, WS_YG);
    const float* dvec = inp(F, 17);
    for (int unit = F.vcu; unit < 64 * 16; unit += F.G) {
        const int g = unit & 63, mt = unit >> 6, b = mt >> 2, ch0 = (mt & 3) * 32;
        __syncthreads();
        s5_stage_u(F, g, mt);
        for (int pc = F.tid; pc < 32 * 16; pc += NTHR) { const int i = pc >> 4, q = pc & 15;
            *(LAS v4u*)(F.lds + S5_HOFF + i * S5_HPITCH + q * 16) = *(const v4u*)(HS + (((size_t)b * 64 + g) * NCHUNK + ch0 + i) * 128 + 8 * q); }
        LDS_WAIT(); __syncthreads();
        const int tl = m >> 4, c = m & 15; const float dv = dvec[16 * g + c];
        const LAS unsigned char* ap = F.lds + S5_AOFF + m * S5_APITCH + 16 * hf; const LAS unsigned char* hp = F.lds + S5_HOFF + m * S5_HPITCH + 16 * hf;
#pragma unroll 1
        for (int q = 0; q < 4; ++q) {
            const int j = (q == 0) ? wave : (q == 1) ? 15 - wave : (q == 2) ? 16 + wave : 31 - wave; const int t = 2 * j + tl;
            f32x16 acc, acc1;
#pragma unroll
            for (int r = 0; r < 16; ++r) { acc[r] = 0.f; acc1[r] = 0.f; }
            const bf16* kt = KT + ((size_t)g * 64 * 16 + c) * 16 + 8 * hf;
            const bf16* w3 = W3 + ((size_t)g * 1024 + 16 * t + c) * 128 + 8 * hf;
            bf16x8 wf[8];
#pragma unroll
            for (int kk = 0; kk < 8; ++kk) wf[kk] = *(const bf16x8*)(w3 + 16 * kk);
#pragma unroll 2
            for (int s2 = 0; s2 <= j; ++s2) { const int s = 2 * s2, tau0 = t - s, tau1 = t - s - 1;
                const bf16x8 b0 = *(const bf16x8*)(kt + tau0 * 256); bf16x8 b1 = (bf16x8){0, 0, 0, 0, 0, 0, 0, 0}; if (tau1 >= 0) b1 = *(const bf16x8*)(kt + tau1 * 256);
                const bf16x8 a0 = *(const LAS bf16x8*)(ap + 32 * s), a1 = *(const LAS bf16x8*)(ap + 32 * s + 32);
                acc = __builtin_amdgcn_mfma_f32_32x32x16_bf16(a0, b0, acc, 0, 0, 0); acc1 = __builtin_amdgcn_mfma_f32_32x32x16_bf16(a1, b1, acc1, 0, 0, 0); }
#pragma unroll
            for (int kk = 0; kk < 8; kk += 2) { const bf16x8 a0 = *(const LAS bf16x8*)(hp + 32 * kk), a1 = *(const LAS bf16x8*)(hp + 32 * kk + 32);
                acc = __builtin_amdgcn_mfma_f32_32x32x16_bf16(a0, wf[kk], acc, 0, 0, 0); acc1 = __builtin_amdgcn_mfma_f32_32x32x16_bf16(a1, wf[kk + 1], acc1, 0, 0, 0); }
#pragma unroll
            for (int r = 0; r < 16; ++r) acc[r] += acc1[r];
#pragma unroll
            for (int r = 0; r < 16; ++r) { const int i = crow(r, hf); const size_t off = ((size_t)g * NTOK + (size_t)b * SEQ + (size_t)(ch0 + i) * SCH + t) * 16 + c;
                const float y = acc[r] + dv * bf2f(*(const LAS bf16*)(F.lds + S5_AOFF + i * S5_APITCH + (t * 16 + c) * 2)); const float x = 0.7978845608028654f * (y + 0.044715f * y * y * y); const float th = 1.f - 2.f / (1.f + __expf(2.f * x));
                YG[off] = (bf16)f2bf(0.5f * y * (1.f + th)); }
        }
    }
}
#ifndef MK_PER_PHASE
#define MK_PER_PHASE 0
#endif
constexpr int NPH = 31;
__device__ __forceinline__ bool in_ph(int k, int lo, int hi) { asm volatile("" : "+s"(lo), "+s"(hi)); return lo <= k && k < hi; }
struct Args { const float* in[34]; float* out; unsigned char* ws; int ph_lo, ph_hi; };
__global__ void __launch_bounds__(NTHR, 2) fwd_kernel(Args args) {
    extern __shared__ __attribute__((aligned(16))) unsigned char lds_raw[];
    Frame F;
    F.lds = (LAS unsigned char*)lds_raw;
    F.tid = threadIdx.x; F.lane = F.tid & 63; F.wave = __builtin_amdgcn_readfirstlane(F.tid >> 6);
    F.G = gridDim.x; { const int bx = blockIdx.x; F.vcu = (F.G % 8 == 0) ? (bx % 8) * (F.G / 8) + bx / 8 : bx; }
    F.out = args.out; F.ws = args.ws;
    for (int u = F.tid; u < 64; u += NTHR) ((LAS unsigned*)(F.lds + UP_MISC))[u] = 0u;
    if (F.tid < 34) *(LAS unsigned long long*)(F.lds + UP_PTR + 8 * F.tid) = (unsigned long long)args.in[F.tid];
    const bool is_w0 = (F.wave == 0);
    F.tid = 0; F.lane = 0;
    __syncthreads();
    XcdBarrier bar; bar.w0 = is_w0; bar.bar = wsp<unsigned>(F, WS_CTL) + CW_BAR; bar.x = 0; bar.st = nullptr;
#if !MK_PER_PHASE
    bar = xcd_barrier_post(wsp<unsigned>(F, WS_CTL) + CW_BAR, (volatile LAS unsigned*)(F.lds + UP_MISC) + 8, is_w0);
#endif
    const int lo = args.ph_lo, hi = args.ph_hi;
#define IN(k) in_ph((k), lo, hi)
#ifndef REPMASK
#define REPMASK 0ull
#endif
#define REPS(n) ((((unsigned long long)(REPMASK)) >> (n)) & 1ull ? 2 : 1)
#ifndef ONLY_SITE
#define EN(n) true
#else
#define EN(n) ((n) == ONLY_SITE)
#endif
#if MK_PER_PHASE
#define SEAM(k) do { } while (0)
#else
#define SEAM(k) do { if (IN(k) && IN((k) + 1)) xcd_barrier(bar); } while (0)
#endif
    const int bx = (int)blockIdx.x;
    typedef pg8::EpiBf16<0> EpiB;
    if (IN(0) && EN(0)) _Pragma("unroll") for (int rep_ = 0; rep_ < REPS(0); ++rep_) { const Frame P = pframe(F); p0_prologue(P); }
    SEAM(0);

            if (IN(1) && EN(1)) _Pragma("unroll") for (int rep_ = 0; rep_ < REPS(1); ++rep_) { const Frame P = pframe(F);
                { pg8::Gemm g{wsp<bf16>(P, WS_XB), wsp<bf16>(P, WS_WTIN0), NTOK, EVW, DM, P.wave}; pg8::StaticOrder S; S.init(NTOK, EVW, P.G, bx);
                  EpiB E{wsp<bf16>(P, WS_P1), EVW, nullptr, 0, 0, 1.f}; pg8::gemm_phase<EpiB, pg8::StaticOrder, true, true>(P.lds, g, S, E); }
                { pg8::Gemm g{wsp<bf16>(P, WS_MEMB), wsp<bf16>(P, WS_WTXK), NMEM, 2048, DM, P.wave}; pg8::StaticOrder S; S.init(NMEM, 2048, P.G, (bx + P.G - P.G / 2) % P.G);
                  EpiB E{wsp<bf16>(P, WS_KX), 2048, nullptr, 0, 0, 1.f}; pg8::gemm_phase<EpiB, pg8::StaticOrder, true, true>(P.lds, g, S, E); }
                { pg8::Gemm g{wsp<bf16>(P, WS_WTXV), wsp<bf16>(P, WS_MEMB), 2048, NMEM, DM, P.wave}; pg8::StaticOrder S; S.init(2048, NMEM, P.G, (bx + P.G - P.G / 2 - 32) % P.G);
                  EpiB E{wsp<bf16>(P, WS_VXT), NMEM, nullptr, 0, 0, 1.f}; pg8::gemm_phase<EpiB, pg8::StaticOrder, true, true>(P.lds, g, S, E); }
                { pg8::Gemm g{wsp<bf16>(P, WS_WTVB), wsp<bf16>(P, WS_XB), 512, NTOK, DM, P.wave}; pg8::StaticOrder S; S.init(512, NTOK, P.G, (bx + P.G - P.G / 2 - 64) % P.G);
                  pg8::EpiVT E{wsp<bf16>(P, WS_VBT), 512}; pg8::gemm_phase<pg8::EpiVT, pg8::StaticOrder, true, true>(P.lds, g, S, E); }
            }
            SEAM(1);
            if (IN(2) && EN(2)) _Pragma("unroll") for (int rep_ = 0; rep_ < REPS(2); ++rep_) { const Frame P = pframe(F); p2_postproc(P); }
            SEAM(2);
            if (IN(3) && EN(3)) _Pragma("unroll") for (int rep_ = 0; rep_ < REPS(3); ++rep_) { const Frame P = pframe(F); const int kq = (lo < 0) ? 512 : 256;     pg8::Gemm g{wsp<bf16>(P, WS_CQ), wsp<bf16>(P, WS_WTQ), NTOK, 1024, kq, P.wave}; pg8::StaticOrder S; S.init(NTOK, 1024, P.G, bx);
                EpiB E{wsp<bf16>(P, WS_QAI), 1024, nullptr, 0, 0, 1.f}; pg8::gemm_phase<EpiB, pg8::StaticOrder, true, true>(P.lds, g, S, E); }
            SEAM(3);
            if (IN(4)) { if (EN(4)) _Pragma("unroll") for (int rep_ = 0; rep_ < REPS(4); ++rep_) { const Frame P = pframe(F); dsa_phase(P); } if (EN(22)) _Pragma("unroll") for (int rep_ = 0; rep_ < REPS(22); ++rep_) { const Frame P = pframe(F); sb_phase(P); } }
            SEAM(4);
            if (IN(5) && EN(5)) _Pragma("unroll") for (int rep_ = 0; rep_ < REPS(5); ++rep_) { const Frame P = pframe(F); pg8::Gemm g{wsp<bf16>(P, WS_OAB), wsp<bf16>(P, WS_WTOUT0), NTOK, DM, DM, P.wave}; pg8::StaticOrder S; S.init(NTOK, DM, P.G, bx);
                pg8::EpiResF32 E{inp(P, 0), wsp<float>(P, WS_T), DM, DN_ALPHA}; pg8::gemm_phase<pg8::EpiResF32, pg8::StaticOrder, true, true>(P.lds, g, S, E); }
            SEAM(5);
            if (IN(6) && EN(6)) _Pragma("unroll") for (int rep_ = 0; rep_ < REPS(6); ++rep_) { const Frame P = pframe(F); ln_phase(P, wsp<float>(P, WS_T), inp(P, 19), inp(P, 20), wsp<float>(P, WS_HF), wsp<bf16>(P, WS_XB)); }
            SEAM(6);
    {
        constexpr int cb = 7;
        if (IN(cb + 0) && EN(7)) _Pragma("unroll") for (int rep_ = 0; rep_ < REPS(7); ++rep_) { const Frame P = pframe(F); pg8::Gemm g{wsp<bf16>(P, WS_XB), wsp<bf16>(P, WS_WTXQ) + (size_t)0 * DM * DM, NTOK, DM, DM, P.wave}; pg8::StaticOrder S; S.init(NTOK, DM, P.G, bx);
            EpiB E{wsp<bf16>(P, WS_QX), DM, nullptr, 0, 0, 1.f}; pg8::gemm_phase<EpiB, pg8::StaticOrder, true, true>(P.lds, g, S, E); }
        SEAM(cb + 0);
        if (IN(cb + 1) && EN(8)) _Pragma("unroll") for (int rep_ = 0; rep_ < REPS(8); ++rep_) { const Frame P = pframe(F); xattn_phase(P, 0); }
        SEAM(cb + 1);
        if (IN(cb + 2) && EN(9)) _Pragma("unroll") for (int rep_ = 0; rep_ < REPS(9); ++rep_) { const Frame P = pframe(F); pg8::Gemm g{wsp<bf16>(P, WS_AX), wsp<bf16>(P, WS_WTXO) + (size_t)0 * DM * DM, NTOK, DM, DM, P.wave}; pg8::StaticOrder S; S.init(NTOK, DM, P.G, bx);
            pg8::EpiResF32 E{wsp<float>(P, WS_HF), wsp<float>(P, WS_T), DM, DN_ALPHA}; pg8::gemm_phase<pg8::EpiResF32, pg8::StaticOrder, true, true>(P.lds, g, S, E); }
        SEAM(cb + 2);
        if (IN(cb + 3) && EN(10)) _Pragma("unroll") for (int rep_ = 0; rep_ < REPS(10); ++rep_) { const Frame P = pframe(F); ln_phase(P, wsp<float>(P, WS_T), inp(P, 24) + 0 * DM, inp(P, 25) + 0 * DM, wsp<float>(P, WS_HF), wsp<bf16>(P, WS_XB)); }
        SEAM(cb + 3);
        if (IN(cb + 4) && EN(11)) _Pragma("unroll") for (int rep_ = 0; rep_ < REPS(11); ++rep_) { const Frame P = pframe(F); router_phase(P, 0); }
        do { if (IN(cb + 4) && IN(cb + 6)) xcd_barrier(bar); } while (0);
        if (IN(cb + 6) && EN(13)) _Pragma("unroll") for (int rep_ = 0; rep_ < REPS(13); ++rep_) { const Frame P0 = pframe(F); moe_tables(P0, 0); }
        if (IN(cb + 6) && EN(13)) _Pragma("unroll") for (int rep_ = 0; rep_ < REPS(13); ++rep_) { const Frame P = pframe(F); const int nrt = __builtin_amdgcn_readfirstlane(((const LAS int*)(P.lds + UP_TSTART))[32]);
            pg8::Gemm g{wsp<bf16>(P, WS_XB), wsp<bf16>(P, WS_WTGU) + (size_t)0 * NEXP * 2048 * DM, nrt * 256, NEXP * 2048, DM, P.wave};
            pg8::MoeRows<8> AM{wsp<int>(P, WS_ELIST), (const LAS int*)(P.lds + UP_TSTART), (const LAS int*)(P.lds + UP_CNT), (LAS int*)(P.lds + UP_TOK)};
            pg8::MoeOrder<8> S{(const LAS int*)(P.lds + UP_TILEE), nrt, P.G, P.vcu};
            pg8::EpiSwiGlu E{wsp<bf16>(P, WS_ACT), inp(P, 29) + (size_t)0 * NEXP * 2048}; pg8::gemm_phase_g<pg8::EpiSwiGlu, pg8::MoeOrder<8>, pg8::MoeRows<8>, true>(P.lds, g, S, E, AM); }
        SEAM(cb + 6);
        if (IN(cb + 7) && EN(14)) _Pragma("unroll") for (int rep_ = 0; rep_ < REPS(14); ++rep_) { const Frame P0 = pframe(F); moe_tables(P0, 0); }
        if (IN(cb + 7) && EN(14)) _Pragma("unroll") for (int rep_ = 0; rep_ < REPS(14); ++rep_) { const Frame P = pframe(F); const int nrt = __builtin_amdgcn_readfirstlane(((const LAS int*)(P.lds + UP_TSTART))[32]);
            pg8::Gemm g{wsp<bf16>(P, WS_ACT), wsp<bf16>(P, WS_WTDN) + (size_t)0 * NEXP * DM * DM, nrt * 256, NEXP * DM, DM, P.wave};
            pg8::MoeOrder<4> S{(const LAS int*)(P.lds + UP_TILEE), nrt, P.G, P.vcu};
            pg8::EpiDown E{wsp<bf16>(P, WS_XG), inp(P, 31) + (size_t)0 * NEXP * DM, wsp<float>(P, WS_EGATE), (const LAS int*)(P.lds + UP_TSTART), (const LAS int*)(P.lds + UP_CNT)}; pg8::gemm_phase<pg8::EpiDown, pg8::MoeOrder<4>, true, true>(P.lds, g, S, E); }
        SEAM(cb + 7);
        if (IN(cb + 8) && EN(15)) { const Frame P = pframe(F); combine_phase(P, 0, 0 == 0 ? wsp<float>(P, WS_HF) : P.out, REPS(15)); }
        SEAM(cb + 8);
    }

            if (IN(16) && EN(16)) _Pragma("unroll") for (int rep_ = 0; rep_ < REPS(16); ++rep_) { const Frame P = pframe(F); pg8::Gemm g{wsp<bf16>(P, WS_XB), wsp<bf16>(P, WS_WTS5IN), NTOK, DM, DM, P.wave}; pg8::StaticOrder S; S.init(NTOK, DM, P.G, bx);
                pg8::EpiBlk E{wsp<bf16>(P, WS_U)}; pg8::gemm_phase<pg8::EpiBlk, pg8::StaticOrder, true, true>(P.lds, g, S, E); }
            SEAM(16);
            if (IN(17) && EN(17)) _Pragma("unroll") for (int rep_ = 0; rep_ < REPS(17); ++rep_) { const Frame P = pframe(F); s5_local_phase(P); }
            SEAM(17);
            if (IN(18) && EN(18)) _Pragma("unroll") for (int rep_ = 0; rep_ < REPS(18); ++rep_) { const Frame P = pframe(F); s5_scan_phase(P); }
            SEAM(18);
            if (IN(19) && EN(19)) _Pragma("unroll") for (int rep_ = 0; rep_ < REPS(19); ++rep_) { const Frame P = pframe(F); s5_out_phase(P); }
            SEAM(19);
            if (IN(20) && EN(20)) _Pragma("unroll") for (int rep_ = 0; rep_ < REPS(20); ++rep_) { const Frame P = pframe(F); pg8::Gemm g{wsp<bf16>(P, WS_YG), wsp<bf16>(P, WS_WTS5OUT), NTOK, 2048, DM, P.wave}; pg8::StaticOrder S; S.init(NTOK, 2048, P.G, bx);
                pg8::EpiGluRes E{wsp<float>(P, WS_HF), wsp<float>(P, WS_T), DM, DN_ALPHA}; pg8::BlkRows AM; pg8::gemm_phase_g<pg8::EpiGluRes, pg8::StaticOrder, pg8::BlkRows, true>(P.lds, g, S, E, AM); }
            SEAM(20);
            if (IN(21) && EN(21)) _Pragma("unroll") for (int rep_ = 0; rep_ < REPS(21); ++rep_) { const Frame P = pframe(F); ln_phase(P, wsp<float>(P, WS_T), inp(P, 19) + DM, inp(P, 20) + DM, wsp<float>(P, WS_HF), wsp<bf16>(P, WS_XB)); }
            SEAM(21);
    {
        constexpr int cb = 22;
        if (IN(cb + 0) && EN(7)) _Pragma("unroll") for (int rep_ = 0; rep_ < REPS(7); ++rep_) { const Frame P = pframe(F); pg8::Gemm g{wsp<bf16>(P, WS_XB), wsp<bf16>(P, WS_WTXQ) + (size_t)1 * DM * DM, NTOK, DM, DM, P.wave}; pg8::StaticOrder S; S.init(NTOK, DM, P.G, bx);
            EpiB E{wsp<bf16>(P, WS_QX), DM, nullptr, 0, 0, 1.f}; pg8::gemm_phase<EpiB, pg8::StaticOrder, true, true>(P.lds, g, S, E); }
        SEAM(cb + 0);
        if (IN(cb + 1) && EN(8)) _Pragma("unroll") for (int rep_ = 0; rep_ < REPS(8); ++rep_) { const Frame P = pframe(F); xattn_phase(P, 1); }
        SEAM(cb + 1);
        if (IN(cb + 2) && EN(9)) _Pragma("unroll") for (int rep_ = 0; rep_ < REPS(9); ++rep_) { const Frame P = pframe(F); pg8::Gemm g{wsp<bf16>(P, WS_AX), wsp<bf16>(P, WS_WTXO) + (size_t)1 * DM * DM, NTOK, DM, DM, P.wave}; pg8::StaticOrder S; S.init(NTOK, DM, P.G, bx);
            pg8::EpiResF32 E{wsp<float>(P, WS_HF), wsp<float>(P, WS_T), DM, DN_ALPHA}; pg8::gemm_phase<pg8::EpiResF32, pg8::StaticOrder, true, true>(P.lds, g, S, E); }
        SEAM(cb + 2);
        if (IN(cb + 3) && EN(10)) _Pragma("unroll") for (int rep_ = 0; rep_ < REPS(10); ++rep_) { const Frame P = pframe(F); ln_phase(P, wsp<float>(P, WS_T), inp(P, 24) + 1 * DM, inp(P, 25) + 1 * DM, wsp<float>(P, WS_HF), wsp<bf16>(P, WS_XB)); }
        SEAM(cb + 3);
        if (IN(cb + 4) && EN(11)) _Pragma("unroll") for (int rep_ = 0; rep_ < REPS(11); ++rep_) { const Frame P = pframe(F); router_phase(P, 1); }
        do { if (IN(cb + 4) && IN(cb + 6)) xcd_barrier(bar); } while (0);
        if (IN(cb + 6) && EN(13)) _Pragma("unroll") for (int rep_ = 0; rep_ < REPS(13); ++rep_) { const Frame P0 = pframe(F); moe_tables(P0, 1); }
        if (IN(cb + 6) && EN(13)) _Pragma("unroll") for (int rep_ = 0; rep_ < REPS(13); ++rep_) { const Frame P = pframe(F); const int nrt = __builtin_amdgcn_readfirstlane(((const LAS int*)(P.lds + UP_TSTART))[32]);
            pg8::Gemm g{wsp<bf16>(P, WS_XB), wsp<bf16>(P, WS_WTGU) + (size_t)1 * NEXP * 2048 * DM, nrt * 256, NEXP * 2048, DM, P.wave};
            pg8::MoeRows<8> AM{wsp<int>(P, WS_ELIST), (const LAS int*)(P.lds + UP_TSTART), (const LAS int*)(P.lds + UP_CNT), (LAS int*)(P.lds + UP_TOK)};
            pg8::MoeOrder<8> S{(const LAS int*)(P.lds + UP_TILEE), nrt, P.G, P.vcu};
            pg8::EpiSwiGlu E{wsp<bf16>(P, WS_ACT), inp(P, 29) + (size_t)1 * NEXP * 2048}; pg8::gemm_phase_g<pg8::EpiSwiGlu, pg8::MoeOrder<8>, pg8::MoeRows<8>, true>(P.lds, g, S, E, AM); }
        SEAM(cb + 6);
        if (IN(cb + 7) && EN(14)) _Pragma("unroll") for (int rep_ = 0; rep_ < REPS(14); ++rep_) { const Frame P0 = pframe(F); moe_tables(P0, 1); }
        if (IN(cb + 7) && EN(14)) _Pragma("unroll") for (int rep_ = 0; rep_ < REPS(14); ++rep_) { const Frame P = pframe(F); const int nrt = __builtin_amdgcn_readfirstlane(((const LAS int*)(P.lds + UP_TSTART))[32]);
            pg8::Gemm g{wsp<bf16>(P, WS_ACT), wsp<bf16>(P, WS_WTDN) + (size_t)1 * NEXP * DM * DM, nrt * 256, NEXP * DM, DM, P.wave};
            pg8::MoeOrder<4> S{(const LAS int*)(P.lds + UP_TILEE), nrt, P.G, P.vcu};
            pg8::EpiDown E{wsp<bf16>(P, WS_XG), inp(P, 31) + (size_t)1 * NEXP * DM, wsp<float>(P, WS_EGATE), (const LAS int*)(P.lds + UP_TSTART), (const LAS int*)(P.lds + UP_CNT)}; pg8::gemm_phase<pg8::EpiDown, pg8::MoeOrder<4>, true, true>(P.lds, g, S, E); }
        SEAM(cb + 7);
        if (IN(cb + 8) && EN(15)) { const Frame P = pframe(F); combine_phase(P, 1, 1 == 0 ? wsp<float>(P, WS_HF) : P.out, REPS(15)); }

    }
#undef IN
#undef SEAM
}

extern "C" void kernel_launch(void* const* d_in, const int* in_sizes, int n_in, void* d_out, int out_size, void* d_ws, size_t ws_size, hipStream_t stream) {
    static int grid = 0;
    if (grid == 0) {
        if (n_in != 34 || in_sizes[0] != NTOK * DM || out_size != NTOK * DM || ws_size < WS_WTVB + 2 * MiB) {
            fprintf(stderr, "kernel_launch: built for 34 inputs, x/out of %d floats, >= %zu bytes of workspace; got n_in %d, in0 %d, out %d, ws %zu; nothing launched\n", NTOK * DM, (size_t)WS_END, n_in, n_in > 0 ? in_sizes[0] : -1, out_size, ws_size);
            grid = -1; return; }
        int dev = 0, cus = 0, per_cu = 0;
        if (hipGetDevice(&dev) != hipSuccess || hipDeviceGetAttribute(&cus, hipDeviceAttributeMultiprocessorCount, dev) != hipSuccess) { fprintf(stderr, "kernel_launch: device query failed\n"); grid = -1; return; }
        if (hipFuncSetAttribute((const void*)fwd_kernel, hipFuncAttributeMaxDynamicSharedMemorySize, LDS_BYTES) != hipSuccess) { fprintf(stderr, "kernel_launch: hipFuncSetAttribute failed\n"); grid = -1; return; }
        if (hipOccupancyMaxActiveBlocksPerMultiprocessor(&per_cu, (const void*)fwd_kernel, NTHR, LDS_BYTES) != hipSuccess || per_cu < 1)
            fprintf(stderr, "kernel_launch: note: occupancy query reports %d workgroups per CU\n", per_cu);
        (void)hipGetLastError();
        grid = cus;
    }
    if (grid < 0) return;
    if (hipMemsetAsync((char*)d_ws + WS_CTL, 0, CTL_ZERO_BYTES, stream) != hipSuccess) { fprintf(stderr, "kernel_launch: memset failed\n"); return; }
    Args a{};
    for (int i = 0; i < 34; ++i) a.in[i] = (const float*)d_in[i];
    a.out = (float*)d_out; a.ws = (unsigned char*)d_ws;
#if MK_PER_PHASE
    for (int p = 0; p < NPH; ++p) { a.ph_lo = p; a.ph_hi = p + 1; hipLaunchKernelGGL(fwd_kernel, dim3(grid), dim3(NTHR), LDS_BYTES, stream, a); }
#else
    a.ph_lo = 0; a.ph_hi = NPH;
    hipLaunchKernelGGL(fwd_kernel, dim3(grid), dim3(NTHR), LDS_BYTES, stream, a);
#endif
    const hipError_t le = hipPeekAtLastError();
    if (le != hipSuccess) fprintf(stderr, "kernel_launch: launch failed: %s\n", hipGetErrorName(le));
}
```
